# Optimizing an MI355X kernel written in HIP

```python
import jax, jax.numpy as jnp
from jax import lax
import numpy as np

D_MODEL = 1024
BATCH = 4
SEQ = 8192
DEPTH = 2
DEC_BATCH = 128
DEC_SEQ = 4
PAST_LEN = 16384
PAGE_SIZE = 128

N_A_LAYERS = DEPTH // 2
N_B_LAYERS = DEPTH - N_A_LAYERS
CHUNK = 128
GM_HALF = 2 * D_MODEL
GM_GROUPS = 8
GM_GROUP_DIM = GM_HALF // GM_GROUPS
HEAD_DIM = 64
N_HEADS = D_MODEL // HEAD_DIM
N_KV_HEADS = N_HEADS // 8
Q_PER_KV = N_HEADS // N_KV_HEADS
WINDOW = 128
ROT_DIM = HEAD_DIM // 4
ROPE_THETA = 500000.0
D_FF = 2816
CONV_W = 3
PLE_DIM = 256
EPS = 1e-6
NEG_INF = -1e30

kernel_name = "yoco_gmlp_swa_sink_convffn_step"


def rmsnorm(x, w):
    xf = x.astype(jnp.float32)
    y = xf * lax.rsqrt(jnp.mean(xf * xf, axis=-1, keepdims=True) + EPS)
    return (y * w.astype(jnp.float32)).astype(x.dtype)


def partial_rope(x, pos):
    half = ROT_DIM // 2
    inv_freq = ROPE_THETA ** (-jnp.arange(half, dtype=jnp.float32) / half)
    ang = pos.astype(jnp.float32)[:, None] * inv_freq[None, :]
    cos = jnp.cos(ang)[None, :, None, :].astype(x.dtype)
    sin = jnp.sin(ang)[None, :, None, :].astype(x.dtype)
    x1 = x[..., :half]
    x2 = x[..., half:ROT_DIM]
    return jnp.concatenate([x1 * cos - x2 * sin, x2 * cos + x1 * sin, x[..., ROT_DIM:]], axis=-1)


def chunk_gmlp(h, w_in, v_norm, w_s, b_s, w_out, chunk_len):
    B, T, _ = h.shape
    z = jax.nn.gelu(h @ w_in)
    u, v = z[..., :GM_HALF], z[..., GM_HALF:]
    v = rmsnorm(v, v_norm)
    n = T // chunk_len
    L = chunk_len
    causal = jnp.tril(jnp.ones((L, L), dtype=bool))
    ws = jnp.where(causal[None], w_s[:, :L, :L], 0).astype(v.dtype)
    vb = v.reshape(B, n, L, GM_GROUPS, GM_GROUP_DIM)
    mixed = jnp.einsum('gts,bnsgc->bntgc', ws, vb) + b_s[:, :L].T[None, None, :, :, None].astype(v.dtype)
    out = u * mixed.reshape(B, T, GM_HALF)
    return out @ w_out, v


def conv_ffn(h, conv_state, w_gate, w_up, conv_w, conv_b, w_down):
    T = h.shape[1]
    g = h @ w_gate
    gp = jnp.concatenate([conv_state.astype(g.dtype), g], axis=1)
    conv = conv_b.astype(g.dtype)
    for k in range(CONV_W):
        conv = conv + gp[:, k:k + T] * conv_w[k]
    act = jax.nn.gelu(conv) * (h @ w_up)
    return act @ w_down, gp[:, T:]


def band_attention(q, k, v, sinks, k_past, v_past):
    B, T = q.shape[0], q.shape[1]
    if k_past is None:
        nb = T // WINDOW
        lq = WINDOW
        pad = jnp.zeros((B, WINDOW, N_KV_HEADS, HEAD_DIM), k.dtype)
        kp = jnp.concatenate([pad, k], axis=1).reshape(B, nb + 1, WINDOW, N_KV_HEADS, HEAD_DIM)
        vp = jnp.concatenate([pad, v], axis=1).reshape(B, nb + 1, WINDOW, N_KV_HEADS, HEAD_DIM)
        kb = jnp.concatenate([kp[:, :-1], kp[:, 1:]], axis=2)
        vb = jnp.concatenate([vp[:, :-1], vp[:, 1:]], axis=2)
        block_ok = (jnp.arange(nb)[:, None, None] > 0) | (jnp.arange(2 * WINDOW)[None, None, :] >= WINDOW)
    else:
        nb = 1
        lq = T
        kb = jnp.concatenate([k_past.astype(k.dtype), k], axis=1)[:, None]
        vb = jnp.concatenate([v_past.astype(v.dtype), v], axis=1)[:, None]
        block_ok = jnp.ones((1, 1, WINDOW + T), dtype=bool)
    lk = WINDOW + lq
    qi = jnp.arange(lq)[:, None]
    sj = jnp.arange(lk)[None, :]
    mask = ((sj > qi) & (sj <= qi + WINDOW))[None] & block_ok
    qb = q.reshape(B, nb, lq, N_KV_HEADS, Q_PER_KV, HEAD_DIM)
    s = jnp.einsum('bnqkgd,bnskd->bnkgqs', qb, kb, preferred_element_type=jnp.float32) * (HEAD_DIM ** -0.5)
    s = jnp.where(mask[None, :, None, None], s, NEG_INF)
    sink = jnp.broadcast_to(sinks.astype(jnp.float32).reshape(1, 1, N_KV_HEADS, Q_PER_KV, 1, 1), s.shape[:-1] + (1,))
    p = jax.nn.softmax(jnp.concatenate([s, sink], axis=-1), axis=-1)[..., :-1].astype(vb.dtype)
    o = jnp.einsum('bnkgqs,bnskd->bnqkgd', p, vb)
    return o.reshape(B, T, N_HEADS * HEAD_DIM)


def setup_inputs(seed: int = 0) -> dict:
    key = jax.random.key(seed)
    ks = jax.random.split(key, 32)

    def nrm(k, shape, scale=1.0):
        return jax.random.normal(k, shape, jnp.float32) * scale

    def gain(k, shape):
        return 1.0 + 0.05 * jax.random.normal(k, shape, jnp.float32)

    kv_dim = N_KV_HEADS * HEAD_DIM
    return {
        "x_prompt": nrm(ks[0], (BATCH, SEQ, D_MODEL)),
        "x_sample": nrm(ks[1], (DEC_BATCH, DEC_SEQ, D_MODEL)),
        "state_ffn_conv": nrm(ks[2], (DEPTH, DEC_BATCH, CONV_W - 1, D_FF)),
        "cache_k_win": nrm(ks[3], (DEC_BATCH, WINDOW, N_KV_HEADS, HEAD_DIM)),
        "cache_v_win": nrm(ks[4], (DEC_BATCH, WINDOW, N_KV_HEADS, HEAD_DIM)),
        "p_prompt": nrm(ks[5], (DEPTH, BATCH, SEQ, PLE_DIM)),
        "p_sample": nrm(ks[6], (DEPTH, DEC_BATCH, DEC_SEQ, PLE_DIM)),
        "norm_mix": gain(ks[7], (DEPTH, D_MODEL)),
        "gm_w_in": nrm(ks[8], (N_A_LAYERS, D_MODEL, 2 * GM_HALF), D_MODEL ** -0.5),
        "gm_v_norm": gain(ks[9], (N_A_LAYERS, GM_HALF)),
        "gm_w_s": nrm(ks[10], (N_A_LAYERS, GM_GROUPS, CHUNK, CHUNK), CHUNK ** -0.5),
        "gm_b_s": 1.0 + 0.1 * nrm(ks[11], (N_A_LAYERS, GM_GROUPS, CHUNK)),
        "gm_w_out": nrm(ks[12], (N_A_LAYERS, GM_HALF, D_MODEL), GM_HALF ** -0.5),
        "kv_norm": gain(ks[13], (D_MODEL,)),
        "w_kv": nrm(ks[14], (D_MODEL, 2 * kv_dim), D_MODEL ** -0.5),
        "w_q": nrm(ks[15], (N_B_LAYERS, D_MODEL, N_HEADS * HEAD_DIM), D_MODEL ** -0.5),
        "attn_sinks": nrm(ks[16], (N_B_LAYERS, N_HEADS), 0.5),
        "w_o": nrm(ks[17], (N_B_LAYERS, N_HEADS * HEAD_DIM, D_MODEL), (N_HEADS * HEAD_DIM) ** -0.5),
        "norm_ffn": gain(ks[18], (DEPTH, D_MODEL)),
        "ffn_w_gate": nrm(ks[19], (DEPTH, D_MODEL, D_FF), D_MODEL ** -0.5),
        "ffn_w_up": nrm(ks[20], (DEPTH, D_MODEL, D_FF), D_MODEL ** -0.5),
        "ffn_conv_w": nrm(ks[21], (DEPTH, CONV_W, D_FF), CONV_W ** -0.5),
        "ffn_conv_b": nrm(ks[22], (DEPTH, D_FF), 0.02),
        "ffn_w_down": nrm(ks[23], (DEPTH, D_FF, D_MODEL), D_FF ** -0.5),
        "ple_norm": gain(ks[24], (DEPTH, D_MODEL)),
        "ple_w_gate": nrm(ks[25], (DEPTH, D_MODEL, D_MODEL), D_MODEL ** -0.5),
        "ple_w_proj": nrm(ks[26], (DEPTH, PLE_DIM, D_MODEL), PLE_DIM ** -0.5),
        "final_norm": gain(ks[27], (D_MODEL,)),
    }


def reference(x_prompt, x_sample, state_ffn_conv, cache_k_win, cache_v_win, p_prompt, p_sample,
              norm_mix, gm_w_in, gm_v_norm, gm_w_s, gm_b_s, gm_w_out, kv_norm, w_kv, w_q, attn_sinks, w_o,
              norm_ffn, ffn_w_gate, ffn_w_up, ffn_conv_w, ffn_conv_b, ffn_w_down,
              ple_norm, ple_w_gate, ple_w_proj, final_norm):
    kv_dim = N_KV_HEADS * HEAD_DIM

    def shared_kv(x, pos):
        B, T, _ = x.shape
        kv = rmsnorm(x, kv_norm) @ w_kv
        k = partial_rope(kv[..., :kv_dim].reshape(B, T, N_KV_HEADS, HEAD_DIM), pos)
        v = kv[..., kv_dim:].reshape(B, T, N_KV_HEADS, HEAD_DIM)
        return k, v

    def trunk(x, p, conv_state, k_past, v_past, pos, chunk_len):
        B, T, _ = x.shape
        gm_v, new_conv = [], []
        k = v = None
        for i in range(DEPTH):
            h = rmsnorm(x, norm_mix[i])
            if i < N_A_LAYERS:
                mix, v_rows = chunk_gmlp(h, gm_w_in[i], gm_v_norm[i], gm_w_s[i], gm_b_s[i], gm_w_out[i], chunk_len)
                gm_v.append(v_rows)
            else:
                j = i - N_A_LAYERS
                q = partial_rope((h @ w_q[j]).reshape(B, T, N_HEADS, HEAD_DIM), pos)
                mix = band_attention(q, k, v, attn_sinks[j], k_past, v_past) @ w_o[j]
            x = x + mix
            h = rmsnorm(x, norm_ffn[i])
            ffn, cs = conv_ffn(h, conv_state[i], ffn_w_gate[i], ffn_w_up[i], ffn_conv_w[i], ffn_conv_b[i], ffn_w_down[i])
            new_conv.append(cs)
            x = x + ffn
            gate = jax.nn.sigmoid(rmsnorm(x, ple_norm[i]) @ ple_w_gate[i])
            x = x + (p[i] @ ple_w_proj[i]) * gate
            if i == N_A_LAYERS - 1:
                k, v = shared_kv(x, pos)
        return rmsnorm(x, final_norm), gm_v, new_conv, k, v

    zero_conv = jnp.zeros((DEPTH, x_prompt.shape[0], CONV_W - 1, D_FF), x_prompt.dtype)
    pos_prompt = jnp.arange(SEQ, dtype=jnp.int32)
    pos_sample = PAST_LEN + jnp.arange(DEC_SEQ, dtype=jnp.int32)

    y_prompt, _, conv_p, k_p, v_p = trunk(x_prompt, p_prompt, zero_conv, None, None, pos_prompt, CHUNK)
    y_sample, gm_s, conv_s, k_s, v_s = trunk(x_sample, p_sample, state_ffn_conv, cache_k_win, cache_v_win,
                                             pos_sample, DEC_SEQ)

    new_gm_v_sample = jnp.stack(gm_s, axis=0)
    new_conv_prompt = jnp.stack(conv_p, axis=0)
    new_conv_sample = jnp.stack(conv_s, axis=0)
    new_k_prompt = k_p[:, -WINDOW:]
    new_v_prompt = v_p[:, -WINDOW:]
    return (y_prompt, y_sample, new_gm_v_sample, new_conv_prompt, new_conv_sample,
            new_k_prompt, new_v_prompt, k_s, v_s)
```

```cpp
#include <hip/hip_runtime.h>
#include <hip/hip_cooperative_groups.h>
#include <cstdio>
#include <cstdint>
namespace cg = cooperative_groups;

#define LAS __attribute__((address_space(3)))
typedef unsigned short bf16_t;
typedef short bf16x8 __attribute__((ext_vector_type(8)));
typedef float f32x4 __attribute__((ext_vector_type(4)));
typedef float f32x2 __attribute__((ext_vector_type(2)));
typedef unsigned u32x4 __attribute__((ext_vector_type(4)));
typedef unsigned u32x2 __attribute__((ext_vector_type(2)));

constexpr int DM = 1024, SEQ = 8192, MP = 32768, MS = 512, MT = MP + MS;
constexpr int GH = 2048, DFF = 2816, PLE = 256, KVD = 128;
constexpr float EPS = 1e-6f;
constexpr float LOG2E = 1.4426950408889634f;

constexpr size_t MiB = 1u << 20;
constexpr size_t WS_ROPE = 1 * MiB;
constexpr size_t WS_WTRIL = 2 * MiB;
constexpr size_t WS_SSA = 3 * MiB;
constexpr size_t WS_SSB = 6 * MiB;
constexpr size_t WS_VSS = 9 * MiB;
constexpr size_t WS_HG = 14 * MiB;
constexpr size_t WS_C0 = 25 * MiB;
constexpr size_t WS_U0 = 36 * MiB;
constexpr size_t WS_KB = 47 * MiB;
constexpr size_t WS_VB = 56 * MiB;
constexpr size_t WS_WIN = 66 * MiB;
constexpr size_t WS_WOUT = 74 * MiB;
constexpr size_t WS_WGU0 = 78 * MiB;
constexpr size_t WS_WD0 = 100 * MiB;
constexpr size_t WS_WPG0 = 111 * MiB;
constexpr size_t WS_WPP0 = 115 * MiB;
constexpr size_t WS_WQKV = 116 * MiB;
constexpr size_t WS_WO = 119 * MiB;
constexpr size_t WS_XBA = 121 * MiB;
constexpr size_t WS_PB = 186 * MiB;
constexpr size_t WS_Z = 219 * MiB;
constexpr size_t WS_END = 479 * MiB;

constexpr size_t O_Y = 0, O_GMV = 34078720, O_NCP = 35127296, O_NCS = 35172352, O_NKP = 36614144, O_NVP = 36679680, O_KS = 36745216, O_VS = 36810752;

__device__ __forceinline__ unsigned cvt_pk_bf16(float lo, float hi) { unsigned r; asm volatile("v_cvt_pk_bf16_f32 %0, %1, %2" : "=v"(r) : "v"(lo), "v"(hi)); return r; }
__device__ __forceinline__ float bf2f(unsigned h) { return __uint_as_float(h << 16); }
__device__ __forceinline__ u32x2 pack4(f32x4 v) { u32x2 w; w.x = cvt_pk_bf16(v[0], v[1]); w.y = cvt_pk_bf16(v[2], v[3]); return w; }
__device__ __forceinline__ f32x4 unpack4(u32x2 w) { return (f32x4){bf2f(w.x & 0xffffu), bf2f(w.x >> 16), bf2f(w.y & 0xffffu), bf2f(w.y >> 16)}; }
__device__ __forceinline__ float gelu1(float x) {
    const float z = x * (0.7978845608f + 0.0356774081f * x * x);
    const float e = __builtin_amdgcn_exp2f(-2.0f * LOG2E * z);
    return x * __builtin_amdgcn_rcpf(1.0f + e);
}
__device__ __forceinline__ f32x4 gelu4(f32x4 v) { return (f32x4){gelu1(v[0]), gelu1(v[1]), gelu1(v[2]), gelu1(v[3])}; }
__device__ __forceinline__ float sigmoid1(float x) { return __builtin_amdgcn_rcpf(1.0f + __builtin_amdgcn_exp2f(-LOG2E * x)); }
__device__ __forceinline__ float dot4(f32x4 v) { return (v[0] * v[0] + v[1] * v[1]) + (v[2] * v[2] + v[3] * v[3]); }
__device__ __forceinline__ float rstd16(const float* ss, int row) { return __builtin_amdgcn_rsqf(ss[row] * (1.0f / 1024.0f) + EPS); }
#define EPI_FENCE() asm volatile("" ::: "memory")
__device__ __forceinline__ int opaque_tid(int wave0) { int l; asm volatile("v_mbcnt_lo_u32_b32 %0, -1, 0\n\tv_mbcnt_hi_u32_b32 %0, -1, %0" : "=v"(l)); return wave0 * 64 + l; }
__device__ __forceinline__ f32x4 shfl4(f32x4 v, int src) { return (f32x4){__shfl(v[0], src), __shfl(v[1], src), __shfl(v[2], src), __shfl(v[3], src)}; }
__device__ __forceinline__ float wave_sum(float v) {
#pragma unroll
    for (int o = 1; o < 64; o <<= 1) v += __shfl_xor(v, o);
    return v;
}

namespace pg8 {
constexpr int BM = 256, BK = 64, HALF = 128, HTB = HALF * BK * 2, STAGE_BYTES = 8 * HTB, NXCD = 8, WGM = 8;
__host__ __device__ __forceinline__ int lds_byte(int r, int c) { const int st = (r >> 4) * 2 + (c >> 5), rr = r & 15, cc = c & 31, ob = rr * 64 + cc * 2; return st * 1024 + (ob ^ (((ob >> 9) & 1) << 5)); }
__host__ __device__ __forceinline__ void stage_rc(int b, int& R, int& C) { const int st = b / 1024, sb = b % 1024, swz = sb ^ (((sb >> 9) & 1) << 5); R = (st >> 1) * 16 + swz / 64; C = (st & 1) * 32 + (swz % 64) / 2; }

struct Unit { int pm, pn; };
struct Gemm { const bf16_t* A; const bf16_t* Bt; int M, N, K, lda; };

struct StaticOrder {
    int nM, nN, nwg, G, c;
    __device__ void init(int M, int N, int G_, int c_) { nM = M / BM; nN = N / BM; nwg = nM * nN; G = G_; c = c_; }
    __device__ bool next(int i, Unit& u) const {
        const long L = (long)i * G + c; if (L >= nwg) return false;
        int wgid = (int)L; { const int q = nwg / NXCD, r = nwg % NXCD, xcd = wgid % NXCD, off = wgid / NXCD; wgid = (xcd < r ? xcd * (q + 1) : r * (q + 1) + (xcd - r) * q) + off; }
        const int nig = WGM * nN, gid = wgid / nig, fm = gid * WGM, gsz = (nM - fm) < WGM ? (nM - fm) : WGM;
        u.pm = fm + ((wgid % nig) % gsz); u.pn = (wgid % nig) / gsz; return true;
    }
};

template <class Epi, bool ALIGN_EPI = true, bool SP2 = true>
__device__ __forceinline__ void gemm_phase(LAS unsigned char* lds, const Gemm g, const StaticOrder& S_in, const Epi& E, int wave0) {
    StaticOrder S = S_in; asm volatile("" : "+s"(S.c));
    const int tid = opaque_tid(wave0), wid = __builtin_amdgcn_readfirstlane(tid >> 6), lane = tid & 63, wr = wid >> 2, wc = wid & 3, fr = lane & 15, fq = lane >> 4;
    const int K = g.K, nt = K / BK;
    unsigned voffA[2], voffB[2];
#pragma unroll
    for (int i = 0; i < 2; ++i) { int R, C; stage_rc(tid * 16 + i * 8192, R, C);
        voffA[i] = (unsigned)(R * g.lda + C) * 2u; voffB[i] = (unsigned)(R * K + C) * 2u; }
    const size_t kstep = (size_t)(BK * 2);
    const size_t hstepA = (size_t)HALF * g.lda * 2, hstepB = (size_t)HALF * K * 2;
    const size_t tstepA = 2 * hstepA, tstepB = 2 * hstepB;
    const unsigned ldsw = (unsigned)wid * 1024u;
    const int aoff = lds_byte(wr * 64 + fr, fq * 8), boff = lds_byte(wc * 32 + fr, fq * 8);
#define PG8_SA(b, h) (((b) * 2 + (h)) * HTB)
#define PG8_SB(b, h) ((4 + (b) * 2 + (h)) * HTB)
#define PG8_STAGE(bufoff, gbase, voff) do { _Pragma("unroll") for (int _i = 0; _i < 2; ++_i) \
        __builtin_amdgcn_global_load_lds((const unsigned*)((const char*)(gbase) + (voff)[_i]), (LAS unsigned*)(lds + (bufoff) + ldsw + _i * 8192), 16, 0, 0); } while (0)
#define PG8_LDA(dst, b, h) do { _Pragma("unroll") for (int m = 0; m < 4; ++m) _Pragma("unroll") for (int k = 0; k < 2; ++k) dst[m][k] = *(const LAS bf16x8*)(lds + PG8_SA(b, h) + aoff + m * 2048 + k * 1024); } while (0)
#define PG8_LDB(dst, b, h) do { _Pragma("unroll") for (int n = 0; n < 2; ++n) _Pragma("unroll") for (int k = 0; k < 2; ++k) dst[n][k] = *(const LAS bf16x8*)(lds + PG8_SB(b, h) + boff + n * 2048 + k * 1024); } while (0)
#define PG8_MMA(ai, bj, At, Bt) do { __builtin_amdgcn_s_setprio(1); _Pragma("unroll") for (int m = 0; m < 4; ++m) _Pragma("unroll") for (int n = 0; n < 2; ++n) _Pragma("unroll") for (int k = 0; k < 2; ++k) \
        acc[ai][bj][m][n] = __builtin_amdgcn_mfma_f32_16x16x32_bf16(Bt[n][k], At[m][k], acc[ai][bj][m][n], 0, 0, 0); __builtin_amdgcn_s_setprio(0); } while (0)
#define PG8_WAIT_V(n) asm volatile("s_waitcnt vmcnt(" #n ")" ::: "memory")
#define PG8_WAIT_L(n) asm volatile("s_waitcnt lgkmcnt(" #n ")" ::: "memory")
#define PG8_BAR __builtin_amdgcn_s_barrier()
#define PG8_SCHED __builtin_amdgcn_sched_barrier(0)
    Unit cur, nxt; int ui = 0;
    if (!S.next(0, cur)) return;
    f32x4 acc[2][2][4][2];
#pragma unroll
    for (int a = 0; a < 2; ++a)
#pragma unroll
        for (int b = 0; b < 2; ++b)
#pragma unroll
            for (int m = 0; m < 4; ++m)
#pragma unroll
                for (int n = 0; n < 2; ++n) acc[a][b][m][n] = (f32x4){0.f, 0.f, 0.f, 0.f};
    bf16x8 At[4][2], B0[2][2], B1[2][2];
    const char* cA = (const char*)g.A + (size_t)cur.pm * tstepA; const char* cB = (const char*)g.Bt + (size_t)cur.pn * tstepB;
    if constexpr (SP2) {
        PG8_STAGE(PG8_SB(0, 0), cB, voffB); PG8_STAGE(PG8_SB(0, 1), cB + hstepB, voffB); PG8_STAGE(PG8_SA(0, 0), cA, voffA); PG8_STAGE(PG8_SA(0, 1), cA + hstepA, voffA);
        if (wr == 1) PG8_BAR;
        PG8_WAIT_V(2); PG8_BAR;
        PG8_STAGE(PG8_SB(1, 0), cB + kstep, voffB); PG8_STAGE(PG8_SA(1, 0), cA + kstep, voffA); PG8_STAGE(PG8_SB(1, 1), cB + hstepB + kstep, voffB);
        PG8_WAIT_V(6); PG8_BAR;
    } else {
        PG8_STAGE(PG8_SB(0, 0), cB, voffB); PG8_STAGE(PG8_SA(0, 0), cA, voffA); PG8_STAGE(PG8_SB(0, 1), cB + hstepB, voffB); PG8_STAGE(PG8_SA(0, 1), cA + hstepA, voffA);
        if (wr == 1) PG8_BAR;
        PG8_WAIT_V(4); PG8_BAR;
        PG8_STAGE(PG8_SB(1, 0), cB + kstep, voffB); PG8_STAGE(PG8_SA(1, 0), cA + kstep, voffA); PG8_STAGE(PG8_SB(1, 1), cB + hstepB + kstep, voffB);
        PG8_WAIT_V(6); PG8_BAR;
    }
    for (;;) {
        const bool has_next = S.next(ui + 1, nxt);
        const char* nA = has_next ? (const char*)g.A + (size_t)nxt.pm * tstepA : cA; const char* nB = has_next ? (const char*)g.Bt + (size_t)nxt.pn * tstepB : cB;
        for (int t = 0; t < nt; t += 2) {
            const bool last = (t == nt - 2);
            const char* a1 = cA + (size_t)(t + 1) * kstep;
            const char* a2 = last ? nA : cA + (size_t)(t + 2) * kstep; const char* b2 = last ? nB : cB + (size_t)(t + 2) * kstep;
            const char* a3 = a2 + kstep; const char* b3 = b2 + kstep;
            if constexpr (SP2) {
            PG8_LDB(B0, 0, 0); PG8_LDB(B1, 0, 1); PG8_SCHED; PG8_LDA(At, 0, 0); PG8_STAGE(PG8_SA(1, 1), a1 + hstepA, voffA);
            PG8_WAIT_V(8); PG8_WAIT_L(0); PG8_BAR; PG8_MMA(0, 0, At, B0); PG8_MMA(0, 1, At, B1); PG8_BAR; PG8_SCHED;
            PG8_LDA(At, 0, 1); PG8_STAGE(PG8_SB(0, 0), b2, voffB); PG8_STAGE(PG8_SB(0, 1), b2 + hstepB, voffB); PG8_STAGE(PG8_SA(0, 0), a2, voffA);
            PG8_WAIT_V(8); PG8_WAIT_L(0); PG8_BAR; PG8_MMA(1, 0, At, B0); PG8_MMA(1, 1, At, B1); PG8_BAR; PG8_SCHED;
            PG8_LDB(B0, 1, 0); PG8_LDB(B1, 1, 1); PG8_SCHED; PG8_LDA(At, 1, 0); PG8_STAGE(PG8_SA(0, 1), a2 + hstepA, voffA);
            PG8_WAIT_V(8); PG8_WAIT_L(0); PG8_BAR; PG8_MMA(0, 0, At, B0); PG8_MMA(0, 1, At, B1); PG8_BAR; PG8_SCHED;
            PG8_LDA(At, 1, 1); PG8_STAGE(PG8_SB(1, 0), b3, voffB); PG8_STAGE(PG8_SB(1, 1), b3 + hstepB, voffB); PG8_STAGE(PG8_SA(1, 0), a3, voffA);
            PG8_WAIT_V(8); PG8_WAIT_L(0); PG8_BAR; PG8_MMA(1, 0, At, B0); PG8_MMA(1, 1, At, B1); PG8_BAR; PG8_SCHED;
            } else {
            PG8_LDB(B0, 0, 0); PG8_SCHED; PG8_LDA(At, 0, 0); PG8_STAGE(PG8_SA(1, 1), a1 + hstepA, voffA);
            PG8_WAIT_L(8); PG8_BAR; PG8_WAIT_L(0); PG8_MMA(0, 0, At, B0); PG8_BAR; PG8_SCHED;
            PG8_LDB(B1, 0, 1); PG8_STAGE(PG8_SB(0, 0), b2, voffB);
            PG8_BAR; PG8_WAIT_L(0); PG8_MMA(0, 1, At, B1); PG8_BAR;
            PG8_LDA(At, 0, 1); PG8_STAGE(PG8_SA(0, 0), a2, voffA);
            PG8_BAR; PG8_WAIT_L(0); PG8_MMA(1, 0, At, B0); PG8_BAR; PG8_SCHED;
            PG8_STAGE(PG8_SB(0, 1), b2 + hstepB, voffB);
            PG8_WAIT_V(6); PG8_BAR; PG8_MMA(1, 1, At, B1); PG8_BAR;
            PG8_LDB(B0, 1, 0); PG8_SCHED; PG8_LDA(At, 1, 0); PG8_STAGE(PG8_SA(0, 1), a2 + hstepA, voffA);
            PG8_WAIT_L(8); PG8_BAR; PG8_WAIT_L(0); PG8_MMA(0, 0, At, B0); PG8_BAR; PG8_SCHED;
            PG8_LDB(B1, 1, 1); PG8_STAGE(PG8_SB(1, 0), b3, voffB);
            PG8_BAR; PG8_WAIT_L(0); PG8_MMA(0, 1, At, B1); PG8_BAR;
            PG8_LDA(At, 1, 1); PG8_STAGE(PG8_SA(1, 0), a3, voffA);
            PG8_BAR; PG8_WAIT_L(0); PG8_MMA(1, 0, At, B0); PG8_BAR; PG8_SCHED;
            PG8_STAGE(PG8_SB(1, 1), b3 + hstepB, voffB);
            PG8_WAIT_V(6); PG8_BAR; PG8_MMA(1, 1, At, B1); PG8_BAR;
            }
        }
        if constexpr (ALIGN_EPI) { if (wr == 0) PG8_BAR; }
        E(acc, cur, wr, wc, fr, fq);
        if (!has_next) break;
#pragma unroll
        for (int a = 0; a < 2; ++a)
#pragma unroll
            for (int b = 0; b < 2; ++b)
#pragma unroll
                for (int m = 0; m < 4; ++m)
#pragma unroll
                    for (int n = 0; n < 2; ++n) acc[a][b][m][n] = (f32x4){0.f, 0.f, 0.f, 0.f};
        cur = nxt; cA = nA; cB = nB; ++ui;
        if constexpr (ALIGN_EPI) { if (wr == 1) PG8_BAR; }
    }
    PG8_WAIT_V(0);
    if constexpr (!ALIGN_EPI) { if (wr == 0) PG8_BAR; }
    PG8_BAR;
#undef PG8_SA
#undef PG8_SB
#undef PG8_STAGE
#undef PG8_LDA
#undef PG8_LDB
#undef PG8_MMA
#undef PG8_WAIT_V
#undef PG8_WAIT_L
#undef PG8_BAR
#undef PG8_SCHED
}
}
using pg8::Unit;
typedef f32x4 Acc[2][2][4][2];

struct EpiGm {
    const float* ss; bf16_t* Z; float* vss;
    __device__ __forceinline__ void operator()(Acc& acc, const Unit& u, int wr, int wc, int fr, int fq) const {
        asm volatile("" : "+v"(fr), "+v"(fq));
#pragma unroll
        for (int ai = 0; ai < 2; ++ai)
#pragma unroll
            for (int m = 0; m < 4; ++m) {
                const int row = u.pm * 256 + ai * 128 + wr * 64 + m * 16 + fr;
                const float rs = rstd16(ss, row); float s = 0.f;
#pragma unroll
                for (int bj = 0; bj < 2; ++bj)
#pragma unroll
                    for (int n = 0; n < 2; ++n) {
                        const int col = u.pn * 256 + bj * 128 + wc * 32 + n * 16 + 4 * fq;
                        const f32x4 v = gelu4(acc[ai][bj][m][n] * rs);
                        *(u32x2*)(Z + (size_t)row * 4096 + col) = pack4(v);
                        s += dot4(v);
                    }
                if (u.pn >= 8) { s += __shfl_xor(s, 16); s += __shfl_xor(s, 32); if (fq == 0) unsafeAtomicAdd(vss + row, s); }
                EPI_FENCE();
            }
    }
};
struct EpiRes {
    float* X; bf16_t* xb; float* sso;
    __device__ __forceinline__ void operator()(Acc& acc, const Unit& u, int wr, int wc, int fr, int fq) const {
        asm volatile("" : "+v"(fr), "+v"(fq));
#pragma unroll
        for (int ai = 0; ai < 2; ++ai)
#pragma unroll
            for (int m = 0; m < 4; ++m) {
                const int row = u.pm * 256 + ai * 128 + wr * 64 + m * 16 + fr; float s = 0.f;
#pragma unroll
                for (int bj = 0; bj < 2; ++bj)
#pragma unroll
                    for (int n = 0; n < 2; ++n) {
                        const int col = u.pn * 256 + bj * 128 + wc * 32 + n * 16 + 4 * fq;
                        float* xp = X + (size_t)row * 1024 + col;
                        const f32x4 v = *(const f32x4*)xp + acc[ai][bj][m][n];
                        *(f32x4*)xp = v; *(u32x2*)(xb + (size_t)row * 1024 + col) = pack4(v); s += dot4(v);
                    }
                s += __shfl_xor(s, 16); s += __shfl_xor(s, 32); if (fq == 0) unsafeAtomicAdd(sso + row, s);
                EPI_FENCE();
            }
    }
};
struct EpiF32 {
    float* C;
    __device__ __forceinline__ void operator()(Acc& acc, const Unit& u, int wr, int wc, int fr, int fq) const {
        asm volatile("" : "+v"(fr), "+v"(fq));
#pragma unroll
        for (int ai = 0; ai < 2; ++ai)
#pragma unroll
            for (int m = 0; m < 4; ++m) {
                const int row = u.pm * 256 + ai * 128 + wr * 64 + m * 16 + fr;
#pragma unroll
                for (int bj = 0; bj < 2; ++bj)
#pragma unroll
                    for (int n = 0; n < 2; ++n) { const int col = u.pn * 256 + bj * 128 + wc * 32 + n * 16 + 4 * fq; *(f32x4*)(C + (size_t)row * 1024 + col) = acc[ai][bj][m][n]; }
                EPI_FENCE();
            }
    }
};
struct EpiPle {
    const float* ss; const float* PR; float* X; bf16_t* xb; float* sso;
    __device__ __forceinline__ void operator()(Acc& acc, const Unit& u, int wr, int wc, int fr, int fq) const {
        asm volatile("" : "+v"(fr), "+v"(fq));
#pragma unroll
        for (int ai = 0; ai < 2; ++ai)
#pragma unroll
            for (int m = 0; m < 4; ++m) {
                const int row = u.pm * 256 + ai * 128 + wr * 64 + m * 16 + fr; const float rs = rstd16(ss, row); float s = 0.f;
#pragma unroll
                for (int bj = 0; bj < 2; ++bj)
#pragma unroll
                    for (int n = 0; n < 2; ++n) {
                        const int col = u.pn * 256 + bj * 128 + wc * 32 + n * 16 + 4 * fq;
                        const size_t off = (size_t)row * 1024 + col;
                        const f32x4 a = acc[ai][bj][m][n] * rs, pr = *(const f32x4*)(PR + off);
                        f32x4 v = *(const f32x4*)(X + off);
                        v = v + pr * (f32x4){sigmoid1(a[0]), sigmoid1(a[1]), sigmoid1(a[2]), sigmoid1(a[3])};
                        *(f32x4*)(X + off) = v; *(u32x2*)(xb + off) = pack4(v); s += dot4(v);
                    }
                s += __shfl_xor(s, 16); s += __shfl_xor(s, 32); if (fq == 0) unsafeAtomicAdd(sso + row, s);
                EPI_FENCE();
            }
    }
};
struct EpiGU {
    const float* ss; bf16_t* act; const float* cw; const float* cb; float* hg; float* c0; float* u0; const float* state; float* ncs;
    __device__ __forceinline__ void operator()(Acc& acc, const Unit& u, int wr, int wc, int fr, int fq) const {
        asm volatile("" : "+v"(fr), "+v"(fq));
        const int src1 = (fq << 4) | ((fr + 15) & 15), src2 = (fq << 4) | ((fr + 14) & 15);
        const bool samp = u.pm >= 128;
#pragma unroll
        for (int ai = 0; ai < 2; ++ai)
#pragma unroll
            for (int m = 0; m < 4; ++m) {
                const int row = u.pm * 256 + ai * 128 + wr * 64 + m * 16 + fr; const float rs = rstd16(ss, row);
#pragma unroll
                for (int bj = 0; bj < 2; ++bj)
#pragma unroll
                    for (int n = 0; n < 2; ++n) acc[ai][bj][m][n] = acc[ai][bj][m][n] * rs;
            }
#pragma unroll
        for (int n = 0; n < 2; ++n) {
            const int colg = u.pn * 128 + wc * 32 + n * 16 + 4 * fq;
            const f32x4 w0 = *(const f32x4*)(cw + colg), w1 = *(const f32x4*)(cw + DFF + colg), w2 = *(const f32x4*)(cw + 2 * DFF + colg), bb = *(const f32x4*)(cb + colg);
#pragma unroll
            for (int ai = 0; ai < 2; ++ai)
#pragma unroll
                for (int m = 0; m < 4; ++m) {
                    const int row = u.pm * 256 + ai * 128 + wr * 64 + m * 16 + fr;
                    const f32x4 g = acc[ai][0][m][n], gp = (m > 0) ? acc[ai][0][m > 0 ? m - 1 : 0][n] : g;
                    const f32x4 t1 = (fr == 15) ? gp : g, t2 = (fr >= 14) ? gp : g;
                    f32x4 g1 = shfl4(t1, src1), g2 = shfl4(t2, src2);
                    if (samp) {
                        const int t = fr & 3, b = (row - MP) >> 2;
                        if (t == 0) { g1 = *(const f32x4*)(state + (size_t)(b * 2 + 1) * DFF + colg); g2 = *(const f32x4*)(state + (size_t)(b * 2) * DFF + colg); }
                        else if (t == 1) { g2 = *(const f32x4*)(state + (size_t)(b * 2 + 1) * DFF + colg); }
                        else { *(f32x4*)(ncs + (size_t)(b * 2 + t - 2) * DFF + colg) = g; }
                    }
                    const f32x4 conv = bb + w0 * g2 + w1 * g1 + w2 * g;
                    const f32x4 up = acc[ai][1][m][n];
                    *(u32x2*)(act + (size_t)row * DFF + colg) = pack4(gelu4(conv) * up);
                    if (!samp) {
                        if (m == 0 && fr < 2) { const int gj = (row >> 6) * 2 + fr; f32x4 c = bb + w2 * g; if (fr == 1) c = c + w1 * g1;
                            *(f32x4*)(c0 + (size_t)gj * DFF + colg) = c; *(f32x4*)(u0 + (size_t)gj * DFF + colg) = up; }
                        if (m == 3 && fr >= 14) { const int gj = (row >> 6) * 2 + (fr - 14); *(f32x4*)(hg + (size_t)gj * DFF + colg) = g; }
                    }
                    EPI_FENCE();
                }
        }
    }
};
struct EpiQKV {
    const float* ss; const float* rope; bf16_t* Q; bf16_t* KB; bf16_t* VB; float* out;
    __device__ __forceinline__ void operator()(Acc& acc, const Unit& u, int wr, int wc, int fr, int fq) const {
        asm volatile("" : "+v"(fr), "+v"(fq));
#pragma unroll
        for (int ai = 0; ai < 2; ++ai)
#pragma unroll
            for (int m = 0; m < 4; ++m) {
                const int row = u.pm * 256 + ai * 128 + wr * 64 + m * 16 + fr; const float rs = rstd16(ss, row);
                const int posidx = row < MP ? (row & (SEQ - 1)) : SEQ + (row & 3);
                const f32x4 cs = *(const f32x4*)(rope + (size_t)posidx * 16 + 4 * (fq & 1)), sn = *(const f32x4*)(rope + (size_t)posidx * 16 + 8 + 4 * (fq & 1));
#pragma unroll
                for (int bj = 0; bj < 2; ++bj)
#pragma unroll
                    for (int n = 0; n < 2; ++n) {
                        f32x4 v = acc[ai][bj][m][n] * rs;
                        const int cu = bj * 128 + wc * 32 + n * 16 + 4 * fq;
                        const bool isV = (u.pn == 4) && (bj == 1);
                        if (n == 0 && (wc & 1) == 0 && !isV) {
                            const f32x4 pt = (f32x4){__shfl_xor(v[0], 32), __shfl_xor(v[1], 32), __shfl_xor(v[2], 32), __shfl_xor(v[3], 32)};
                            v = (fq < 2) ? (v * cs - pt * sn) : (v * cs + pt * sn);
                        }
                        if (u.pn < 4) { v = v * 0.125f; *(u32x2*)(Q + (size_t)row * 1024 + u.pn * 256 + cu) = pack4(v); }
                        else {
                            const int c2 = cu & 127; bf16_t* dst = bj == 0 ? KB : VB;
                            *(u32x2*)(dst + (size_t)row * KVD + c2) = pack4(v);
                            if (row >= MP) *(f32x4*)(out + (bj == 0 ? O_KS : O_VS) + (size_t)(row - MP) * KVD + c2) = v;
                            else if ((row & (SEQ - 1)) >= SEQ - 128) *(f32x4*)(out + (bj == 0 ? O_NKP : O_NVP) + (size_t)((row >> 13) * 128 + (row & (SEQ - 1)) - (SEQ - 128)) * KVD + c2) = v;
                        }
                    }
                EPI_FENCE();
            }
    }
};

struct Params {
    const float *x_prompt, *x_sample, *state, *cache_k, *cache_v, *p_prompt, *p_sample, *norm_mix, *gm_w_in, *gm_v_norm, *gm_w_s, *gm_b_s, *gm_w_out, *kv_norm, *w_kv, *w_q, *sinks, *w_o,
        *norm_ffn, *w_gate, *w_up, *conv_w, *conv_b, *w_down, *ple_norm, *ple_w_gate, *ple_w_proj, *final_norm;
    float* out; unsigned char* ws;
};

__device__ __forceinline__ void tr_item(const float* W, int K, int N, bf16_t* WT, const float* scale, int mode, int row_off, LAS float* scr, int item, int lane) {
    const int nblk = N / 32, kb = item / nblk, nb = item % nblk, k0 = 64 * kb, n0 = 32 * nb;
#pragma unroll 8
    for (int i = 0; i < 32; ++i) { const int kk = 2 * i + (lane >> 5); float w = W[(size_t)(k0 + kk) * N + n0 + (lane & 31)]; if (scale) w *= scale[k0 + kk]; scr[kk * 33 + (lane & 31)] = w; }
    asm volatile("s_waitcnt lgkmcnt(0)" ::: "memory");
    const int c = lane & 7;
    const int drow0 = mode == 0 ? row_off + n0 : ((n0 >> 7) * 256 + (mode == 2 ? 128 : 0) + (n0 & 127));
#pragma unroll
    for (int j = 0; j < 4; ++j) { const int n = (lane >> 3) + 8 * j; const LAS float* s = scr + (8 * c) * 33 + n;
        u32x4 o; o.x = cvt_pk_bf16(s[0 * 33], s[1 * 33]); o.y = cvt_pk_bf16(s[2 * 33], s[3 * 33]); o.z = cvt_pk_bf16(s[4 * 33], s[5 * 33]); o.w = cvt_pk_bf16(s[6 * 33], s[7 * 33]);
        *(u32x4*)(WT + (size_t)(drow0 + n) * K + k0 + 8 * c) = o; }
    asm volatile("s_waitcnt lgkmcnt(0)" ::: "memory");
}

__device__ __forceinline__ void prologue(const Params& P, LAS unsigned char* lds, int G, int wave0) {
    const int tid = opaque_tid(wave0), lane = tid & 63, wave = tid >> 6;
    unsigned char* ws = P.ws;
    LAS float* scr = (LAS float*)(lds + wave * 16384);
    const int gw = blockIdx.x * 8 + wave, NGW = G * 8;
    constexpr int NITEMS = 2048 + 1024 + 4 * 1408 + 2 * 1408 + 2 * 512 + 2 * 128 + 512 + 128 + 512;
    for (int it = gw; it < NITEMS; it += NGW) {
        int r = it;
#define TRJ(cnt, ...) if (r < (cnt)) { tr_item(__VA_ARGS__, scr, r, lane); continue; } r -= (cnt);
        TRJ(2048, P.gm_w_in, 1024, 4096, (bf16_t*)(ws + WS_WIN), P.norm_mix, 0, 0)
        TRJ(1024, P.gm_w_out, 2048, 1024, (bf16_t*)(ws + WS_WOUT), nullptr, 0, 0)
        TRJ(1408, P.w_gate, 1024, DFF, (bf16_t*)(ws + WS_WGU0), P.norm_ffn, 1, 0)
        TRJ(1408, P.w_up, 1024, DFF, (bf16_t*)(ws + WS_WGU0), P.norm_ffn, 2, 0)
        TRJ(1408, P.w_gate + (size_t)1024 * DFF, 1024, DFF, (bf16_t*)(ws + WS_WGU0 + 11 * MiB), P.norm_ffn + 1024, 1, 0)
        TRJ(1408, P.w_up + (size_t)1024 * DFF, 1024, DFF, (bf16_t*)(ws + WS_WGU0 + 11 * MiB), P.norm_ffn + 1024, 2, 0)
        TRJ(1408, P.w_down, DFF, 1024, (bf16_t*)(ws + WS_WD0), nullptr, 0, 0)
        TRJ(1408, P.w_down + (size_t)DFF * 1024, DFF, 1024, (bf16_t*)(ws + WS_WD0 + 5632 * 1024), nullptr, 0, 0)
        TRJ(512, P.ple_w_gate, 1024, 1024, (bf16_t*)(ws + WS_WPG0), P.ple_norm, 0, 0)
        TRJ(512, P.ple_w_gate + 1024 * 1024, 1024, 1024, (bf16_t*)(ws + WS_WPG0 + 2 * MiB), P.ple_norm + 1024, 0, 0)
        TRJ(128, P.ple_w_proj, 256, 1024, (bf16_t*)(ws + WS_WPP0), nullptr, 0, 0)
        TRJ(128, P.ple_w_proj + 256 * 1024, 256, 1024, (bf16_t*)(ws + WS_WPP0 + 512 * 1024), nullptr, 0, 0)
        TRJ(512, P.w_q, 1024, 1024, (bf16_t*)(ws + WS_WQKV), P.norm_mix + 1024, 0, 0)
        TRJ(128, P.w_kv, 1024, 256, (bf16_t*)(ws + WS_WQKV), P.kv_norm, 0, 1024)
        TRJ(512, P.w_o, 1024, 1024, (bf16_t*)(ws + WS_WO), nullptr, 0, 0)
#undef TRJ
    }
    float* X = P.out; bf16_t* XBA = (bf16_t*)(ws + WS_XBA); float* SSA = (float*)(ws + WS_SSA);
    for (int m = gw; m < MT; m += NGW) {
        const float* src = m < MP ? P.x_prompt + (size_t)m * DM : P.x_sample + (size_t)(m - MP) * DM;
        float s = 0.f;
#pragma unroll
        for (int j = 0; j < 4; ++j) { const f32x4 v = *((const f32x4*)src + lane + 64 * j); s += dot4(v);
            *((f32x4*)(X + (size_t)m * DM) + lane + 64 * j) = v; *((u32x2*)(XBA + (size_t)m * DM) + lane + 64 * j) = pack4(v); }
        s = wave_sum(s);
        if (lane == 0) { SSA[m] = s; ((float*)(ws + WS_SSB))[m] = 0.f; ((float*)(ws + WS_VSS))[m] = 0.f; }
    }
    bf16_t* PB = (bf16_t*)(ws + WS_PB);
    for (int m = gw; m < 2 * MT; m += NGW) {
        const int L = m / MT, r = m % MT;
        const float* src = r < MP ? P.p_prompt + ((size_t)L * MP + r) * PLE : P.p_sample + ((size_t)L * MS + (r - MP)) * PLE;
        const f32x4 v = *((const f32x4*)src + lane);
        *((u32x2*)(PB + (size_t)m * PLE) + lane) = pack4(v);
    }
    const int gt = blockIdx.x * 512 + tid, NGT = G * 512;
    bf16_t* WT = (bf16_t*)(ws + WS_WTRIL);
    for (int i = gt; i < 8 * 128 * 128 / 2; i += NGT) { const int e = 2 * i, s = e & 127, t = (e >> 7) & 127;
        const float a = s <= t ? P.gm_w_s[e] : 0.f, b = (s + 1) <= t ? P.gm_w_s[e + 1] : 0.f; ((unsigned*)WT)[i] = cvt_pk_bf16(a, b); }
    float* rope = (float*)(ws + WS_ROPE);
    for (int i = gt; i < 8196 * 8; i += NGT) { const int pi = i >> 3, f = i & 7; const int pos = pi < SEQ ? pi : 16384 + (pi - SEQ);
        const float inv = __builtin_powf(500000.0f, -(float)f * 0.125f); const float ang = (float)pos * inv;
        double rev = (double)ang * 0.15915494309189535; rev -= __builtin_rint(rev); const float rf = (float)rev;
        rope[pi * 16 + f] = __builtin_amdgcn_cosf(rf); rope[pi * 16 + 8 + f] = __builtin_amdgcn_sinf(rf); }
}

__device__ __forceinline__ void gating_phase(const Params& P, LAS unsigned char* lds, int G, int wave0) {
    const int tid = opaque_tid(wave0), lane = tid & 63, wave = tid >> 6, fr = lane & 15, fq = lane >> 4;
    unsigned char* ws = P.ws;
    bf16_t* Z = (bf16_t*)(ws + WS_Z); const float* VSS = (const float*)(ws + WS_VSS); const bf16_t* WTR = (const bf16_t*)(ws + WS_WTRIL);
    LAS bf16_t* Vs = (LAS bf16_t*)lds;
    LAS float* rsb = (LAS float*)(lds + 128 * 264 * 2);
    for (int unit = blockIdx.x; unit < 2048; unit += G) {
        const int ch = unit >> 3, g = unit & 7, row0 = ch * 128;
        if (tid < 128) rsb[tid] = __builtin_amdgcn_rsqf(VSS[row0 + tid] * (1.0f / 2048.0f) + EPS);
        __syncthreads();
#pragma unroll
        for (int j = 0; j < 8; ++j) { const int idx = tid + 512 * j, r = idx >> 5, c8 = (idx & 31) * 8;
            const u32x4 raw = *(const u32x4*)(Z + (size_t)(row0 + r) * 4096 + 2048 + 256 * g + c8);
            const f32x4 wa = *(const f32x4*)(P.gm_v_norm + 256 * g + c8), wb = *(const f32x4*)(P.gm_v_norm + 256 * g + c8 + 4);
            const float rs = rsb[r];
            u32x4 o;
            o.x = cvt_pk_bf16(bf2f(raw.x & 0xffffu) * rs * wa[0], bf2f(raw.x >> 16) * rs * wa[1]);
            o.y = cvt_pk_bf16(bf2f(raw.y & 0xffffu) * rs * wa[2], bf2f(raw.y >> 16) * rs * wa[3]);
            o.z = cvt_pk_bf16(bf2f(raw.z & 0xffffu) * rs * wb[0], bf2f(raw.z >> 16) * rs * wb[1]);
            o.w = cvt_pk_bf16(bf2f(raw.w & 0xffffu) * rs * wb[2], bf2f(raw.w >> 16) * rs * wb[3]);
            *(LAS u32x4*)(Vs + r * 264 + c8) = o; }
        __syncthreads();
        bf16x8 vf[4][2];
#pragma unroll
        for (int ks = 0; ks < 4; ++ks)
#pragma unroll
            for (int nt = 0; nt < 2; ++nt)
#pragma unroll
                for (int j = 0; j < 8; ++j) vf[ks][nt][j] = (short)Vs[(32 * ks + 8 * fq + j) * 264 + 32 * wave + 16 * nt + fr];
#pragma unroll
        for (int mt = 0; mt < 8; ++mt) {
            f32x4 a2[2] = {(f32x4){0.f, 0.f, 0.f, 0.f}, (f32x4){0.f, 0.f, 0.f, 0.f}};
#pragma unroll
            for (int ks = 0; ks < 4; ++ks) if (32 * ks <= 16 * mt + 15) {
                const bf16x8 wf = *(const bf16x8*)(WTR + (size_t)(g * 128 + 16 * mt + fr) * 128 + 32 * ks + 8 * fq);
#pragma unroll
                for (int nt = 0; nt < 2; ++nt) a2[nt] = __builtin_amdgcn_mfma_f32_16x16x32_bf16(vf[ks][nt], wf, a2[nt], 0, 0, 0);
            }
            const int t = 16 * mt + fr; const float bias = P.gm_b_s[g * 128 + t];
#pragma unroll
            for (int nt = 0; nt < 2; ++nt) { bf16_t* zp = Z + (size_t)(row0 + t) * 4096 + 256 * g + 32 * wave + 16 * nt + 4 * fq;
                const f32x4 uu = unpack4(*(const u32x2*)zp); *(u32x2*)zp = pack4(uu * (a2[nt] + bias)); }
        }
        __syncthreads();
    }
    float* gmv = P.out + O_GMV;
    for (int b = blockIdx.x; b < 128; b += G) {
        const int row0 = MP + 4 * b;
        if (tid < 4) rsb[tid] = __builtin_amdgcn_rsqf(VSS[row0 + tid] * (1.0f / 2048.0f) + EPS);
        __syncthreads();
        const int c = 4 * tid, g = c >> 8;
        const f32x4 vw = *(const f32x4*)(P.gm_v_norm + c);
        f32x4 v[4];
#pragma unroll
        for (int s = 0; s < 4; ++s) { v[s] = unpack4(*(const u32x2*)(Z + (size_t)(row0 + s) * 4096 + 2048 + c)) * rsb[s] * vw; *(f32x4*)(gmv + (size_t)(4 * b + s) * GH + c) = v[s]; }
#pragma unroll
        for (int t = 0; t < 4; ++t) { const float bias = P.gm_b_s[g * 128 + t]; f32x4 mx = (f32x4){bias, bias, bias, bias};
#pragma unroll
            for (int s = 0; s <= t; ++s) mx = mx + v[s] * P.gm_w_s[(g * 128 + t) * 128 + s];
            bf16_t* zp = Z + (size_t)(row0 + t) * 4096 + c; *(u32x2*)zp = pack4(unpack4(*(const u32x2*)zp) * mx); }
        __syncthreads();
    }
}

__device__ __forceinline__ void fixup_phase(const Params& P, int L, int G, int wave0) {
    unsigned char* ws = P.ws;
    const f32x4* HG = (const f32x4*)(ws + WS_HG); const f32x4* C0 = (const f32x4*)(ws + WS_C0); const f32x4* U0 = (const f32x4*)(ws + WS_U0);
    bf16_t* ACT = (bf16_t*)(ws + WS_Z);
    const f32x4* cw = (const f32x4*)(P.conv_w + (size_t)L * 3 * DFF);
    const int gt = blockIdx.x * 512 + opaque_tid(wave0), NGT = G * 512;
    for (int idx = gt; idx < 1024 * 704; idx += NGT) {
        const int gj = idx / 704, c4 = idx % 704, grp = gj >> 1, j = gj & 1, r = 64 * grp + j;
        f32x4 conv = C0[idx]; const f32x4 up = U0[idx];
        if ((grp & 127) != 0) { const f32x4 h0 = HG[(size_t)((grp - 1) * 2) * 704 + c4], h1 = HG[(size_t)((grp - 1) * 2 + 1) * 704 + c4]; const f32x4 w0 = cw[c4], w1 = cw[704 + c4];
            conv = conv + (j == 0 ? (w0 * h0 + w1 * h1) : (w0 * h1)); }
        *(u32x2*)(ACT + (size_t)r * DFF + 4 * c4) = pack4(gelu4(conv) * up);
    }
    for (int i = gt; i < MT; i += NGT) { ((float*)(ws + WS_SSA))[i] = 0.f; ((float*)(ws + WS_SSB))[i] = 0.f; }
    f32x4* ncp = (f32x4*)(P.out + O_NCP + (size_t)L * 4 * 2 * DFF);
    for (int idx = gt; idx < 8 * 704; idx += NGT) { const int bj = idx / 704, c4 = idx % 704, b = bj >> 1, j = bj & 1; ncp[idx] = HG[(size_t)((128 * b + 127) * 2 + j) * 704 + c4]; }
}

__device__ __forceinline__ void attn_phase(const Params& P, LAS unsigned char* lds, int G, int wave0) {
    const int tid = opaque_tid(wave0), lane = tid & 63, wave = tid >> 6, fr = lane & 15, fq = lane >> 4;
    unsigned char* ws = P.ws;
    bf16_t* Q = (bf16_t*)(ws + WS_Z + 195 * MiB); const bf16_t* KB = (const bf16_t*)(ws + WS_KB); const bf16_t* VB = (const bf16_t*)(ws + WS_VB);
    LAS bf16_t* Ks = (LAS bf16_t*)lds;
    LAS bf16_t* VTs = (LAS bf16_t*)(lds + 256 * 72 * 2);
    for (int i = blockIdx.x * 512 + tid; i < MT; i += G * 512) ((float*)(ws + WS_SSB))[i] = 0.f;
    for (int unit = blockIdx.x; unit < 768; unit += G) {
        const bool samp = unit >= 512;
        const int kvh = unit & 1;
        int b, qb;
        if (!samp) { b = unit >> 7; qb = (unit >> 1) & 63; } else { b = (unit - 512) >> 1; qb = 1; }
#pragma unroll
        for (int j = 0; j < 4; ++j) {
            const int idx = tid + 512 * j, r = idx >> 3, c8 = (idx & 7) * 8;
            u32x4 kv = (u32x4){0u, 0u, 0u, 0u}, vv = (u32x4){0u, 0u, 0u, 0u};
            if (!samp) { const int t = 128 * (qb - 1) + r; if (t >= 0) { const size_t go = (size_t)(b * SEQ + t) * KVD + kvh * 64 + c8; kv = *(const u32x4*)(KB + go); vv = *(const u32x4*)(VB + go); } }
            else if (r < 128) { const size_t go = ((size_t)(b * 128 + r) * 2 + kvh) * 64 + c8;
                const f32x4 k0 = *(const f32x4*)(P.cache_k + go), k1 = *(const f32x4*)(P.cache_k + go + 4), v0 = *(const f32x4*)(P.cache_v + go), v1 = *(const f32x4*)(P.cache_v + go + 4);
                kv = (u32x4){cvt_pk_bf16(k0[0], k0[1]), cvt_pk_bf16(k0[2], k0[3]), cvt_pk_bf16(k1[0], k1[1]), cvt_pk_bf16(k1[2], k1[3])};
                vv = (u32x4){cvt_pk_bf16(v0[0], v0[1]), cvt_pk_bf16(v0[2], v0[3]), cvt_pk_bf16(v1[0], v1[1]), cvt_pk_bf16(v1[2], v1[3])}; }
            else if (r < 132) { const size_t go = (size_t)(MP + 4 * b + (r - 128)) * KVD + kvh * 64 + c8; kv = *(const u32x4*)(KB + go); vv = *(const u32x4*)(VB + go); }
            *(LAS u32x4*)(Ks + r * 72 + c8) = kv;
            const int sp = r & 31, kk = (r & ~31) + 8 * ((sp & 15) >> 2) + 4 * (sp >> 4) + (sp & 3);
            LAS bf16_t* vt = VTs + c8 * 264 + kk;
            vt[0 * 264] = (bf16_t)(vv.x & 0xffffu); vt[1 * 264] = (bf16_t)(vv.x >> 16); vt[2 * 264] = (bf16_t)(vv.y & 0xffffu); vt[3 * 264] = (bf16_t)(vv.y >> 16);
            vt[4 * 264] = (bf16_t)(vv.z & 0xffffu); vt[5 * 264] = (bf16_t)(vv.z >> 16); vt[6 * 264] = (bf16_t)(vv.w & 0xffffu); vt[7 * 264] = (bf16_t)(vv.w >> 16);
        }
        __syncthreads();
        const int h = kvh * 8 + wave; const float sink = P.sinks[h];
        const int nrt = samp ? 1 : 8;
        for (int rt = 0; rt < nrt; ++rt) {
            const int rowq = samp ? (MP + 4 * b + (fr & 3)) : (b * SEQ + qb * 128 + rt * 16 + fr);
            const int qi = samp ? fr : 16 * rt + fr;
            const int kt0 = samp ? 0 : (rt & ~1);
            bf16x8 qf[2];
#pragma unroll
            for (int k = 0; k < 2; ++k) qf[k] = *(const bf16x8*)(Q + (size_t)rowq * 1024 + h * 64 + 32 * k + 8 * fq);
            f32x4 S[10];
#pragma unroll
            for (int i = 0; i < 10; ++i) { f32x4 a = (f32x4){0.f, 0.f, 0.f, 0.f};
#pragma unroll
                for (int k = 0; k < 2; ++k) { const bf16x8 kf = *(const LAS bf16x8*)(Ks + (16 * (kt0 + i) + fr) * 72 + 32 * k + 8 * fq); a = __builtin_amdgcn_mfma_f32_16x16x32_bf16(kf, qf[k], a, 0, 0, 0); }
                S[i] = a; }
            float mx = sink;
#pragma unroll
            for (int i = 0; i < 10; ++i)
#pragma unroll
                for (int j = 0; j < 4; ++j) { const int kw = 16 * (kt0 + i) + 4 * fq + j;
                    const bool vis = (kw > qi) && (kw <= qi + 128) && (samp ? (kw < 132) : (qb > 0 || kw >= 128));
                    const float sv = vis ? S[i][j] : -1e30f; S[i][j] = sv; mx = fmaxf(mx, sv); }
            mx = fmaxf(mx, __shfl_xor(mx, 16)); mx = fmaxf(mx, __shfl_xor(mx, 32));
            float sum = 0.f;
#pragma unroll
            for (int i = 0; i < 10; ++i)
#pragma unroll
                for (int j = 0; j < 4; ++j) { const float e = __builtin_amdgcn_exp2f((S[i][j] - mx) * LOG2E); S[i][j] = e; sum += e; }
            sum += __shfl_xor(sum, 16); sum += __shfl_xor(sum, 32);
            const float inv = 1.0f / (sum + __builtin_amdgcn_exp2f((sink - mx) * LOG2E));
            f32x4 o[4] = {(f32x4){0.f, 0.f, 0.f, 0.f}, (f32x4){0.f, 0.f, 0.f, 0.f}, (f32x4){0.f, 0.f, 0.f, 0.f}, (f32x4){0.f, 0.f, 0.f, 0.f}};
#pragma unroll
            for (int i = 0; i < 5; ++i) {
                const f32x4 p0 = S[2 * i] * inv, p1 = S[2 * i + 1] * inv;
                const u32x4 pw = (u32x4){cvt_pk_bf16(p0[0], p0[1]), cvt_pk_bf16(p0[2], p0[3]), cvt_pk_bf16(p1[0], p1[1]), cvt_pk_bf16(p1[2], p1[3])};
                const bf16x8 pf = __builtin_bit_cast(bf16x8, pw);
#pragma unroll
                for (int dt = 0; dt < 4; ++dt) { const bf16x8 vfr = *(const LAS bf16x8*)(VTs + (16 * dt + fr) * 264 + 32 * ((kt0 >> 1) + i) + 8 * fq); o[dt] = __builtin_amdgcn_mfma_f32_16x16x32_bf16(vfr, pf, o[dt], 0, 0, 0); }
            }
            if (!samp || fr < 4) {
#pragma unroll
                for (int dt = 0; dt < 4; ++dt) *(u32x2*)(Q + (size_t)rowq * 1024 + h * 64 + 16 * dt + 4 * fq) = pack4(o[dt]);
            }
        }
        __syncthreads();
    }
}

__device__ __forceinline__ void final_phase(const Params& P, int G, int wave0) {
    const int tid = opaque_tid(wave0), lane = tid & 63, wave = tid >> 6;
    const float* SSB = (const float*)(P.ws + WS_SSB);
    const int gw = blockIdx.x * 8 + wave, NGW = G * 8;
    f32x4 w[4];
#pragma unroll
    for (int j = 0; j < 4; ++j) w[j] = *((const f32x4*)P.final_norm + lane + 64 * j);
    for (int m = gw; m < MT; m += NGW) {
        const float rs = rstd16(SSB, m);
        f32x4* xr = (f32x4*)(P.out + (size_t)m * DM);
#pragma unroll
        for (int j = 0; j < 4; ++j) xr[lane + 64 * j] = xr[lane + 64 * j] * rs * w[j];
    }
}

constexpr int LDS_BYTES = 147456;
__global__ void __launch_bounds__(512, 2) yoco_fwd(Params P) {
    extern __shared__ __attribute__((aligned(16))) unsigned char lds_raw[];
    LAS unsigned char* lds = (LAS unsigned char*)lds_raw;
    cg::grid_group grid = cg::this_grid();
    constexpr int G = 256;
    const int wave0 = __builtin_amdgcn_readfirstlane((int)threadIdx.x >> 6);
    unsigned char* ws = P.ws;
    float* X = P.out;
    bf16_t* XBA = (bf16_t*)(ws + WS_XBA); bf16_t* Z = (bf16_t*)(ws + WS_Z); bf16_t* XBB = (bf16_t*)(ws + WS_Z + 130 * MiB); bf16_t* QO = (bf16_t*)(ws + WS_Z + 195 * MiB);
    float* PR = (float*)(ws + WS_Z); float* SSA = (float*)(ws + WS_SSA); float* SSB = (float*)(ws + WS_SSB);

#ifndef PHM
#define PHM 0xffff
#endif
    if (PHM & 1) prologue(P, lds, G, wave0);
    grid.sync();
#pragma unroll 1
    for (int L = 0; L < 2; ++L) {
        pg8::StaticOrder S;
        if (L == 0) {
            { pg8::Gemm g{XBA, (const bf16_t*)(ws + WS_WIN), MT, 4096, 1024, 1024}; S.init(MT, 4096, G, blockIdx.x);
              EpiGm E{SSA, Z, (float*)(ws + WS_VSS)}; if (PHM & 2) pg8::gemm_phase<EpiGm>(lds, g, S, E, wave0); }
            grid.sync();
            if (PHM & 4) gating_phase(P, lds, G, wave0);
            grid.sync();
        } else {
            { pg8::Gemm g{XBB, (const bf16_t*)(ws + WS_WQKV), MT, 1280, 1024, 1024}; S.init(MT, 1280, G, blockIdx.x);
              EpiQKV E{SSB, (const float*)(ws + WS_ROPE), QO, (bf16_t*)(ws + WS_KB), (bf16_t*)(ws + WS_VB), P.out}; if (PHM & 8) pg8::gemm_phase<EpiQKV>(lds, g, S, E, wave0); }
            grid.sync();
            if (PHM & 16) attn_phase(P, lds, G, wave0);
            grid.sync();
        }
        { pg8::Gemm g{L == 0 ? Z : QO, (const bf16_t*)(ws + (L == 0 ? WS_WOUT : WS_WO)), MT, 1024, L == 0 ? 2048 : 1024, L == 0 ? 4096 : 1024}; S.init(MT, 1024, G, blockIdx.x);
          EpiRes E{X, XBA, SSB}; if (PHM & 32) pg8::gemm_phase<EpiRes>(lds, g, S, E, wave0); }
        grid.sync();
        { pg8::Gemm g{XBA, (const bf16_t*)(ws + WS_WGU0 + (size_t)L * 11 * MiB), MT, 2 * DFF, 1024, 1024}; S.init(MT, 2 * DFF, G, blockIdx.x);
          EpiGU E{SSB, Z, P.conv_w + (size_t)L * 3 * DFF, P.conv_b + (size_t)L * DFF, (float*)(ws + WS_HG), (float*)(ws + WS_C0), (float*)(ws + WS_U0),
                  P.state + (size_t)L * 128 * 2 * DFF, P.out + O_NCS + (size_t)L * 128 * 2 * DFF};
          if (PHM & 64) pg8::gemm_phase<EpiGU>(lds, g, S, E, wave0); }
        grid.sync();
        if (PHM & 128) fixup_phase(P, L, G, wave0);
        grid.sync();
        { pg8::Gemm g{Z, (const bf16_t*)(ws + WS_WD0 + (size_t)L * 5632 * 1024), MT, 1024, DFF, DFF}; S.init(MT, 1024, G, blockIdx.x);
          EpiRes E{X, XBA, SSA}; if (PHM & 256) pg8::gemm_phase<EpiRes>(lds, g, S, E, wave0); }
        grid.sync();
        { pg8::Gemm g{(const bf16_t*)(ws + WS_PB) + (size_t)L * MT * PLE, (const bf16_t*)(ws + WS_WPP0 + (size_t)L * 512 * 1024), MT, 1024, 256, 256}; S.init(MT, 1024, G, blockIdx.x);
          EpiF32 E{PR}; if (PHM & 512) pg8::gemm_phase<EpiF32>(lds, g, S, E, wave0); }
        { pg8::Gemm g{XBA, (const bf16_t*)(ws + WS_WPG0 + (size_t)L * 2 * MiB), MT, 1024, 1024, 1024}; S.init(MT, 1024, G, blockIdx.x);
          EpiPle E{SSA, PR, X, XBB, SSB}; if (PHM & 1024) pg8::gemm_phase<EpiPle>(lds, g, S, E, wave0); }
        grid.sync();
    }
    if (PHM & 2048) final_phase(P, G, wave0);
}

extern "C" void kernel_launch(void* const* d_in, const int* in_sizes, int n_in, void* d_out, int out_size, void* d_ws, size_t ws_size, hipStream_t stream) {
    static int grid = 0;
    if (grid == 0) {
        if (n_in != 28 || ws_size < WS_END) { fprintf(stderr, "kernel_launch: unexpected n_in %d / ws_size %zu\n", n_in, ws_size); grid = -1; return; }
        int dev = 0, cus = 0, per_cu = 0;
        hipGetDevice(&dev); hipDeviceGetAttribute(&cus, hipDeviceAttributeMultiprocessorCount, dev);
        hipFuncSetAttribute((const void*)yoco_fwd, hipFuncAttributeMaxDynamicSharedMemorySize, LDS_BYTES);
        hipOccupancyMaxActiveBlocksPerMultiprocessor(&per_cu, (const void*)yoco_fwd, 512, LDS_BYTES);
        if (per_cu < 1) { fprintf(stderr, "kernel_launch: occupancy query says %d blocks/CU\n", per_cu); per_cu = 1; }
        (void)hipGetLastError();
        if (cus < 256) { fprintf(stderr, "kernel_launch: needs 256 CUs, device has %d\n", cus); grid = -1; return; }
        grid = 256;
    }
    if (grid < 0) return;
    Params p{};
    const float** pp = (const float**)&p;
    for (int i = 0; i < 28; ++i) pp[i] = (const float*)d_in[i];
    p.out = (float*)d_out; p.ws = (unsigned char*)d_ws;
    void* args[] = {&p};
    hipError_t e = hipLaunchCooperativeKernel((const void*)yoco_fwd, dim3(grid), dim3(512), args, LDS_BYTES, stream);
    if (e != hipSuccess) fprintf(stderr, "cooperative launch failed: %s (grid %d)\n", hipGetErrorString(e), grid);
}
```

```cpp
#include <hip/hip_runtime.h>
#include <hip/hip_cooperative_groups.h>
#include <cstdio>
#include <cstdint>
namespace cg = cooperative_groups;
#ifndef PROBE
#define PROBE 0
#endif

#define LAS __attribute__((address_space(3)))
typedef unsigned short bf16_t;
typedef short bf16x8 __attribute__((ext_vector_type(8)));
typedef float f32x4 __attribute__((ext_vector_type(4)));
typedef float f32x2 __attribute__((ext_vector_type(2)));
typedef unsigned u32x4 __attribute__((ext_vector_type(4)));
typedef unsigned u32x2 __attribute__((ext_vector_type(2)));

constexpr int DM = 1024, SEQ = 8192, MP = 32768, MS = 512, MT = MP + MS;
constexpr int GH = 2048, DFF = 2816, PLE = 256, KVD = 128;
constexpr float EPS = 1e-6f;
constexpr float LOG2E = 1.4426950408889634f;

constexpr size_t MiB = 1u << 20;
constexpr size_t WS_ROPE = 1 * MiB;
constexpr size_t WS_WTRIL = 2 * MiB;
constexpr size_t WS_SSA = 3 * MiB;
constexpr size_t WS_SSB = 6 * MiB;
constexpr size_t WS_VSS = 9 * MiB;
constexpr size_t WS_HG = 14 * MiB;
constexpr size_t WS_C0 = 25 * MiB;
constexpr size_t WS_U0 = 36 * MiB;
constexpr size_t WS_KB = 47 * MiB;
constexpr size_t WS_VB = 56 * MiB;
constexpr size_t WS_WIN = 66 * MiB;
constexpr size_t WS_WOUT = 74 * MiB;
constexpr size_t WS_WGU0 = 78 * MiB;
constexpr size_t WS_WD0 = 100 * MiB;
constexpr size_t WS_WPG0 = 111 * MiB;
constexpr size_t WS_WPP0 = 115 * MiB;
constexpr size_t WS_WQKV = 116 * MiB;
constexpr size_t WS_WO = 119 * MiB;
constexpr size_t WS_XBA = 121 * MiB;
constexpr size_t WS_PB = 186 * MiB;
constexpr size_t WS_Z = 219 * MiB;
constexpr size_t WS_END = 479 * MiB;

constexpr size_t O_Y = 0, O_GMV = 34078720, O_NCP = 35127296, O_NCS = 35172352, O_NKP = 36614144, O_NVP = 36679680, O_KS = 36745216, O_VS = 36810752;

__device__ __forceinline__ unsigned cvt_pk_bf16(float lo, float hi) { unsigned r; asm volatile("v_cvt_pk_bf16_f32 %0, %1, %2" : "=v"(r) : "v"(lo), "v"(hi)); return r; }
__device__ __forceinline__ float bf2f(unsigned h) { return __uint_as_float(h << 16); }
__device__ __forceinline__ u32x2 pack4(f32x4 v) { u32x2 w; w.x = cvt_pk_bf16(v[0], v[1]); w.y = cvt_pk_bf16(v[2], v[3]); return w; }
__device__ __forceinline__ f32x4 unpack4(u32x2 w) { return (f32x4){bf2f(w.x & 0xffffu), bf2f(w.x >> 16), bf2f(w.y & 0xffffu), bf2f(w.y >> 16)}; }
__device__ __forceinline__ float gelu1(float x) {
    const float z = x * (0.7978845608f + 0.0356774081f * x * x);
    const float e = __builtin_amdgcn_exp2f(-2.0f * LOG2E * z);
    return x * __builtin_amdgcn_rcpf(1.0f + e);
}
__device__ __forceinline__ f32x4 gelu4(f32x4 v) { return (f32x4){gelu1(v[0]), gelu1(v[1]), gelu1(v[2]), gelu1(v[3])}; }
__device__ __forceinline__ float sigmoid1(float x) { return __builtin_amdgcn_rcpf(1.0f + __builtin_amdgcn_exp2f(-LOG2E * x)); }
__device__ __forceinline__ float dot4(f32x4 v) { return (v[0] * v[0] + v[1] * v[1]) + (v[2] * v[2] + v[3] * v[3]); }
__device__ __forceinline__ float rstd16(const float* ss, int row) { return __builtin_amdgcn_rsqf(ss[row] * (1.0f / 1024.0f) + EPS); }
#define EPI_FENCE() asm volatile("" ::: "memory")
__device__ __forceinline__ int opaque_tid(int wave0) { int l; asm volatile("v_mbcnt_lo_u32_b32 %0, -1, 0\n\tv_mbcnt_hi_u32_b32 %0, -1, %0" : "=v"(l)); return wave0 * 64 + l; }
__device__ __forceinline__ f32x4 shfl4(f32x4 v, int src) { return (f32x4){__shfl(v[0], src), __shfl(v[1], src), __shfl(v[2], src), __shfl(v[3], src)}; }
__device__ __forceinline__ float wave_sum(float v) {
#pragma unroll
    for (int o = 1; o < 64; o <<= 1) v += __shfl_xor(v, o);
    return v;
}

namespace pg8 {
constexpr int BM = 256, BK = 64, HALF = 128, HTB = HALF * BK * 2, STAGE_BYTES = 8 * HTB, NXCD = 8, WGM = 8;
__host__ __device__ __forceinline__ int lds_byte(int r, int c) { const int st = (r >> 4) * 2 + (c >> 5), rr = r & 15, cc = c & 31, ob = rr * 64 + cc * 2; return st * 1024 + (ob ^ (((ob >> 9) & 1) << 5)); }
__host__ __device__ __forceinline__ void stage_rc(int b, int& R, int& C) { const int st = b / 1024, sb = b % 1024, swz = sb ^ (((sb >> 9) & 1) << 5); R = (st >> 1) * 16 + swz / 64; C = (st & 1) * 32 + (swz % 64) / 2; }

struct Unit { int pm, pn; };
struct Gemm { const bf16_t* A; const bf16_t* Bt; int M, N, K, lda; };

struct StaticOrder {
    int nM, nN, nwg, G, c;
    __device__ void init(int M, int N, int G_, int c_) { nM = M / BM; nN = N / BM; nwg = nM * nN; G = G_; c = c_; }
    __device__ bool next(int i, Unit& u) const {
        const long L = (long)i * G + c; if (L >= nwg) return false;
        int wgid = (int)L; { const int q = nwg / NXCD, r = nwg % NXCD, xcd = wgid % NXCD, off = wgid / NXCD; wgid = (xcd < r ? xcd * (q + 1) : r * (q + 1) + (xcd - r) * q) + off; }
        const int nig = WGM * nN, gid = wgid / nig, fm = gid * WGM, gsz = (nM - fm) < WGM ? (nM - fm) : WGM;
        u.pm = fm + ((wgid % nig) % gsz); u.pn = (wgid % nig) / gsz; return true;
    }
};

template <class Epi, bool ALIGN_EPI = true, bool SP2 = true>
__device__ __forceinline__ void gemm_phase(LAS unsigned char* lds, const Gemm g, const StaticOrder& S_in, const Epi& E, int wave0) {
    StaticOrder S = S_in; asm volatile("" : "+s"(S.c));
    const int tid = opaque_tid(wave0), wid = __builtin_amdgcn_readfirstlane(tid >> 6), lane = tid & 63, wr = wid >> 2, wc = wid & 3, fr = lane & 15, fq = lane >> 4;
    const int K = g.K, nt = K / BK;
    unsigned voffA[2], voffB[2];
#pragma unroll
    for (int i = 0; i < 2; ++i) { int R, C; stage_rc(tid * 16 + i * 8192, R, C);
        voffA[i] = (unsigned)(R * g.lda + C) * 2u; voffB[i] = (unsigned)(R * K + C) * 2u; }
    const size_t kstep = (size_t)(BK * 2);
    const size_t hstepA = (size_t)HALF * g.lda * 2, hstepB = (size_t)HALF * K * 2;
    const size_t tstepA = 2 * hstepA, tstepB = 2 * hstepB;
    const unsigned ldsw = (unsigned)wid * 1024u;
    const int aoff = lds_byte(wr * 64 + fr, fq * 8), boff = lds_byte(wc * 32 + fr, fq * 8);
#define PG8_SA(b, h) (((b) * 2 + (h)) * HTB)
#define PG8_SB(b, h) ((4 + (b) * 2 + (h)) * HTB)
#define PG8_STAGE(bufoff, gbase, voff) do { _Pragma("unroll") for (int _i = 0; _i < 2; ++_i) \
        __builtin_amdgcn_global_load_lds((const unsigned*)((const char*)(gbase) + (voff)[_i]), (LAS unsigned*)(lds + (bufoff) + ldsw + _i * 8192), 16, 0, 0); } while (0)
#define PG8_LDA(dst, b, h) do { _Pragma("unroll") for (int m = 0; m < 4; ++m) _Pragma("unroll") for (int k = 0; k < 2; ++k) dst[m][k] = *(const LAS bf16x8*)(lds + PG8_SA(b, h) + aoff + m * 2048 + k * 1024); } while (0)
#define PG8_LDB(dst, b, h) do { _Pragma("unroll") for (int n = 0; n < 2; ++n) _Pragma("unroll") for (int k = 0; k < 2; ++k) dst[n][k] = *(const LAS bf16x8*)(lds + PG8_SB(b, h) + boff + n * 2048 + k * 1024); } while (0)
#define PG8_MMA(ai, bj, At, Bt) do { __builtin_amdgcn_s_setprio(1); _Pragma("unroll") for (int m = 0; m < 4; ++m) _Pragma("unroll") for (int n = 0; n < 2; ++n) _Pragma("unroll") for (int k = 0; k < 2; ++k) \
        acc[ai][bj][m][n] = __builtin_amdgcn_mfma_f32_16x16x32_bf16(Bt[n][k], At[m][k], acc[ai][bj][m][n], 0, 0, 0); __builtin_amdgcn_s_setprio(0); } while (0)
#define PG8_WAIT_V(n) asm volatile("s_waitcnt vmcnt(" #n ")" ::: "memory")
#define PG8_WAIT_L(n) asm volatile("s_waitcnt lgkmcnt(" #n ")" ::: "memory")
#define PG8_BAR __builtin_amdgcn_s_barrier()
#define PG8_SCHED __builtin_amdgcn_sched_barrier(0)
    Unit cur, nxt; int ui = 0;
    if (!S.next(0, cur)) return;
    f32x4 acc[2][2][4][2];
#pragma unroll
    for (int a = 0; a < 2; ++a)
#pragma unroll
        for (int b = 0; b < 2; ++b)
#pragma unroll
            for (int m = 0; m < 4; ++m)
#pragma unroll
                for (int n = 0; n < 2; ++n) acc[a][b][m][n] = (f32x4){0.f, 0.f, 0.f, 0.f};
    bf16x8 At[4][2], B0[2][2], B1[2][2];
    const char* cA = (const char*)g.A + (size_t)cur.pm * tstepA; const char* cB = (const char*)g.Bt + (size_t)cur.pn * tstepB;
    if constexpr (SP2) {
        PG8_STAGE(PG8_SB(0, 0), cB, voffB); PG8_STAGE(PG8_SB(0, 1), cB + hstepB, voffB); PG8_STAGE(PG8_SA(0, 0), cA, voffA); PG8_STAGE(PG8_SA(0, 1), cA + hstepA, voffA);
        if (wr == 1) PG8_BAR;
        PG8_WAIT_V(2); PG8_BAR;
        PG8_STAGE(PG8_SB(1, 0), cB + kstep, voffB); PG8_STAGE(PG8_SA(1, 0), cA + kstep, voffA); PG8_STAGE(PG8_SB(1, 1), cB + hstepB + kstep, voffB);
        PG8_WAIT_V(6); PG8_BAR;
    } else {
        PG8_STAGE(PG8_SB(0, 0), cB, voffB); PG8_STAGE(PG8_SA(0, 0), cA, voffA); PG8_STAGE(PG8_SB(0, 1), cB + hstepB, voffB); PG8_STAGE(PG8_SA(0, 1), cA + hstepA, voffA);
        if (wr == 1) PG8_BAR;
        PG8_WAIT_V(4); PG8_BAR;
        PG8_STAGE(PG8_SB(1, 0), cB + kstep, voffB); PG8_STAGE(PG8_SA(1, 0), cA + kstep, voffA); PG8_STAGE(PG8_SB(1, 1), cB + hstepB + kstep, voffB);
        PG8_WAIT_V(6); PG8_BAR;
    }
    for (;;) {
        const bool has_next = S.next(ui + 1, nxt);
        const char* nA = has_next ? (const char*)g.A + (size_t)nxt.pm * tstepA : cA; const char* nB = has_next ? (const char*)g.Bt + (size_t)nxt.pn * tstepB : cB;
        for (int t = 0; t < nt; t += 2) {
            const bool last = (t == nt - 2);
            const char* a1 = cA + (size_t)(t + 1) * kstep;
            const char* a2 = last ? nA : cA + (size_t)(t + 2) * kstep; const char* b2 = last ? nB : cB + (size_t)(t + 2) * kstep;
            const char* a3 = a2 + kstep; const char* b3 = b2 + kstep;
            if constexpr (SP2) {
            PG8_LDB(B0, 0, 0); PG8_LDB(B1, 0, 1); PG8_SCHED; PG8_LDA(At, 0, 0); PG8_STAGE(PG8_SA(1, 1), a1 + hstepA, voffA);
            PG8_WAIT_V(8); PG8_WAIT_L(0); PG8_BAR; PG8_MMA(0, 0, At, B0); PG8_MMA(0, 1, At, B1); PG8_BAR; PG8_SCHED;
            PG8_LDA(At, 0, 1); PG8_STAGE(PG8_SB(0, 0), b2, voffB); PG8_STAGE(PG8_SB(0, 1), b2 + hstepB, voffB); PG8_STAGE(PG8_SA(0, 0), a2, voffA);
            PG8_WAIT_V(8); PG8_WAIT_L(0); PG8_BAR; PG8_MMA(1, 0, At, B0); PG8_MMA(1, 1, At, B1); PG8_BAR; PG8_SCHED;
            PG8_LDB(B0, 1, 0); PG8_LDB(B1, 1, 1); PG8_SCHED; PG8_LDA(At, 1, 0); PG8_STAGE(PG8_SA(0, 1), a2 + hstepA, voffA);
            PG8_WAIT_V(8); PG8_WAIT_L(0); PG8_BAR; PG8_MMA(0, 0, At, B0); PG8_MMA(0, 1, At, B1); PG8_BAR; PG8_SCHED;
            PG8_LDA(At, 1, 1); PG8_STAGE(PG8_SB(1, 0), b3, voffB); PG8_STAGE(PG8_SB(1, 1), b3 + hstepB, voffB); PG8_STAGE(PG8_SA(1, 0), a3, voffA);
            PG8_WAIT_V(8); PG8_WAIT_L(0); PG8_BAR; PG8_MMA(1, 0, At, B0); PG8_MMA(1, 1, At, B1); PG8_BAR; PG8_SCHED;
            } else {
            PG8_LDB(B0, 0, 0); PG8_SCHED; PG8_LDA(At, 0, 0); PG8_STAGE(PG8_SA(1, 1), a1 + hstepA, voffA);
            PG8_WAIT_L(8); PG8_BAR; PG8_WAIT_L(0); PG8_MMA(0, 0, At, B0); PG8_BAR; PG8_SCHED;
            PG8_LDB(B1, 0, 1); PG8_STAGE(PG8_SB(0, 0), b2, voffB);
            PG8_BAR; PG8_WAIT_L(0); PG8_MMA(0, 1, At, B1); PG8_BAR;
            PG8_LDA(At, 0, 1); PG8_STAGE(PG8_SA(0, 0), a2, voffA);
            PG8_BAR; PG8_WAIT_L(0); PG8_MMA(1, 0, At, B0); PG8_BAR; PG8_SCHED;
            PG8_STAGE(PG8_SB(0, 1), b2 + hstepB, voffB);
            PG8_WAIT_V(6); PG8_BAR; PG8_MMA(1, 1, At, B1); PG8_BAR;
            PG8_LDB(B0, 1, 0); PG8_SCHED; PG8_LDA(At, 1, 0); PG8_STAGE(PG8_SA(0, 1), a2 + hstepA, voffA);
            PG8_WAIT_L(8); PG8_BAR; PG8_WAIT_L(0); PG8_MMA(0, 0, At, B0); PG8_BAR; PG8_SCHED;
            PG8_LDB(B1, 1, 1); PG8_STAGE(PG8_SB(1, 0), b3, voffB);
            PG8_BAR; PG8_WAIT_L(0); PG8_MMA(0, 1, At, B1); PG8_BAR;
            PG8_LDA(At, 1, 1); PG8_STAGE(PG8_SA(1, 0), a3, voffA);
            PG8_BAR; PG8_WAIT_L(0); PG8_MMA(1, 0, At, B0); PG8_BAR; PG8_SCHED;
            PG8_STAGE(PG8_SB(1, 1), b3 + hstepB, voffB);
            PG8_WAIT_V(6); PG8_BAR; PG8_MMA(1, 1, At, B1); PG8_BAR;
            }
        }
        if constexpr (ALIGN_EPI) { if (wr == 0) PG8_BAR; }
        E(acc, cur, wr, wc, fr, fq);
        if (!has_next) break;
#pragma unroll
        for (int a = 0; a < 2; ++a)
#pragma unroll
            for (int b = 0; b < 2; ++b)
#pragma unroll
                for (int m = 0; m < 4; ++m)
#pragma unroll
                    for (int n = 0; n < 2; ++n) acc[a][b][m][n] = (f32x4){0.f, 0.f, 0.f, 0.f};
        cur = nxt; cA = nA; cB = nB; ++ui;
        if constexpr (ALIGN_EPI) { if (wr == 1) PG8_BAR; }
    }
    PG8_WAIT_V(0);
    if constexpr (!ALIGN_EPI) { if (wr == 0) PG8_BAR; }
    PG8_BAR;
#undef PG8_SA
#undef PG8_SB
#undef PG8_STAGE
#undef PG8_LDA
#undef PG8_LDB
#undef PG8_MMA
#undef PG8_WAIT_V
#undef PG8_WAIT_L
#undef PG8_BAR
#undef PG8_SCHED
}
}
using pg8::Unit;
typedef f32x4 Acc[2][2][4][2];

struct EpiGm {
    const float* ss; bf16_t* Z; float* vss;
    __device__ __forceinline__ void operator()(Acc& acc, const Unit& u, int wr, int wc, int fr, int fq) const {
        asm volatile("" : "+v"(fr), "+v"(fq));
#pragma unroll
        for (int ai = 0; ai < 2; ++ai)
#pragma unroll
            for (int m = 0; m < 4; ++m) {
                const int row = u.pm * 256 + ai * 128 + wr * 64 + m * 16 + fr;
                const float rs = rstd16(ss, row); float s = 0.f;
#pragma unroll
                for (int bj = 0; bj < 2; ++bj)
#pragma unroll
                    for (int n = 0; n < 2; ++n) {
                        const int col = u.pn * 256 + bj * 128 + wc * 32 + n * 16 + 4 * fq;
                        const f32x4 v = gelu4(acc[ai][bj][m][n] * rs);
                        *(u32x2*)(Z + (size_t)row * 4096 + col) = pack4(v);
                        s += dot4(v);
                    }
                if (u.pn >= 8) { s += __shfl_xor(s, 16); s += __shfl_xor(s, 32); if (fq == 0) unsafeAtomicAdd(vss + row, s); }
                EPI_FENCE();
            }
    }
};
struct EpiRes {
    float* X; bf16_t* xb; float* sso;
    __device__ __forceinline__ void operator()(Acc& acc, const Unit& u, int wr, int wc, int fr, int fq) const {
        asm volatile("" : "+v"(fr), "+v"(fq));
#pragma unroll
        for (int ai = 0; ai < 2; ++ai)
#pragma unroll
            for (int m = 0; m < 4; ++m) {
                const int row = u.pm * 256 + ai * 128 + wr * 64 + m * 16 + fr; float s = 0.f;
#pragma unroll
                for (int bj = 0; bj < 2; ++bj)
#pragma unroll
                    for (int n = 0; n < 2; ++n) {
                        const int col = u.pn * 256 + bj * 128 + wc * 32 + n * 16 + 4 * fq;
                        float* xp = X + (size_t)row * 1024 + col;
                        const f32x4 v = *(const f32x4*)xp + acc[ai][bj][m][n];
                        *(f32x4*)xp = v; *(u32x2*)(xb + (size_t)row * 1024 + col) = pack4(v); s += dot4(v);
                    }
                s += __shfl_xor(s, 16); s += __shfl_xor(s, 32); if (fq == 0) unsafeAtomicAdd(sso + row, s);
                EPI_FENCE();
            }
    }
};
struct EpiF32 {
    float* C;
    __device__ __forceinline__ void operator()(Acc& acc, const Unit& u, int wr, int wc, int fr, int fq) const {
        asm volatile("" : "+v"(fr), "+v"(fq));
#pragma unroll
        for (int ai = 0; ai < 2; ++ai)
#pragma unroll
            for (int m = 0; m < 4; ++m) {
                const int row = u.pm * 256 + ai * 128 + wr * 64 + m * 16 + fr;
#pragma unroll
                for (int bj = 0; bj < 2; ++bj)
#pragma unroll
                    for (int n = 0; n < 2; ++n) { const int col = u.pn * 256 + bj * 128 + wc * 32 + n * 16 + 4 * fq; *(f32x4*)(C + (size_t)row * 1024 + col) = acc[ai][bj][m][n]; }
                EPI_FENCE();
            }
    }
};
struct EpiPle {
    const float* ss; const float* PR; float* X; bf16_t* xb; float* sso;
    __device__ __forceinline__ void operator()(Acc& acc, const Unit& u, int wr, int wc, int fr, int fq) const {
        asm volatile("" : "+v"(fr), "+v"(fq));
#pragma unroll
        for (int ai = 0; ai < 2; ++ai)
#pragma unroll
            for (int m = 0; m < 4; ++m) {
                const int row = u.pm * 256 + ai * 128 + wr * 64 + m * 16 + fr; const float rs = rstd16(ss, row); float s = 0.f;
#pragma unroll
                for (int bj = 0; bj < 2; ++bj)
#pragma unroll
                    for (int n = 0; n < 2; ++n) {
                        const int col = u.pn * 256 + bj * 128 + wc * 32 + n * 16 + 4 * fq;
                        const size_t off = (size_t)row * 1024 + col;
                        const f32x4 a = acc[ai][bj][m][n] * rs, pr = *(const f32x4*)(PR + off);
                        f32x4 v = *(const f32x4*)(X + off);
                        v = v + pr * (f32x4){sigmoid1(a[0]), sigmoid1(a[1]), sigmoid1(a[2]), sigmoid1(a[3])};
                        *(f32x4*)(X + off) = v; *(u32x2*)(xb + off) = pack4(v); s += dot4(v);
                    }
                s += __shfl_xor(s, 16); s += __shfl_xor(s, 32); if (fq == 0) unsafeAtomicAdd(sso + row, s);
                EPI_FENCE();
            }
    }
};
struct EpiGU {
    const float* ss; bf16_t* act; const float* cw; const float* cb; float* hg; float* c0; float* u0; const float* state; float* ncs;
    __device__ __forceinline__ void operator()(Acc& acc, const Unit& u, int wr, int wc, int fr, int fq) const {
        asm volatile("" : "+v"(fr), "+v"(fq));
        const int src1 = (fq << 4) | ((fr + 15) & 15), src2 = (fq << 4) | ((fr + 14) & 15);
        const bool samp = u.pm >= 128;
#pragma unroll
        for (int ai = 0; ai < 2; ++ai)
#pragma unroll
            for (int m = 0; m < 4; ++m) {
                const int row = u.pm * 256 + ai * 128 + wr * 64 + m * 16 + fr; const float rs = rstd16(ss, row);
#pragma unroll
                for (int bj = 0; bj < 2; ++bj)
#pragma unroll
                    for (int n = 0; n < 2; ++n) acc[ai][bj][m][n] = acc[ai][bj][m][n] * rs;
            }
#pragma unroll
        for (int n = 0; n < 2; ++n) {
            const int colg = u.pn * 128 + wc * 32 + n * 16 + 4 * fq;
            const f32x4 w0 = *(const f32x4*)(cw + colg), w1 = *(const f32x4*)(cw + DFF + colg), w2 = *(const f32x4*)(cw + 2 * DFF + colg), bb = *(const f32x4*)(cb + colg);
#pragma unroll
            for (int ai = 0; ai < 2; ++ai)
#pragma unroll
                for (int m = 0; m < 4; ++m) {
                    const int row = u.pm * 256 + ai * 128 + wr * 64 + m * 16 + fr;
                    const f32x4 g = acc[ai][0][m][n], gp = (m > 0) ? acc[ai][0][m > 0 ? m - 1 : 0][n] : g;
                    const f32x4 t1 = (fr == 15) ? gp : g, t2 = (fr >= 14) ? gp : g;
                    f32x4 g1 = shfl4(t1, src1), g2 = shfl4(t2, src2);
                    if (samp) {
                        const int t = fr & 3, b = (row - MP) >> 2;
                        if (t == 0) { g1 = *(const f32x4*)(state + (size_t)(b * 2 + 1) * DFF + colg); g2 = *(const f32x4*)(state + (size_t)(b * 2) * DFF + colg); }
                        else if (t == 1) { g2 = *(const f32x4*)(state + (size_t)(b * 2 + 1) * DFF + colg); }
                        else { *(f32x4*)(ncs + (size_t)(b * 2 + t - 2) * DFF + colg) = g; }
                    }
                    const f32x4 conv = bb + w0 * g2 + w1 * g1 + w2 * g;
                    const f32x4 up = acc[ai][1][m][n];
                    *(u32x2*)(act + (size_t)row * DFF + colg) = pack4(gelu4(conv) * up);
                    if (!samp) {
                        if (m == 0 && fr < 2) { const int gj = (row >> 6) * 2 + fr; f32x4 c = bb + w2 * g; if (fr == 1) c = c + w1 * g1;
                            *(f32x4*)(c0 + (size_t)gj * DFF + colg) = c; *(f32x4*)(u0 + (size_t)gj * DFF + colg) = up; }
                        if (m == 3 && fr >= 14) { const int gj = (row >> 6) * 2 + (fr - 14); *(f32x4*)(hg + (size_t)gj * DFF + colg) = g; }
                    }
                    EPI_FENCE();
                }
        }
    }
};
struct EpiQKV {
    const float* ss; const float* rope; bf16_t* Q; bf16_t* KB; bf16_t* VB; float* out;
    __device__ __forceinline__ void operator()(Acc& acc, const Unit& u, int wr, int wc, int fr, int fq) const {
        asm volatile("" : "+v"(fr), "+v"(fq));
#pragma unroll
        for (int ai = 0; ai < 2; ++ai)
#pragma unroll
            for (int m = 0; m < 4; ++m) {
                const int row = u.pm * 256 + ai * 128 + wr * 64 + m * 16 + fr; const float rs = rstd16(ss, row);
                const int posidx = row < MP ? (row & (SEQ - 1)) : SEQ + (row & 3);
                const f32x4 cs = *(const f32x4*)(rope + (size_t)posidx * 16 + 4 * (fq & 1)), sn = *(const f32x4*)(rope + (size_t)posidx * 16 + 8 + 4 * (fq & 1));
#pragma unroll
                for (int bj = 0; bj < 2; ++bj)
#pragma unroll
                    for (int n = 0; n < 2; ++n) {
                        f32x4 v = acc[ai][bj][m][n] * rs;
                        const int cu = bj * 128 + wc * 32 + n * 16 + 4 * fq;
                        const bool isV = (u.pn == 4) && (bj == 1);
                        if (n == 0 && (wc & 1) == 0 && !isV) {
                            const f32x4 pt = (f32x4){__shfl_xor(v[0], 32), __shfl_xor(v[1], 32), __shfl_xor(v[2], 32), __shfl_xor(v[3], 32)};
                            v = (fq < 2) ? (v * cs - pt * sn) : (v * cs + pt * sn);
                        }
                        if (u.pn < 4) { v = v * 0.125f; *(u32x2*)(Q + (size_t)row * 1024 + u.pn * 256 + cu) = pack4(v); }
                        else {
                            const int c2 = cu & 127; bf16_t* dst = bj == 0 ? KB : VB;
                            *(u32x2*)(dst + (size_t)row * KVD + c2) = pack4(v);
                            if (row >= MP) *(f32x4*)(out + (bj == 0 ? O_KS : O_VS) + (size_t)(row - MP) * KVD + c2) = v;
                            else if ((row & (SEQ - 1)) >= SEQ - 128) *(f32x4*)(out + (bj == 0 ? O_NKP : O_NVP) + (size_t)((row >> 13) * 128 + (row & (SEQ - 1)) - (SEQ - 128)) * KVD + c2) = v;
                        }
                    }
                EPI_FENCE();
            }
    }
};

struct Params {
    const float *x_prompt, *x_sample, *state, *cache_k, *cache_v, *p_prompt, *p_sample, *norm_mix, *gm_w_in, *gm_v_norm, *gm_w_s, *gm_b_s, *gm_w_out, *kv_norm, *w_kv, *w_q, *sinks, *w_o,
        *norm_ffn, *w_gate, *w_up, *conv_w, *conv_b, *w_down, *ple_norm, *ple_w_gate, *ple_w_proj, *final_norm;
    float* out; unsigned char* ws;
};

__device__ __forceinline__ void tr_item(const float* W, int K, int N, bf16_t* WT, const float* scale, int mode, int row_off, LAS float* scr, int item, int lane) {
    const int nblk = N / 32, kb = item / nblk, nb = item % nblk, k0 = 64 * kb, n0 = 32 * nb;
#pragma unroll 8
    for (int i = 0; i < 32; ++i) { const int kk = 2 * i + (lane >> 5); float w = W[(size_t)(k0 + kk) * N + n0 + (lane & 31)]; if (scale) w *= scale[k0 + kk]; scr[kk * 33 + (lane & 31)] = w; }
    asm volatile("s_waitcnt lgkmcnt(0)" ::: "memory");
    const int c = lane & 7;
    const int drow0 = mode == 0 ? row_off + n0 : ((n0 >> 7) * 256 + (mode == 2 ? 128 : 0) + (n0 & 127));
#pragma unroll
    for (int j = 0; j < 4; ++j) { const int n = (lane >> 3) + 8 * j; const LAS float* s = scr + (8 * c) * 33 + n;
        u32x4 o; o.x = cvt_pk_bf16(s[0 * 33], s[1 * 33]); o.y = cvt_pk_bf16(s[2 * 33], s[3 * 33]); o.z = cvt_pk_bf16(s[4 * 33], s[5 * 33]); o.w = cvt_pk_bf16(s[6 * 33], s[7 * 33]);
        *(u32x4*)(WT + (size_t)(drow0 + n) * K + k0 + 8 * c) = o; }
    asm volatile("s_waitcnt lgkmcnt(0)" ::: "memory");
}

__device__ __forceinline__ void prologue(const Params& P, LAS unsigned char* lds, int G, int wave0) {
    const int tid = opaque_tid(wave0), lane = tid & 63, wave = tid >> 6;
    unsigned char* ws = P.ws;
    LAS float* scr = (LAS float*)(lds + wave * 16384);
    const int gw = blockIdx.x * 8 + wave, NGW = G * 8;
    constexpr int NITEMS = 2048 + 1024 + 4 * 1408 + 2 * 1408 + 2 * 512 + 2 * 128 + 512 + 128 + 512;
    for (int it = gw; it < NITEMS; it += NGW) {
        int r = it;
#define TRJ(cnt, ...) if (r < (cnt)) { tr_item(__VA_ARGS__, scr, r, lane); continue; } r -= (cnt);
        TRJ(2048, P.gm_w_in, 1024, 4096, (bf16_t*)(ws + WS_WIN), P.norm_mix, 0, 0)
        TRJ(1024, P.gm_w_out, 2048, 1024, (bf16_t*)(ws + WS_WOUT), nullptr, 0, 0)
        TRJ(1408, P.w_gate, 1024, DFF, (bf16_t*)(ws + WS_WGU0), P.norm_ffn, 1, 0)
        TRJ(1408, P.w_up, 1024, DFF, (bf16_t*)(ws + WS_WGU0), P.norm_ffn, 2, 0)
        TRJ(1408, P.w_gate + (size_t)1024 * DFF, 1024, DFF, (bf16_t*)(ws + WS_WGU0 + 11 * MiB), P.norm_ffn + 1024, 1, 0)
        TRJ(1408, P.w_up + (size_t)1024 * DFF, 1024, DFF, (bf16_t*)(ws + WS_WGU0 + 11 * MiB), P.norm_ffn + 1024, 2, 0)
        TRJ(1408, P.w_down, DFF, 1024, (bf16_t*)(ws + WS_WD0), nullptr, 0, 0)
        TRJ(1408, P.w_down + (size_t)DFF * 1024, DFF, 1024, (bf16_t*)(ws + WS_WD0 + 5632 * 1024), nullptr, 0, 0)
        TRJ(512, P.ple_w_gate, 1024, 1024, (bf16_t*)(ws + WS_WPG0), P.ple_norm, 0, 0)
        TRJ(512, P.ple_w_gate + 1024 * 1024, 1024, 1024, (bf16_t*)(ws + WS_WPG0 + 2 * MiB), P.ple_norm + 1024, 0, 0)
        TRJ(128, P.ple_w_proj, 256, 1024, (bf16_t*)(ws + WS_WPP0), nullptr, 0, 0)
        TRJ(128, P.ple_w_proj + 256 * 1024, 256, 1024, (bf16_t*)(ws + WS_WPP0 + 512 * 1024), nullptr, 0, 0)
        TRJ(512, P.w_q, 1024, 1024, (bf16_t*)(ws + WS_WQKV), P.norm_mix + 1024, 0, 0)
        TRJ(128, P.w_kv, 1024, 256, (bf16_t*)(ws + WS_WQKV), P.kv_norm, 0, 1024)
        TRJ(512, P.w_o, 1024, 1024, (bf16_t*)(ws + WS_WO), nullptr, 0, 0)
#undef TRJ
    }
    float* X = P.out; bf16_t* XBA = (bf16_t*)(ws + WS_XBA); float* SSA = (float*)(ws + WS_SSA);
    for (int m = gw; m < MT; m += NGW) {
        const float* src = m < MP ? P.x_prompt + (size_t)m * DM : P.x_sample + (size_t)(m - MP) * DM;
        float s = 0.f;
#pragma unroll
        for (int j = 0; j < 4; ++j) { const f32x4 v = *((const f32x4*)src + lane + 64 * j); s += dot4(v);
            *((f32x4*)(X + (size_t)m * DM) + lane + 64 * j) = v; *((u32x2*)(XBA + (size_t)m * DM) + lane + 64 * j) = pack4(v); }
        s = wave_sum(s);
        if (lane == 0) { SSA[m] = s; ((float*)(ws + WS_SSB))[m] = 0.f; ((float*)(ws + WS_VSS))[m] = 0.f; }
    }
    bf16_t* PB = (bf16_t*)(ws + WS_PB);
    for (int m = gw; m < 2 * MT; m += NGW) {
        const int L = m / MT, r = m % MT;
        const float* src = r < MP ? P.p_prompt + ((size_t)L * MP + r) * PLE : P.p_sample + ((size_t)L * MS + (r - MP)) * PLE;
        const f32x4 v = *((const f32x4*)src + lane);
        *((u32x2*)(PB + (size_t)m * PLE) + lane) = pack4(v);
    }
    const int gt = blockIdx.x * 512 + tid, NGT = G * 512;
    bf16_t* WT = (bf16_t*)(ws + WS_WTRIL);
    for (int i = gt; i < 8 * 128 * 128 / 2; i += NGT) { const int e = 2 * i, s = e & 127, t = (e >> 7) & 127;
        const float a = s <= t ? P.gm_w_s[e] : 0.f, b = (s + 1) <= t ? P.gm_w_s[e + 1] : 0.f; ((unsigned*)WT)[i] = cvt_pk_bf16(a, b); }
    float* rope = (float*)(ws + WS_ROPE);
    for (int i = gt; i < 8196 * 8; i += NGT) { const int pi = i >> 3, f = i & 7; const int pos = pi < SEQ ? pi : 16384 + (pi - SEQ);
        const float inv = __builtin_powf(500000.0f, -(float)f * 0.125f); const float ang = (float)pos * inv;
        double rev = (double)ang * 0.15915494309189535; rev -= __builtin_rint(rev); const float rf = (float)rev;
        rope[pi * 16 + f] = __builtin_amdgcn_cosf(rf); rope[pi * 16 + 8 + f] = __builtin_amdgcn_sinf(rf); }
}

__device__ __forceinline__ void gating_phase(const Params& P, LAS unsigned char* lds, int G, int wave0) {
    const int tid = opaque_tid(wave0), lane = tid & 63, wave = tid >> 6, fr = lane & 15, fq = lane >> 4;
    unsigned char* ws = P.ws;
    bf16_t* Z = (bf16_t*)(ws + WS_Z); const float* VSS = (const float*)(ws + WS_VSS); const bf16_t* WTR = (const bf16_t*)(ws + WS_WTRIL);
    LAS bf16_t* Vs = (LAS bf16_t*)lds;
    LAS float* rsb = (LAS float*)(lds + 128 * 264 * 2);
    for (int unit = blockIdx.x; unit < 2048; unit += G) {
        const int ch = unit >> 3, g = unit & 7, row0 = ch * 128;
        if (tid < 128) rsb[tid] = __builtin_amdgcn_rsqf(VSS[row0 + tid] * (1.0f / 2048.0f) + EPS);
        __syncthreads();
#pragma unroll
        for (int j = 0; j < 8; ++j) { const int idx = tid + 512 * j, r = idx >> 5, c8 = (idx & 31) * 8;
            const u32x4 raw = *(const u32x4*)(Z + (size_t)(row0 + r) * 4096 + 2048 + 256 * g + c8);
            const f32x4 wa = *(const f32x4*)(P.gm_v_norm + 256 * g + c8), wb = *(const f32x4*)(P.gm_v_norm + 256 * g + c8 + 4);
            const float rs = rsb[r];
            u32x4 o;
            o.x = cvt_pk_bf16(bf2f(raw.x & 0xffffu) * rs * wa[0], bf2f(raw.x >> 16) * rs * wa[1]);
            o.y = cvt_pk_bf16(bf2f(raw.y & 0xffffu) * rs * wa[2], bf2f(raw.y >> 16) * rs * wa[3]);
            o.z = cvt_pk_bf16(bf2f(raw.z & 0xffffu) * rs * wb[0], bf2f(raw.z >> 16) * rs * wb[1]);
            o.w = cvt_pk_bf16(bf2f(raw.w & 0xffffu) * rs * wb[2], bf2f(raw.w >> 16) * rs * wb[3]);
            *(LAS u32x4*)(Vs + r * 264 + c8) = o; }
        __syncthreads();
        bf16x8 vf[4][2];
#pragma unroll
        for (int ks = 0; ks < 4; ++ks)
#pragma unroll
            for (int nt = 0; nt < 2; ++nt)
#pragma unroll
                for (int j = 0; j < 8; ++j) vf[ks][nt][j] = (short)Vs[(32 * ks + 8 * fq + j) * 264 + 32 * wave + 16 * nt + fr];
#pragma unroll
        for (int mt = 0; mt < 8; ++mt) {
            f32x4 a2[2] = {(f32x4){0.f, 0.f, 0.f, 0.f}, (f32x4){0.f, 0.f, 0.f, 0.f}};
#pragma unroll
            for (int ks = 0; ks < 4; ++ks) if (32 * ks <= 16 * mt + 15) {
                const bf16x8 wf = *(const bf16x8*)(WTR + (size_t)(g * 128 + 16 * mt + fr) * 128 + 32 * ks + 8 * fq);
#pragma unroll
                for (int nt = 0; nt < 2; ++nt) a2[nt] = __builtin_amdgcn_mfma_f32_16x16x32_bf16(vf[ks][nt], wf, a2[nt], 0, 0, 0);
            }
            const int t = 16 * mt + fr; const float bias = P.gm_b_s[g * 128 + t];
#pragma unroll
            for (int nt = 0; nt < 2; ++nt) { bf16_t* zp = Z + (size_t)(row0 + t) * 4096 + 256 * g + 32 * wave + 16 * nt + 4 * fq;
                const f32x4 uu = unpack4(*(const u32x2*)zp); *(u32x2*)zp = pack4(uu * (a2[nt] + bias)); }
        }
        __syncthreads();
    }
    float* gmv = P.out + O_GMV;
    for (int b = blockIdx.x; b < 128; b += G) {
        const int row0 = MP + 4 * b;
        if (tid < 4) rsb[tid] = __builtin_amdgcn_rsqf(VSS[row0 + tid] * (1.0f / 2048.0f) + EPS);
        __syncthreads();
        const int c = 4 * tid, g = c >> 8;
        const f32x4 vw = *(const f32x4*)(P.gm_v_norm + c);
        f32x4 v[4];
#pragma unroll
        for (int s = 0; s < 4; ++s) { v[s] = unpack4(*(const u32x2*)(Z + (size_t)(row0 + s) * 4096 + 2048 + c)) * rsb[s] * vw; *(f32x4*)(gmv + (size_t)(4 * b + s) * GH + c) = v[s]; }
#pragma unroll
        for (int t = 0; t < 4; ++t) { const float bias = P.gm_b_s[g * 128 + t]; f32x4 mx = (f32x4){bias, bias, bias, bias};
#pragma unroll
            for (int s = 0; s <= t; ++s) mx = mx + v[s] * P.gm_w_s[(g * 128 + t) * 128 + s];
            bf16_t* zp = Z + (size_t)(row0 + t) * 4096 + c; *(u32x2*)zp = pack4(unpack4(*(const u32x2*)zp) * mx); }
        __syncthreads();
    }
}

__device__ __forceinline__ void fixup_phase(const Params& P, int L, int G, int wave0) {
    unsigned char* ws = P.ws;
    const f32x4* HG = (const f32x4*)(ws + WS_HG); const f32x4* C0 = (const f32x4*)(ws + WS_C0); const f32x4* U0 = (const f32x4*)(ws + WS_U0);
    bf16_t* ACT = (bf16_t*)(ws + WS_Z);
    const f32x4* cw = (const f32x4*)(P.conv_w + (size_t)L * 3 * DFF);
    const int gt = blockIdx.x * 512 + opaque_tid(wave0), NGT = G * 512;
    for (int idx = gt; idx < 1024 * 704; idx += NGT) {
        const int gj = idx / 704, c4 = idx % 704, grp = gj >> 1, j = gj & 1, r = 64 * grp + j;
        f32x4 conv = C0[idx]; const f32x4 up = U0[idx];
        if ((grp & 127) != 0) { const f32x4 h0 = HG[(size_t)((grp - 1) * 2) * 704 + c4], h1 = HG[(size_t)((grp - 1) * 2 + 1) * 704 + c4]; const f32x4 w0 = cw[c4], w1 = cw[704 + c4];
            conv = conv + (j == 0 ? (w0 * h0 + w1 * h1) : (w0 * h1)); }
        *(u32x2*)(ACT + (size_t)r * DFF + 4 * c4) = pack4(gelu4(conv) * up);
    }
    for (int i = gt; i < MT; i += NGT) { ((float*)(ws + WS_SSA))[i] = 0.f; ((float*)(ws + WS_SSB))[i] = 0.f; }
    f32x4* ncp = (f32x4*)(P.out + O_NCP + (size_t)L * 4 * 2 * DFF);
    for (int idx = gt; idx < 8 * 704; idx += NGT) { const int bj = idx / 704, c4 = idx % 704, b = bj >> 1, j = bj & 1; ncp[idx] = HG[(size_t)((128 * b + 127) * 2 + j) * 704 + c4]; }
}

__device__ __forceinline__ void attn_phase(const Params& P, LAS unsigned char* lds, int G, int wave0) {
    const int tid = opaque_tid(wave0), lane = tid & 63, wave = tid >> 6, fr = lane & 15, fq = lane >> 4;
    unsigned char* ws = P.ws;
    bf16_t* Q = (bf16_t*)(ws + WS_Z + 195 * MiB); const bf16_t* KB = (const bf16_t*)(ws + WS_KB); const bf16_t* VB = (const bf16_t*)(ws + WS_VB);
    LAS bf16_t* Ks = (LAS bf16_t*)lds;
    LAS bf16_t* VTs = (LAS bf16_t*)(lds + 256 * 72 * 2);
    for (int i = blockIdx.x * 512 + tid; i < MT; i += G * 512) ((float*)(ws + WS_SSB))[i] = 0.f;
    for (int unit = blockIdx.x; unit < 768; unit += G) {
        const bool samp = unit >= 512;
        const int kvh = unit & 1;
        int b, qb;
        if (!samp) { b = unit >> 7; qb = (unit >> 1) & 63; } else { b = (unit - 512) >> 1; qb = 1; }
#pragma unroll
        for (int j = 0; j < 4; ++j) {
            const int idx = tid + 512 * j, r = idx >> 3, c8 = (idx & 7) * 8;
            u32x4 kv = (u32x4){0u, 0u, 0u, 0u}, vv = (u32x4){0u, 0u, 0u, 0u};
            if (!samp) { const int t = 128 * (qb - 1) + r; if (t >= 0) { const size_t go = (size_t)(b * SEQ + t) * KVD + kvh * 64 + c8; kv = *(const u32x4*)(KB + go); vv = *(const u32x4*)(VB + go); } }
            else if (r < 128) { const size_t go = ((size_t)(b * 128 + r) * 2 + kvh) * 64 + c8;
                const f32x4 k0 = *(const f32x4*)(P.cache_k + go), k1 = *(const f32x4*)(P.cache_k + go + 4), v0 = *(const f32x4*)(P.cache_v + go), v1 = *(const f32x4*)(P.cache_v + go + 4);
                kv = (u32x4){cvt_pk_bf16(k0[0], k0[1]), cvt_pk_bf16(k0[2], k0[3]), cvt_pk_bf16(k1[0], k1[1]), cvt_pk_bf16(k1[2], k1[3])};
                vv = (u32x4){cvt_pk_bf16(v0[0], v0[1]), cvt_pk_bf16(v0[2], v0[3]), cvt_pk_bf16(v1[0], v1[1]), cvt_pk_bf16(v1[2], v1[3])}; }
            else if (r < 132) { const size_t go = (size_t)(MP + 4 * b + (r - 128)) * KVD + kvh * 64 + c8; kv = *(const u32x4*)(KB + go); vv = *(const u32x4*)(VB + go); }
            *(LAS u32x4*)(Ks + r * 72 + c8) = kv;
            const int sp = r & 31, kk = (r & ~31) + 8 * ((sp & 15) >> 2) + 4 * (sp >> 4) + (sp & 3);
            LAS bf16_t* vt = VTs + c8 * 264 + kk;
            vt[0 * 264] = (bf16_t)(vv.x & 0xffffu); vt[1 * 264] = (bf16_t)(vv.x >> 16); vt[2 * 264] = (bf16_t)(vv.y & 0xffffu); vt[3 * 264] = (bf16_t)(vv.y >> 16);
            vt[4 * 264] = (bf16_t)(vv.z & 0xffffu); vt[5 * 264] = (bf16_t)(vv.z >> 16); vt[6 * 264] = (bf16_t)(vv.w & 0xffffu); vt[7 * 264] = (bf16_t)(vv.w >> 16);
        }
        __syncthreads();
        const int h = kvh * 8 + wave; const float sink = P.sinks[h];
        const int nrt = samp ? 1 : 8;
        for (int rt = 0; rt < nrt; ++rt) {
            const int rowq = samp ? (MP + 4 * b + (fr & 3)) : (b * SEQ + qb * 128 + rt * 16 + fr);
            const int qi = samp ? fr : 16 * rt + fr;
            const int kt0 = samp ? 0 : (rt & ~1);
            bf16x8 qf[2];
#pragma unroll
            for (int k = 0; k < 2; ++k) qf[k] = *(const bf16x8*)(Q + (size_t)rowq * 1024 + h * 64 + 32 * k + 8 * fq);
            f32x4 S[10];
#pragma unroll
            for (int i = 0; i < 10; ++i) { f32x4 a = (f32x4){0.f, 0.f, 0.f, 0.f};
#pragma unroll
                for (int k = 0; k < 2; ++k) { const bf16x8 kf = *(const LAS bf16x8*)(Ks + (16 * (kt0 + i) + fr) * 72 + 32 * k + 8 * fq); a = __builtin_amdgcn_mfma_f32_16x16x32_bf16(kf, qf[k], a, 0, 0, 0); }
                S[i] = a; }
            float mx = sink;
#pragma unroll
            for (int i = 0; i < 10; ++i)
#pragma unroll
                for (int j = 0; j < 4; ++j) { const int kw = 16 * (kt0 + i) + 4 * fq + j;
                    const bool vis = (kw > qi) && (kw <= qi + 128) && (samp ? (kw < 132) : (qb > 0 || kw >= 128));
                    const float sv = vis ? S[i][j] : -1e30f; S[i][j] = sv; mx = fmaxf(mx, sv); }
            mx = fmaxf(mx, __shfl_xor(mx, 16)); mx = fmaxf(mx, __shfl_xor(mx, 32));
            float sum = 0.f;
#pragma unroll
            for (int i = 0; i < 10; ++i)
#pragma unroll
                for (int j = 0; j < 4; ++j) { const float e = __builtin_amdgcn_exp2f((S[i][j] - mx) * LOG2E); S[i][j] = e; sum += e; }
            sum += __shfl_xor(sum, 16); sum += __shfl_xor(sum, 32);
            const float inv = 1.0f / (sum + __builtin_amdgcn_exp2f((sink - mx) * LOG2E));
            f32x4 o[4] = {(f32x4){0.f, 0.f, 0.f, 0.f}, (f32x4){0.f, 0.f, 0.f, 0.f}, (f32x4){0.f, 0.f, 0.f, 0.f}, (f32x4){0.f, 0.f, 0.f, 0.f}};
#pragma unroll
            for (int i = 0; i < 5; ++i) {
                const f32x4 p0 = S[2 * i] * inv, p1 = S[2 * i + 1] * inv;
                const u32x4 pw = (u32x4){cvt_pk_bf16(p0[0], p0[1]), cvt_pk_bf16(p0[2], p0[3]), cvt_pk_bf16(p1[0], p1[1]), cvt_pk_bf16(p1[2], p1[3])};
                const bf16x8 pf = __builtin_bit_cast(bf16x8, pw);
#pragma unroll
                for (int dt = 0; dt < 4; ++dt) { const bf16x8 vfr = *(const LAS bf16x8*)(VTs + (16 * dt + fr) * 264 + 32 * ((kt0 >> 1) + i) + 8 * fq); o[dt] = __builtin_amdgcn_mfma_f32_16x16x32_bf16(vfr, pf, o[dt], 0, 0, 0); }
            }
            if (!samp || fr < 4) {
#pragma unroll
                for (int dt = 0; dt < 4; ++dt) *(u32x2*)(Q + (size_t)rowq * 1024 + h * 64 + 16 * dt + 4 * fq) = pack4(o[dt]);
            }
        }
        __syncthreads();
    }
}

__device__ __forceinline__ void final_phase(const Params& P, int G, int wave0) {
    const int tid = opaque_tid(wave0), lane = tid & 63, wave = tid >> 6;
    const float* SSB = (const float*)(P.ws + WS_SSB);
    const int gw = blockIdx.x * 8 + wave, NGW = G * 8;
    f32x4 w[4];
#pragma unroll
    for (int j = 0; j < 4; ++j) w[j] = *((const f32x4*)P.final_norm + lane + 64 * j);
    for (int m = gw; m < MT; m += NGW) {
        const float rs = rstd16(SSB, m);
        f32x4* xr = (f32x4*)(P.out + (size_t)m * DM);
#pragma unroll
        for (int j = 0; j < 4; ++j) xr[lane + 64 * j] = xr[lane + 64 * j] * rs * w[j];
    }
}


#define XB_TMO      128
#define XB_XCNT(j)  (256  + 64 * (j))
#define XB_XSUB(j)  (1280 + 64 * (j))
#define XB_XGEN(j)  (2304 + 64 * (j))
#define XB_TOP      3328
#define XB_TOPGEN   3392
#define XCD_BAR_WORDS 3456
#define XB_SPIN_CAP (1u << 18)
__device__ __forceinline__ unsigned xb_ld(unsigned* p)              { return __hip_atomic_load(p, __ATOMIC_RELAXED, __HIP_MEMORY_SCOPE_AGENT); }
__device__ __forceinline__ unsigned xb_add(unsigned* p, unsigned v) { return __hip_atomic_fetch_add(p, v, __ATOMIC_RELAXED, __HIP_MEMORY_SCOPE_AGENT); }
__device__ __forceinline__ unsigned xb_xcc_id() { return (unsigned)__builtin_amdgcn_s_getreg((3 << 11) | 20) & 0xFu; }
#define XB_SPIN(cond, bar) do { unsigned _sp = 0; while (cond) { __builtin_amdgcn_s_sleep(1); \
    if ((++_sp & 255u) == 0u) { if (xb_ld(&(bar)[XB_TMO])) break; if (_sp > XB_SPIN_CAP) { atomicAdd(&(bar)[XB_TMO], 1u); break; } } } } while (0)
struct XcdBarrier { unsigned* bar; unsigned x; volatile LAS unsigned* st; };
__device__ __forceinline__ XcdBarrier xcd_barrier_post(unsigned* bar, volatile LAS unsigned* st) {
    XcdBarrier b; b.bar = bar; b.x = xb_xcc_id(); b.st = st;
    if (threadIdx.x == 0) (void)xb_add(&bar[XB_XCNT(b.x)], 1u);
    return b;
}
__device__ __forceinline__ void xcd_barrier_complete(unsigned* bar, unsigned x, unsigned& nloc, unsigned& nx) {
    const unsigned G = gridDim.x * gridDim.y * gridDim.z;
    unsigned sum, cnt, mine, sp = 0u;
    for (;;) {
        sum = 0u; cnt = 0u; mine = 0u;
#pragma unroll
        for (unsigned j = 0; j < 16; ++j) { const unsigned c = xb_ld(&bar[XB_XCNT(j)]); sum += c; cnt += (c > 0u) ? 1u : 0u; mine = (j == x) ? c : mine; }
        if (sum == G) break;
        __builtin_amdgcn_s_sleep(1);
        if ((++sp & 255u) == 0u) { if (xb_ld(&bar[XB_TMO])) break; if (sp > XB_SPIN_CAP) { atomicAdd(&bar[XB_TMO], 1u); break; } }
    }
    nloc = mine > 0u ? mine : 1u; nx = cnt > 0u ? cnt : 1u;
}
__device__ __forceinline__ void xcd_barrier(const XcdBarrier& b) {
    asm volatile("s_waitcnt vmcnt(0)" ::: "memory");
    __syncthreads();
    if (threadIdx.x == 0) {
        unsigned* bar = b.bar;
        __builtin_amdgcn_s_waitcnt(0);
        unsigned nloc = b.st[0], nx = b.st[1];
        if (nloc == 0u) { xcd_barrier_complete(bar, b.x, nloc, nx); b.st[0] = nloc; b.st[1] = nx; }
        const unsigned old = xb_add(&bar[XB_XSUB(b.x)], 1u);
        const unsigned gen = old / nloc;
        if (old + 1u == (gen + 1u) * nloc) {
            __builtin_amdgcn_fence(__ATOMIC_RELEASE, "agent");
            asm volatile("s_waitcnt vmcnt(0)" ::: "memory");
            const unsigned og = xb_add(&bar[XB_TOP], 1u);
            const unsigned tg = og / nx;
            if (og + 1u == (tg + 1u) * nx) xb_add(&bar[XB_TOPGEN], 1u);
            else XB_SPIN(xb_ld(&bar[XB_TOPGEN]) == tg, bar);
            __builtin_amdgcn_fence(__ATOMIC_ACQUIRE, "agent");
            xb_add(&bar[XB_XGEN(b.x)], 1u);
            asm volatile("s_waitcnt vmcnt(0)" ::: "memory");
        } else {
            XB_SPIN(xb_ld(&bar[XB_XGEN(b.x)]) == gen, bar);
            __builtin_amdgcn_fence(__ATOMIC_ACQUIRE, "agent");
            asm volatile("s_waitcnt vmcnt(0)" ::: "memory");
        }
    }
    __syncthreads();
}

constexpr int LDS_BYTES = 147456;
__global__ void __launch_bounds__(512, 2) yoco_fwd(Params P) {
    extern __shared__ __attribute__((aligned(16))) unsigned char lds_raw[];
    LAS unsigned char* lds = (LAS unsigned char*)lds_raw;
    cg::grid_group grid = cg::this_grid();
#if PROBE == 1
#define GSYNC() do { xcd_barrier(xbar); xcd_barrier(xbar); } while (0)
#else
#define GSYNC() xcd_barrier(xbar)
#endif
    constexpr int G = 256;
    const int wave0 = __builtin_amdgcn_readfirstlane((int)threadIdx.x >> 6);
    volatile LAS unsigned* xst = (volatile LAS unsigned*)(lds + 131072 + 512);
    if (threadIdx.x < 2) xst[threadIdx.x] = 0u;
    __syncthreads();
    XcdBarrier xbar = xcd_barrier_post((unsigned*)P.ws + 4096, xst);
    unsigned char* ws = P.ws;
    float* X = P.out;
    bf16_t* XBA = (bf16_t*)(ws + WS_XBA); bf16_t* Z = (bf16_t*)(ws + WS_Z); bf16_t* XBB = (bf16_t*)(ws + WS_Z + 130 * MiB); bf16_t* QO = (bf16_t*)(ws + WS_Z + 195 * MiB);
    float* PR = (float*)(ws + WS_Z); float* SSA = (float*)(ws + WS_SSA); float* SSB = (float*)(ws + WS_SSB);

#ifndef PHM
#define PHM 0xffff
#endif
    if (PHM & 1) prologue(P, lds, G, wave0);
    grid.sync();
#pragma unroll 1
    for (int L = 0; L < 2; ++L) {
        pg8::StaticOrder S;
        if (L == 0) {
            { pg8::Gemm g{XBA, (const bf16_t*)(ws + WS_WIN), MT, 4096, 1024, 1024}; S.init(MT, 4096, G, blockIdx.x);
              EpiGm E{SSA, Z, (float*)(ws + WS_VSS)}; if (PHM & 2) pg8::gemm_phase<EpiGm>(lds, g, S, E, wave0); }
            GSYNC();
            if (PHM & 4) gating_phase(P, lds, G, wave0);
            GSYNC();
        } else {
            { pg8::Gemm g{XBB, (const bf16_t*)(ws + WS_WQKV), MT, 1280, 1024, 1024}; S.init(MT, 1280, G, blockIdx.x);
              EpiQKV E{SSB, (const float*)(ws + WS_ROPE), QO, (bf16_t*)(ws + WS_KB), (bf16_t*)(ws + WS_VB), P.out}; if (PHM & 8) pg8::gemm_phase<EpiQKV>(lds, g, S, E, wave0); }
            GSYNC();
            if (PHM & 16) attn_phase(P, lds, G, wave0);
            GSYNC();
        }
        { pg8::Gemm g{L == 0 ? Z : QO, (const bf16_t*)(ws + (L == 0 ? WS_WOUT : WS_WO)), MT, 1024, L == 0 ? 2048 : 1024, L == 0 ? 4096 : 1024}; S.init(MT, 1024, G, blockIdx.x);
          EpiRes E{X, XBA, SSB}; if (PHM & 32) pg8::gemm_phase<EpiRes>(lds, g, S, E, wave0); }
        GSYNC();
        { pg8::Gemm g{XBA, (const bf16_t*)(ws + WS_WGU0 + (size_t)L * 11 * MiB), MT, 2 * DFF, 1024, 1024}; S.init(MT, 2 * DFF, G, blockIdx.x);
          EpiGU E{SSB, Z, P.conv_w + (size_t)L * 3 * DFF, P.conv_b + (size_t)L * DFF, (float*)(ws + WS_HG), (float*)(ws + WS_C0), (float*)(ws + WS_U0),
                  P.state + (size_t)L * 128 * 2 * DFF, P.out + O_NCS + (size_t)L * 128 * 2 * DFF};
          if (PHM & 64) pg8::gemm_phase<EpiGU>(lds, g, S, E, wave0); }
        GSYNC();
        if (PHM & 128) fixup_phase(P, L, G, wave0);
        GSYNC();
        { pg8::Gemm g{Z, (const bf16_t*)(ws + WS_WD0 + (size_t)L * 5632 * 1024), MT, 1024, DFF, DFF}; S.init(MT, 1024, G, blockIdx.x);
          EpiRes E{X, XBA, SSA}; if (PHM & 256) pg8::gemm_phase<EpiRes>(lds, g, S, E, wave0); }
        GSYNC();
        { pg8::Gemm g{(const bf16_t*)(ws + WS_PB) + (size_t)L * MT * PLE, (const bf16_t*)(ws + WS_WPP0 + (size_t)L * 512 * 1024), MT, 1024, 256, 256}; S.init(MT, 1024, G, blockIdx.x);
          EpiF32 E{PR}; if (PHM & 512) pg8::gemm_phase<EpiF32>(lds, g, S, E, wave0); }
        { pg8::Gemm g{XBA, (const bf16_t*)(ws + WS_WPG0 + (size_t)L * 2 * MiB), MT, 1024, 1024, 1024}; S.init(MT, 1024, G, blockIdx.x);
          EpiPle E{SSA, PR, X, XBB, SSB}; if (PHM & 1024) pg8::gemm_phase<EpiPle>(lds, g, S, E, wave0); }
        GSYNC();
    }
    if (PHM & 2048) final_phase(P, G, wave0);
}

extern "C" void kernel_launch(void* const* d_in, const int* in_sizes, int n_in, void* d_out, int out_size, void* d_ws, size_t ws_size, hipStream_t stream) {
    static int grid = 0;
    if (grid == 0) {
        if (n_in != 28 || ws_size < WS_END) { fprintf(stderr, "kernel_launch: unexpected n_in %d / ws_size %zu\n", n_in, ws_size); grid = -1; return; }
        int dev = 0, cus = 0, per_cu = 0;
        hipGetDevice(&dev); hipDeviceGetAttribute(&cus, hipDeviceAttributeMultiprocessorCount, dev);
        hipFuncSetAttribute((const void*)yoco_fwd, hipFuncAttributeMaxDynamicSharedMemorySize, LDS_BYTES);
        hipOccupancyMaxActiveBlocksPerMultiprocessor(&per_cu, (const void*)yoco_fwd, 512, LDS_BYTES);
        if (per_cu < 1) { fprintf(stderr, "kernel_launch: occupancy query says %d blocks/CU\n", per_cu); per_cu = 1; }
        (void)hipGetLastError();
        if (cus < 256) { fprintf(stderr, "kernel_launch: needs 256 CUs, device has %d\n", cus); grid = -1; return; }
        grid = 256;
    }
    if (grid < 0) return;
    if (hipMemsetAsync(d_ws, 0, 65536, stream) != hipSuccess) { fprintf(stderr, "kernel_launch: memset failed\n"); return; }
    Params p{};
    const float** pp = (const float**)&p;
    for (int i = 0; i < 28; ++i) pp[i] = (const float*)d_in[i];
    p.out = (float*)d_out; p.ws = (unsigned char*)d_ws;
    void* args[] = {&p};
    hipError_t e = hipLaunchCooperativeKernel((const void*)yoco_fwd, dim3(grid), dim3(512), args, LDS_BYTES, stream);
    if (e != hipSuccess) fprintf(stderr, "cooperative launch failed: %s (grid %d)\n", hipGetErrorString(e), grid);
}
```

```cpp
#include <hip/hip_runtime.h>
#include <hip/hip_cooperative_groups.h>
#include <cstdio>
#include <cstdint>
namespace cg = cooperative_groups;
#ifndef PROBE
#define PROBE 0
#endif

#define LAS __attribute__((address_space(3)))
typedef unsigned short bf16_t;
typedef short bf16x8 __attribute__((ext_vector_type(8)));
typedef float f32x4 __attribute__((ext_vector_type(4)));
typedef float f32x2 __attribute__((ext_vector_type(2)));
typedef unsigned u32x4 __attribute__((ext_vector_type(4)));
typedef unsigned u32x2 __attribute__((ext_vector_type(2)));

constexpr int DM = 1024, SEQ = 8192, MP = 32768, MS = 512, MT = MP + MS;
constexpr int GH = 2048, DFF = 2816, PLE = 256, KVD = 128;
constexpr float EPS = 1e-6f;
constexpr float LOG2E = 1.4426950408889634f;

constexpr size_t MiB = 1u << 20;
constexpr size_t WS_ROPE = 1 * MiB;
constexpr size_t WS_WTRIL = 2 * MiB;
constexpr size_t WS_SSA = 3 * MiB;
constexpr size_t WS_SSB = 6 * MiB;
constexpr size_t WS_VSS = 9 * MiB;
constexpr size_t WS_HG = 14 * MiB;
constexpr size_t WS_C0 = 25 * MiB;
constexpr size_t WS_U0 = 36 * MiB;
constexpr size_t WS_KB = 47 * MiB;
constexpr size_t WS_VB = 56 * MiB;
constexpr size_t WS_WIN = 66 * MiB;
constexpr size_t WS_WOUT = 74 * MiB;
constexpr size_t WS_WGU0 = 78 * MiB;
constexpr size_t WS_WD0 = 100 * MiB;
constexpr size_t WS_WPG0 = 111 * MiB;
constexpr size_t WS_WPP0 = 115 * MiB;
constexpr size_t WS_WQKV = 116 * MiB;
constexpr size_t WS_WO = 119 * MiB;
constexpr size_t WS_XBA = 121 * MiB;
constexpr size_t WS_PB = 186 * MiB;
constexpr size_t WS_Z = 219 * MiB;
constexpr size_t WS_END = 479 * MiB;

constexpr size_t O_Y = 0, O_GMV = 34078720, O_NCP = 35127296, O_NCS = 35172352, O_NKP = 36614144, O_NVP = 36679680, O_KS = 36745216, O_VS = 36810752;

__device__ __forceinline__ unsigned cvt_pk_bf16(float lo, float hi) { unsigned r; asm volatile("v_cvt_pk_bf16_f32 %0, %1, %2" : "=v"(r) : "v"(lo), "v"(hi)); return r; }
__device__ __forceinline__ float bf2f(unsigned h) { return __uint_as_float(h << 16); }
__device__ __forceinline__ u32x2 pack4(f32x4 v) { u32x2 w; w.x = cvt_pk_bf16(v[0], v[1]); w.y = cvt_pk_bf16(v[2], v[3]); return w; }
__device__ __forceinline__ f32x4 unpack4(u32x2 w) { return (f32x4){bf2f(w.x & 0xffffu), bf2f(w.x >> 16), bf2f(w.y & 0xffffu), bf2f(w.y >> 16)}; }
__device__ __forceinline__ float gelu1(float x) {
    const float z = x * (0.7978845608f + 0.0356774081f * x * x);
    const float e = __builtin_amdgcn_exp2f(-2.0f * LOG2E * z);
    return x * __builtin_amdgcn_rcpf(1.0f + e);
}
__device__ __forceinline__ f32x2 gelu_pk2(f32x2 v) {
    const f32x2 t = (v * v) * (-0.10294325f) + (-2.3022082f);
    const f32x2 y = v * t;
    f32x2 e; e.x = __builtin_amdgcn_exp2f(y.x); e.y = __builtin_amdgcn_exp2f(y.y);
    const f32x2 d = e + 1.0f;
    f32x2 r; r.x = __builtin_amdgcn_rcpf(d.x); r.y = __builtin_amdgcn_rcpf(d.y);
    return v * r;
}
__device__ __forceinline__ f32x4 gelu4(f32x4 v) { const f32x2 a = gelu_pk2((f32x2){v[0], v[1]}), b = gelu_pk2((f32x2){v[2], v[3]}); return (f32x4){a.x, a.y, b.x, b.y}; }
__device__ __forceinline__ f32x4 sigmoid4(f32x4 v) {
    const f32x4 y = v * (-LOG2E);
    const f32x4 e = (f32x4){__builtin_amdgcn_exp2f(y[0]), __builtin_amdgcn_exp2f(y[1]), __builtin_amdgcn_exp2f(y[2]), __builtin_amdgcn_exp2f(y[3])} + 1.0f;
    return (f32x4){__builtin_amdgcn_rcpf(e[0]), __builtin_amdgcn_rcpf(e[1]), __builtin_amdgcn_rcpf(e[2]), __builtin_amdgcn_rcpf(e[3])};
}
__device__ __forceinline__ float sigmoid1(float x) { return __builtin_amdgcn_rcpf(1.0f + __builtin_amdgcn_exp2f(-LOG2E * x)); }
__device__ __forceinline__ u32x4 pack8(f32x4 a, f32x4 b) { u32x4 w; w.x = cvt_pk_bf16(a[0], a[1]); w.y = cvt_pk_bf16(a[2], a[3]); w.z = cvt_pk_bf16(b[0], b[1]); w.w = cvt_pk_bf16(b[2], b[3]); return w; }
__device__ __forceinline__ float dot4(f32x4 v) { return (v[0] * v[0] + v[1] * v[1]) + (v[2] * v[2] + v[3] * v[3]); }
constexpr float SS_SCALE = 512.0f, SS_INV = 1.0f / 512.0f;
__device__ __forceinline__ float ss_get(const float* ss, int row) { return (float)((const unsigned*)ss)[row] * SS_INV; }
__device__ __forceinline__ void ss_set(float* ss, int row, float v) { ((unsigned*)ss)[row] = (unsigned)__builtin_rintf(v * SS_SCALE); }
__device__ __forceinline__ void ss_add(float* ss, int row, float v) { (void)__hip_atomic_fetch_add((unsigned*)ss + row, (unsigned)__builtin_rintf(v * SS_SCALE), __ATOMIC_RELAXED, __HIP_MEMORY_SCOPE_AGENT); }
__device__ __forceinline__ float rstd16(const float* ss, int row) { return __builtin_amdgcn_rsqf(ss_get(ss, row) * (1.0f / 1024.0f) + EPS); }
#define EPI_FENCE() asm volatile("" ::: "memory")
__device__ __forceinline__ int opaque_tid(int wave0) { int l; asm volatile("v_mbcnt_lo_u32_b32 %0, -1, 0\n\tv_mbcnt_hi_u32_b32 %0, -1, %0" : "=v"(l)); return wave0 * 64 + l; }
__device__ __forceinline__ float bperm(float v, int src) { return __int_as_float(__builtin_amdgcn_ds_bpermute(src << 2, __float_as_int(v))); }
__device__ __forceinline__ float xsum16(float v) { const auto r = __builtin_amdgcn_permlane16_swap(__float_as_uint(v), __float_as_uint(v), false, false); return __uint_as_float(r[0]) + __uint_as_float(r[1]); }
__device__ __forceinline__ float xsum32(float v) { const auto r = __builtin_amdgcn_permlane32_swap(__float_as_uint(v), __float_as_uint(v), false, false); return __uint_as_float(r[0]) + __uint_as_float(r[1]); }
__device__ __forceinline__ float xmax16(float v) { const auto r = __builtin_amdgcn_permlane16_swap(__float_as_uint(v), __float_as_uint(v), false, false); return fmaxf(__uint_as_float(r[0]), __uint_as_float(r[1])); }
__device__ __forceinline__ float xmax32(float v) { const auto r = __builtin_amdgcn_permlane32_swap(__float_as_uint(v), __float_as_uint(v), false, false); return fmaxf(__uint_as_float(r[0]), __uint_as_float(r[1])); }
__device__ __forceinline__ float xpartner16(float v, int fq) { const auto r = __builtin_amdgcn_permlane16_swap(__float_as_uint(v), __float_as_uint(v), false, false); return __uint_as_float((fq & 1) ? r[0] : r[1]); }
__device__ __forceinline__ f32x4 shfl4(f32x4 v, int src) { return (f32x4){bperm(v[0], src), bperm(v[1], src), bperm(v[2], src), bperm(v[3], src)}; }
__device__ __forceinline__ float wave_sum(float v, int lane_) {
#pragma unroll
    for (int o = 1; o < 64; o <<= 1) v += bperm(v, lane_ ^ o);
    return v;
}

namespace pg8 {
constexpr int BM = 256, BK = 64, HALF = 128, HTB = HALF * BK * 2, STAGE_BYTES = 8 * HTB, NXCD = 8, WGM = 8;
__host__ __device__ __forceinline__ int lds_byte(int r, int c) { const int st = (r >> 4) * 2 + (c >> 5), rr = r & 15, cc = c & 31, ob = rr * 64 + cc * 2; return st * 1024 + (ob ^ (((ob >> 9) & 1) << 5)); }
__host__ __device__ __forceinline__ void stage_rc(int b, int& R, int& C) { const int st = b / 1024, sb = b % 1024, swz = sb ^ (((sb >> 9) & 1) << 5); R = (st >> 1) * 16 + swz / 64; C = (st & 1) * 32 + (swz % 64) / 2; }

__host__ __device__ __forceinline__ int perm32(int rho) { const int n = rho >> 4, i = rho & 15; return 8 * (i >> 2) + 4 * n + (i & 3); }
template <class E> constexpr auto epi_perm(int) -> decltype(E::PERM) { return E::PERM; }
template <class E> constexpr bool epi_perm(long) { return false; }
struct Unit { int row0, pn, half; };
struct Gemm { const bf16_t* A; const bf16_t* Bt; int M, N, K, lda; };

struct StaticOrder {
    int nM, nN, nwg, G, c;
    __device__ void init(int M, int N, int G_, int c_) { nM = M / BM; nN = N / BM; nwg = nM * nN; G = G_; c = c_; }
    __device__ bool next(int i, Unit& u) const {
        const long L = (long)i * G + c;
        if (L >= nwg) { const int q = (int)(L - nwg); if (q >= 4 * nN) return false; u.row0 = MP + (q & 3) * 128; u.pn = q >> 2; u.half = 1; return true; }
        int wgid = (int)L; { const int q = nwg / NXCD, r = nwg % NXCD, xcd = wgid % NXCD, off = wgid / NXCD; wgid = (xcd < r ? xcd * (q + 1) : r * (q + 1) + (xcd - r) * q) + off; }
        const int nig = WGM * nN, gid = wgid / nig, fm = gid * WGM, gsz = (nM - fm) < WGM ? (nM - fm) : WGM;
        u.row0 = (fm + ((wgid % nig) % gsz)) * BM; u.pn = (wgid % nig) / gsz; u.half = 0; return true;
    }
};

template <class Epi> __device__ __forceinline__ auto acc_init(const Epi& E, f32x4 (&acc)[2][2][4][2], const Unit& u, int wr, int wc, int fr, int fq, int) -> decltype(E.init(acc, u, wr, wc, fr, fq), void()) { E.init(acc, u, wr, wc, fr, fq); }
template <class Epi> __device__ __forceinline__ void acc_init(const Epi&, f32x4 (&acc)[2][2][4][2], const Unit&, int, int, int, int, long) {
#pragma unroll
    for (int a = 0; a < 2; ++a)
#pragma unroll
        for (int b = 0; b < 2; ++b)
#pragma unroll
            for (int m = 0; m < 4; ++m)
#pragma unroll
                for (int n = 0; n < 2; ++n) acc[a][b][m][n] = (f32x4){0.f, 0.f, 0.f, 0.f};
}
template <class Epi, bool ALIGN_EPI = true, bool SP2 = true>
__device__ __forceinline__ void gemm_phase(LAS unsigned char* lds, const Gemm g, const StaticOrder& S_in, const Epi& E, int wave0) {
    StaticOrder S = S_in; asm volatile("" : "+s"(S.c));
    const int tid = opaque_tid(wave0), wid = __builtin_amdgcn_readfirstlane(tid >> 6), lane = tid & 63, wr = wid >> 2, wc = wid & 3, fr = lane & 15, fq = lane >> 4;
    const int K = g.K, nt = K / BK;
    unsigned voffA[2], voffB[2];
#pragma unroll
    for (int i = 0; i < 2; ++i) { int R, C; stage_rc(tid * 16 + i * 8192, R, C);
        const int Rb = epi_perm<Epi>(0) ? ((R & ~31) + perm32(R & 31)) : R;
        voffA[i] = (unsigned)(R * g.lda + C) * 2u; voffB[i] = (unsigned)(Rb * K + C) * 2u; }
    const size_t kstep = (size_t)(BK * 2);
    const size_t hstepA = (size_t)HALF * g.lda * 2, hstepB = (size_t)HALF * K * 2;
    const size_t tstepA = 2 * hstepA, tstepB = 2 * hstepB;
    const unsigned ldsw = (unsigned)wid * 1024u;
    const int aoff = lds_byte(wr * 64 + fr, fq * 8), boff = lds_byte(wc * 32 + fr, fq * 8);
#define PG8_SA(b, h) (((b) * 2 + (h)) * HTB)
#define PG8_SB(b, h) ((4 + (b) * 2 + (h)) * HTB)
#define PG8_STAGE(bufoff, gbase, voff) do { _Pragma("unroll") for (int _i = 0; _i < 2; ++_i) \
        __builtin_amdgcn_global_load_lds((const unsigned*)((const char*)(gbase) + (voff)[_i]), (LAS unsigned*)(lds + (bufoff) + ldsw + _i * 8192), 16, 0, 0); } while (0)
#define PG8_LDA(dst, b, h) do { _Pragma("unroll") for (int m = 0; m < 4; ++m) _Pragma("unroll") for (int k = 0; k < 2; ++k) dst[m][k] = *(const LAS bf16x8*)(lds + PG8_SA(b, h) + aoff + m * 2048 + k * 1024); } while (0)
#define PG8_LDB(dst, b, h) do { _Pragma("unroll") for (int n = 0; n < 2; ++n) _Pragma("unroll") for (int k = 0; k < 2; ++k) dst[n][k] = *(const LAS bf16x8*)(lds + PG8_SB(b, h) + boff + n * 2048 + k * 1024); } while (0)
#define PG8_MMA(ai, bj, At, Bt) do { __builtin_amdgcn_s_setprio(1); _Pragma("unroll") for (int m = 0; m < 4; ++m) _Pragma("unroll") for (int n = 0; n < 2; ++n) _Pragma("unroll") for (int k = 0; k < 2; ++k) \
        acc[ai][bj][m][n] = __builtin_amdgcn_mfma_f32_16x16x32_bf16(Bt[n][k], At[m][k], acc[ai][bj][m][n], 0, 0, 0); __builtin_amdgcn_s_setprio(0); } while (0)
#define PG8_WAIT_V(n) asm volatile("s_waitcnt vmcnt(" #n ")" ::: "memory")
#define PG8_WAIT_L(n) asm volatile("s_waitcnt lgkmcnt(" #n ")" ::: "memory")
#define PG8_BAR __builtin_amdgcn_s_barrier()
#define PG8_SCHED __builtin_amdgcn_sched_barrier(0)
    Unit cur, nxt; int ui = 0;
    if (!S.next(0, cur)) return;
    f32x4 acc[2][2][4][2];
    acc_init(E, acc, cur, wr, wc, fr, fq, 0);
    bf16x8 At[4][2], B0[2][2], B1[2][2];
    const char* cA = (const char*)g.A + (size_t)cur.row0 * g.lda * 2; const char* cB = (const char*)g.Bt + (size_t)cur.pn * tstepB;
    if constexpr (SP2) {
        PG8_STAGE(PG8_SB(0, 0), cB, voffB); PG8_STAGE(PG8_SB(0, 1), cB + hstepB, voffB); PG8_STAGE(PG8_SA(0, 0), cA, voffA); PG8_STAGE(PG8_SA(0, 1), cA + hstepA, voffA);
        if (wr == 1) PG8_BAR;
        PG8_WAIT_V(2); PG8_BAR;
        PG8_STAGE(PG8_SB(1, 0), cB + kstep, voffB); PG8_STAGE(PG8_SA(1, 0), cA + kstep, voffA); PG8_STAGE(PG8_SB(1, 1), cB + hstepB + kstep, voffB);
        PG8_WAIT_V(6); PG8_BAR;
    } else {
        PG8_STAGE(PG8_SB(0, 0), cB, voffB); PG8_STAGE(PG8_SA(0, 0), cA, voffA); PG8_STAGE(PG8_SB(0, 1), cB + hstepB, voffB); PG8_STAGE(PG8_SA(0, 1), cA + hstepA, voffA);
        if (wr == 1) PG8_BAR;
        PG8_WAIT_V(4); PG8_BAR;
        PG8_STAGE(PG8_SB(1, 0), cB + kstep, voffB); PG8_STAGE(PG8_SA(1, 0), cA + kstep, voffA); PG8_STAGE(PG8_SB(1, 1), cB + hstepB + kstep, voffB);
        PG8_WAIT_V(6); PG8_BAR;
    }
    for (;;) {
        const bool has_next = S.next(ui + 1, nxt);
        const char* nA = has_next ? (const char*)g.A + (size_t)nxt.row0 * g.lda * 2 : cA; const char* nB = has_next ? (const char*)g.Bt + (size_t)nxt.pn * tstepB : cB;
        for (int t = 0; t < nt; t += 2) {
            const bool last = (t == nt - 2);
            const char* a1 = cA + (size_t)(t + 1) * kstep;
            const char* a2 = last ? nA : cA + (size_t)(t + 2) * kstep; const char* b2 = last ? nB : cB + (size_t)(t + 2) * kstep;
            const char* a3 = a2 + kstep; const char* b3 = b2 + kstep;
            if constexpr (SP2) {
            PG8_LDB(B0, 0, 0); PG8_LDB(B1, 0, 1); PG8_SCHED; PG8_LDA(At, 0, 0); PG8_STAGE(PG8_SA(1, 1), a1 + hstepA, voffA);
            PG8_WAIT_V(8); PG8_WAIT_L(0); PG8_BAR; PG8_MMA(0, 0, At, B0); PG8_MMA(0, 1, At, B1); PG8_BAR; PG8_SCHED;
            PG8_LDA(At, 0, 1); PG8_STAGE(PG8_SB(0, 0), b2, voffB); PG8_STAGE(PG8_SB(0, 1), b2 + hstepB, voffB); PG8_STAGE(PG8_SA(0, 0), a2, voffA);
            PG8_WAIT_V(8); PG8_WAIT_L(0); PG8_BAR; if (!cur.half) { PG8_MMA(1, 0, At, B0); PG8_MMA(1, 1, At, B1); } PG8_BAR; PG8_SCHED;
            PG8_LDB(B0, 1, 0); PG8_LDB(B1, 1, 1); PG8_SCHED; PG8_LDA(At, 1, 0); PG8_STAGE(PG8_SA(0, 1), a2 + hstepA, voffA);
            PG8_WAIT_V(8); PG8_WAIT_L(0); PG8_BAR; PG8_MMA(0, 0, At, B0); PG8_MMA(0, 1, At, B1); PG8_BAR; PG8_SCHED;
            PG8_LDA(At, 1, 1); PG8_STAGE(PG8_SB(1, 0), b3, voffB); PG8_STAGE(PG8_SB(1, 1), b3 + hstepB, voffB); PG8_STAGE(PG8_SA(1, 0), a3, voffA);
            PG8_WAIT_V(8); PG8_WAIT_L(0); PG8_BAR; if (!cur.half) { PG8_MMA(1, 0, At, B0); PG8_MMA(1, 1, At, B1); } PG8_BAR; PG8_SCHED;
            } else {
            PG8_LDB(B0, 0, 0); PG8_SCHED; PG8_LDA(At, 0, 0); PG8_STAGE(PG8_SA(1, 1), a1 + hstepA, voffA);
            PG8_WAIT_L(8); PG8_BAR; PG8_WAIT_L(0); PG8_MMA(0, 0, At, B0); PG8_BAR; PG8_SCHED;
            PG8_LDB(B1, 0, 1); PG8_STAGE(PG8_SB(0, 0), b2, voffB);
            PG8_BAR; PG8_WAIT_L(0); PG8_MMA(0, 1, At, B1); PG8_BAR;
            PG8_LDA(At, 0, 1); PG8_STAGE(PG8_SA(0, 0), a2, voffA);
            PG8_BAR; PG8_WAIT_L(0); if (!cur.half) { PG8_MMA(1, 0, At, B0); } PG8_BAR; PG8_SCHED;
            PG8_STAGE(PG8_SB(0, 1), b2 + hstepB, voffB);
            PG8_WAIT_V(6); PG8_BAR; if (!cur.half) { PG8_MMA(1, 1, At, B1); } PG8_BAR;
            PG8_LDB(B0, 1, 0); PG8_SCHED; PG8_LDA(At, 1, 0); PG8_STAGE(PG8_SA(0, 1), a2 + hstepA, voffA);
            PG8_WAIT_L(8); PG8_BAR; PG8_WAIT_L(0); PG8_MMA(0, 0, At, B0); PG8_BAR; PG8_SCHED;
            PG8_LDB(B1, 1, 1); PG8_STAGE(PG8_SB(1, 0), b3, voffB);
            PG8_BAR; PG8_WAIT_L(0); PG8_MMA(0, 1, At, B1); PG8_BAR;
            PG8_LDA(At, 1, 1); PG8_STAGE(PG8_SA(1, 0), a3, voffA);
            PG8_BAR; PG8_WAIT_L(0); if (!cur.half) { PG8_MMA(1, 0, At, B0); } PG8_BAR; PG8_SCHED;
            PG8_STAGE(PG8_SB(1, 1), b3 + hstepB, voffB);
            PG8_WAIT_V(6); PG8_BAR; if (!cur.half) { PG8_MMA(1, 1, At, B1); } PG8_BAR;
            }
        }
        if constexpr (ALIGN_EPI) { if (wr == 0) PG8_BAR; }
        E(acc, cur, wr, wc, fr, fq);
        if (!has_next) break;
        cur = nxt; cA = nA; cB = nB; ++ui;
        acc_init(E, acc, cur, wr, wc, fr, fq, 0);
        if constexpr (ALIGN_EPI) { if (wr == 1) PG8_BAR; }
    }
    PG8_WAIT_V(0);
    if constexpr (!ALIGN_EPI) { if (wr == 0) PG8_BAR; }
    PG8_BAR;
#undef PG8_SA
#undef PG8_SB
#undef PG8_STAGE
#undef PG8_LDA
#undef PG8_LDB
#undef PG8_MMA
#undef PG8_WAIT_V
#undef PG8_WAIT_L
#undef PG8_BAR
#undef PG8_SCHED
}
}
using pg8::Unit;
typedef f32x4 Acc[2][2][4][2];

struct EpiGm {
    static constexpr bool PERM = true;
    const float* ss; bf16_t* Z; float* vss;
    __device__ __forceinline__ void operator()(Acc& acc, const Unit& u, int wr, int wc, int fr, int fq) const {
        asm volatile("" : "+v"(fr), "+v"(fq));
        const int lane_ = fq * 16 + fr; (void)lane_;
        const int rowb = u.row0 + wr * 64 + fr, colb = u.pn * 256 + wc * 32 + 8 * fq;
        float rs[8];
#pragma unroll
        for (int g = 0; g < 8; ++g) rs[g] = ss_get(ss, rowb + (g >> 2) * 128 + (g & 3) * 16);
        EPI_FENCE();
#pragma unroll
        for (int g = 0; g < 8; ++g) {
            if (u.half && g >= 4) break;
            const int ai = g >> 2, m = g & 3, row = rowb + ai * 128 + m * 16;
            const float r = __builtin_amdgcn_rsqf(rs[g] * (1.0f / 1024.0f) + EPS); float s = 0.f;
#pragma unroll
            for (int bj = 0; bj < 2; ++bj) {
                const f32x4 v0 = gelu4(acc[ai][bj][m][0] * r), v1 = gelu4(acc[ai][bj][m][1] * r);
                *(u32x4*)(Z + (size_t)row * 4096 + colb + bj * 128) = pack8(v0, v1);
                s += dot4(v0) + dot4(v1);
            }
            if (u.pn >= 8) { s = xsum16(s); s = xsum32(s); if (fq == 0) ss_add(vss, row, s); }
        }
        EPI_FENCE();
    }
};
struct EpiRes {
    static constexpr bool PERM = true;
    const bf16_t* src; bf16_t* dst; float* sso;
    __device__ __forceinline__ void init(Acc& acc, const Unit& u, int wr, int wc, int fr, int fq) const {
        asm volatile("" : "+v"(fr), "+v"(fq));
        const int rowb = u.row0 + wr * 64 + fr, colb = u.pn * 256 + wc * 32 + 8 * fq;
#pragma unroll
        for (int g = 0; g < 8; ++g) { const int ai = g >> 2, m = g & 3;
#pragma unroll
            for (int bj = 0; bj < 2; ++bj) {
                if (u.half && ai == 1) { acc[ai][bj][m][0] = (f32x4){0.f, 0.f, 0.f, 0.f}; acc[ai][bj][m][1] = (f32x4){0.f, 0.f, 0.f, 0.f}; }
                else { const u32x4 w = *(const u32x4*)(src + (size_t)(rowb + ai * 128 + m * 16) * 1024 + colb + bj * 128);
                    acc[ai][bj][m][0] = unpack4((u32x2){w.x, w.y}); acc[ai][bj][m][1] = unpack4((u32x2){w.z, w.w}); } } }
    }
    __device__ __forceinline__ void operator()(Acc& acc, const Unit& u, int wr, int wc, int fr, int fq) const {
        asm volatile("" : "+v"(fr), "+v"(fq));
        const int lane_ = fq * 16 + fr; (void)lane_;
        const int rowb = u.row0 + wr * 64 + fr, colb = u.pn * 256 + wc * 32 + 8 * fq;
#pragma unroll
        for (int g = 0; g < 8; ++g) {
            if (u.half && g >= 4) break;
            const int ai = g >> 2, m = g & 3, row = rowb + ai * 128 + m * 16;
            float s = 0.f;
#pragma unroll
            for (int bj = 0; bj < 2; ++bj) { const f32x4 v0 = acc[ai][bj][m][0], v1 = acc[ai][bj][m][1];
                *(u32x4*)(dst + (size_t)row * 1024 + colb + bj * 128) = pack8(v0, v1); s += dot4(v0) + dot4(v1); }
            s = xsum16(s); s = xsum32(s); if (fq == 0) ss_add(sso, row, s);
        }
        EPI_FENCE();
    }
};
struct EpiBf {
    static constexpr bool PERM = true;
    bf16_t* C;
    __device__ __forceinline__ void operator()(Acc& acc, const Unit& u, int wr, int wc, int fr, int fq) const {
        asm volatile("" : "+v"(fr), "+v"(fq));
        const int rowb = u.row0 + wr * 64 + fr, colb = u.pn * 256 + wc * 32 + 8 * fq;
#pragma unroll
        for (int g = 0; g < 8; ++g) { if (u.half && g >= 4) break; const int ai = g >> 2, m = g & 3, row = rowb + ai * 128 + m * 16;
#pragma unroll
            for (int bj = 0; bj < 2; ++bj) *(u32x4*)(C + (size_t)row * 1024 + colb + bj * 128) = pack8(acc[ai][bj][m][0], acc[ai][bj][m][1]); }
        EPI_FENCE();
    }
};
struct EpiPle {
    static constexpr bool PERM = true;
    const float* ss; const bf16_t* PR; const bf16_t* src; bf16_t* dstb; float* sso;
    __device__ __forceinline__ void operator()(Acc& acc, const Unit& u, int wr, int wc, int fr, int fq) const {
        asm volatile("" : "+v"(fr), "+v"(fq));
        const int lane_ = fq * 16 + fr; (void)lane_;
        const int rowb = u.row0 + wr * 64 + fr, colb = u.pn * 256 + wc * 32 + 8 * fq;
        float rs[8];
#pragma unroll
        for (int g = 0; g < 8; ++g) rs[g] = ss_get(ss, rowb + (g >> 2) * 128 + (g & 3) * 16);
        u32x4 nx[2], np[2];
#pragma unroll
        for (int bj = 0; bj < 2; ++bj) { const size_t off = (size_t)rowb * 1024 + colb + bj * 128; nx[bj] = *(const u32x4*)(src + off); np[bj] = *(const u32x4*)(PR + off); }
        EPI_FENCE();
#pragma unroll
        for (int g = 0; g < 8; ++g) {
            if (u.half && g >= 4) break;
            const int ai = g >> 2, m = g & 3, row = rowb + ai * 128 + m * 16;
            u32x4 cx[2], cp[2];
#pragma unroll
            for (int bj = 0; bj < 2; ++bj) { cx[bj] = nx[bj]; cp[bj] = np[bj]; }
            if (g < 7) { const int row2 = rowb + ((g + 1) >> 2) * 128 + ((g + 1) & 3) * 16;
#pragma unroll
                for (int bj = 0; bj < 2; ++bj) { const size_t off = (size_t)row2 * 1024 + colb + bj * 128; nx[bj] = *(const u32x4*)(src + off); np[bj] = *(const u32x4*)(PR + off); } }
            EPI_FENCE();
            const float r = __builtin_amdgcn_rsqf(rs[g] * (1.0f / 1024.0f) + EPS); float s = 0.f;
#pragma unroll
            for (int bj = 0; bj < 2; ++bj) { const size_t off = (size_t)row * 1024 + colb + bj * 128;
                const f32x4 v0 = unpack4((u32x2){cx[bj].x, cx[bj].y}) + unpack4((u32x2){cp[bj].x, cp[bj].y}) * sigmoid4(acc[ai][bj][m][0] * r);
                const f32x4 v1 = unpack4((u32x2){cx[bj].z, cx[bj].w}) + unpack4((u32x2){cp[bj].z, cp[bj].w}) * sigmoid4(acc[ai][bj][m][1] * r);
                *(u32x4*)(dstb + off) = pack8(v0, v1);
                s += dot4(v0) + dot4(v1); }
            s = xsum16(s); s = xsum32(s); if (fq == 0) ss_add(sso, row, s);
            EPI_FENCE();
        }
    }
};
struct EpiGU {
    static constexpr bool PERM = true;
    const float* ss; bf16_t* act; const float* cw; const float* cb; float* hg; float* c0; float* u0; const float* state; float* ncs;
    __device__ __forceinline__ void operator()(Acc& acc, const Unit& u, int wr, int wc, int fr, int fq) const {
        asm volatile("" : "+v"(fr), "+v"(fq));
        const int lane_ = fq * 16 + fr; (void)lane_;
        const int src1 = (fq << 4) | ((fr + 15) & 15), src2 = (fq << 4) | ((fr + 14) & 15);
        const bool samp = u.row0 >= MP;
#pragma unroll
        for (int ai = 0; ai < 2; ++ai)
#pragma unroll
            for (int m = 0; m < 4; ++m) {
                const int row = u.row0 + ai * 128 + wr * 64 + m * 16 + fr; const float rs = rstd16(ss, row);
#pragma unroll
                for (int bj = 0; bj < 2; ++bj)
#pragma unroll
                    for (int n = 0; n < 2; ++n) acc[ai][bj][m][n] = acc[ai][bj][m][n] * rs;
            }
        const int colg = u.pn * 128 + wc * 32 + 8 * fq;
        f32x4 w0[2], w1[2], w2[2], bb[2];
#pragma unroll
        for (int n = 0; n < 2; ++n) { w0[n] = *(const f32x4*)(cw + colg + 4 * n); w1[n] = *(const f32x4*)(cw + DFF + colg + 4 * n); w2[n] = *(const f32x4*)(cw + 2 * DFF + colg + 4 * n); bb[n] = *(const f32x4*)(cb + colg + 4 * n); }
#pragma unroll
        for (int ai = 0; ai < 2; ++ai)
#pragma unroll
            for (int m = 0; m < 4; ++m) {
                if (u.half && ai == 1) break;
                const int row = u.row0 + ai * 128 + wr * 64 + m * 16 + fr;
                f32x4 a2[2];
#pragma unroll
                for (int n = 0; n < 2; ++n) {
                    const f32x4 g = acc[ai][0][m][n], gp = (m > 0) ? acc[ai][0][m > 0 ? m - 1 : 0][n] : g;
                    const f32x4 t1 = (fr == 15) ? gp : g, t2 = (fr >= 14) ? gp : g;
                    f32x4 g1 = shfl4(t1, src1), g2 = shfl4(t2, src2);
                    if (samp) {
                        const int t = fr & 3, b = (row - MP) >> 2;
                        if (t == 0) { g1 = *(const f32x4*)(state + (size_t)(b * 2 + 1) * DFF + colg + 4 * n); g2 = *(const f32x4*)(state + (size_t)(b * 2) * DFF + colg + 4 * n); }
                        else if (t == 1) { g2 = *(const f32x4*)(state + (size_t)(b * 2 + 1) * DFF + colg + 4 * n); }
                        else { *(f32x4*)(ncs + (size_t)(b * 2 + t - 2) * DFF + colg + 4 * n) = g; }
                    }
                    const f32x4 conv = bb[n] + w0[n] * g2 + w1[n] * g1 + w2[n] * g;
                    const f32x4 up = acc[ai][1][m][n];
                    a2[n] = gelu4(conv) * up;
                    if (!samp) {
                        if (m == 0 && fr < 2) { const int gj = (row >> 6) * 2 + fr; f32x4 c = bb[n] + w2[n] * g; if (fr == 1) c = c + w1[n] * g1;
                            *(f32x4*)(c0 + (size_t)gj * DFF + colg + 4 * n) = c; *(f32x4*)(u0 + (size_t)gj * DFF + colg + 4 * n) = up; }
                        if (m == 3 && fr >= 14) { const int gj = (row >> 6) * 2 + (fr - 14); *(f32x4*)(hg + (size_t)gj * DFF + colg + 4 * n) = g; }
                    }
                }
                *(u32x4*)(act + (size_t)row * DFF + colg) = pack8(a2[0], a2[1]);
                EPI_FENCE();
            }
    }
};
struct EpiQKV {
    static constexpr bool PERM = true;
    const float* ss; const float* rope; bf16_t* Q; bf16_t* KB; bf16_t* VB; float* out;
    __device__ __forceinline__ void operator()(Acc& acc, const Unit& u, int wr, int wc, int fr, int fq) const {
        asm volatile("" : "+v"(fr), "+v"(fq));
        const int lane_ = fq * 16 + fr; (void)lane_;
        float rsq[8];
#pragma unroll
        for (int g = 0; g < 8; ++g) rsq[g] = ss_get(ss, u.row0 + wr * 64 + fr + (g >> 2) * 128 + (g & 3) * 16);
        EPI_FENCE();
#pragma unroll
        for (int ai = 0; ai < 2; ++ai)
#pragma unroll
            for (int m = 0; m < 4; ++m) {
                if (u.half && ai == 1) break;
                const int row = u.row0 + ai * 128 + wr * 64 + m * 16 + fr; const float rs = __builtin_amdgcn_rsqf(rsq[ai * 4 + m] * (1.0f / 1024.0f) + EPS);
                const int posidx = row < MP ? (row & (SEQ - 1)) : SEQ + (row & 3);
                f32x4 cs[2], sn[2];
#pragma unroll
                for (int n = 0; n < 2; ++n) { cs[n] = *(const f32x4*)(rope + (size_t)posidx * 16 + 4 * n); sn[n] = *(const f32x4*)(rope + (size_t)posidx * 16 + 8 + 4 * n); }
#pragma unroll
                for (int bj = 0; bj < 2; ++bj) {
                    const bool isV = (u.pn == 4) && (bj == 1);
                    f32x4 v[2];
#pragma unroll
                    for (int n = 0; n < 2; ++n) {
                        v[n] = acc[ai][bj][m][n] * rs;
                        if ((wc & 1) == 0 && !isV) {
                            const f32x4 pt = (f32x4){xpartner16(v[n][0], fq), xpartner16(v[n][1], fq), xpartner16(v[n][2], fq), xpartner16(v[n][3], fq)};
                            if (fq == 0) v[n] = v[n] * cs[n] - pt * sn[n]; else if (fq == 1) v[n] = v[n] * cs[n] + pt * sn[n];
                        }
                    }
                    const int cu = bj * 128 + wc * 32 + 8 * fq;
                    if (u.pn < 4) { *(u32x4*)(Q + (size_t)row * 1024 + u.pn * 256 + cu) = pack8(v[0] * (0.125f * LOG2E), v[1] * (0.125f * LOG2E)); }
                    else {
                        const int c2 = cu & 127; bf16_t* dst = bj == 0 ? KB : VB;
                        *(u32x4*)(dst + (size_t)row * KVD + c2) = pack8(v[0], v[1]);
                        float* fo = nullptr;
                        if (row >= MP) fo = out + (bj == 0 ? O_KS : O_VS) + (size_t)(row - MP) * KVD + c2;
                        else if ((row & (SEQ - 1)) >= SEQ - 128) fo = out + (bj == 0 ? O_NKP : O_NVP) + (size_t)((row >> 13) * 128 + (row & (SEQ - 1)) - (SEQ - 128)) * KVD + c2;
                        if (fo) { *(f32x4*)fo = v[0]; *(f32x4*)(fo + 4) = v[1]; }
                    }
                }
                EPI_FENCE();
            }
    }
};

struct Params {
    const float *x_prompt, *x_sample, *state, *cache_k, *cache_v, *p_prompt, *p_sample, *norm_mix, *gm_w_in, *gm_v_norm, *gm_w_s, *gm_b_s, *gm_w_out, *kv_norm, *w_kv, *w_q, *sinks, *w_o,
        *norm_ffn, *w_gate, *w_up, *conv_w, *conv_b, *w_down, *ple_norm, *ple_w_gate, *ple_w_proj, *final_norm;
    float* out; unsigned char* ws;
};

constexpr int PARAM_OFF = 131072 + 1024;
__device__ __forceinline__ unsigned long long ldq(const LAS unsigned char* pbase, int i) {
    const unsigned long long v = ((const LAS unsigned long long*)pbase)[i];
    const unsigned lo = __builtin_amdgcn_readfirstlane((unsigned)v), hi = __builtin_amdgcn_readfirstlane((unsigned)(v >> 32));
    return ((unsigned long long)hi << 32) | lo;
}
__device__ __forceinline__ Params load_params(LAS unsigned char* lds) {
    Params p;
    unsigned poff = PARAM_OFF; asm volatile("" : "+v"(poff));
    const LAS unsigned char* pb = lds + poff;
    p.x_prompt = (decltype(p.x_prompt))(__attribute__((address_space(1))) float*)ldq(pb, 0);
    p.x_sample = (decltype(p.x_sample))(__attribute__((address_space(1))) float*)ldq(pb, 1);
    p.state = (decltype(p.state))(__attribute__((address_space(1))) float*)ldq(pb, 2);
    p.cache_k = (decltype(p.cache_k))(__attribute__((address_space(1))) float*)ldq(pb, 3);
    p.cache_v = (decltype(p.cache_v))(__attribute__((address_space(1))) float*)ldq(pb, 4);
    p.p_prompt = (decltype(p.p_prompt))(__attribute__((address_space(1))) float*)ldq(pb, 5);
    p.p_sample = (decltype(p.p_sample))(__attribute__((address_space(1))) float*)ldq(pb, 6);
    p.norm_mix = (decltype(p.norm_mix))(__attribute__((address_space(1))) float*)ldq(pb, 7);
    p.gm_w_in = (decltype(p.gm_w_in))(__attribute__((address_space(1))) float*)ldq(pb, 8);
    p.gm_v_norm = (decltype(p.gm_v_norm))(__attribute__((address_space(1))) float*)ldq(pb, 9);
    p.gm_w_s = (decltype(p.gm_w_s))(__attribute__((address_space(1))) float*)ldq(pb, 10);
    p.gm_b_s = (decltype(p.gm_b_s))(__attribute__((address_space(1))) float*)ldq(pb, 11);
    p.gm_w_out = (decltype(p.gm_w_out))(__attribute__((address_space(1))) float*)ldq(pb, 12);
    p.kv_norm = (decltype(p.kv_norm))(__attribute__((address_space(1))) float*)ldq(pb, 13);
    p.w_kv = (decltype(p.w_kv))(__attribute__((address_space(1))) float*)ldq(pb, 14);
    p.w_q = (decltype(p.w_q))(__attribute__((address_space(1))) float*)ldq(pb, 15);
    p.sinks = (decltype(p.sinks))(__attribute__((address_space(1))) float*)ldq(pb, 16);
    p.w_o = (decltype(p.w_o))(__attribute__((address_space(1))) float*)ldq(pb, 17);
    p.norm_ffn = (decltype(p.norm_ffn))(__attribute__((address_space(1))) float*)ldq(pb, 18);
    p.w_gate = (decltype(p.w_gate))(__attribute__((address_space(1))) float*)ldq(pb, 19);
    p.w_up = (decltype(p.w_up))(__attribute__((address_space(1))) float*)ldq(pb, 20);
    p.conv_w = (decltype(p.conv_w))(__attribute__((address_space(1))) float*)ldq(pb, 21);
    p.conv_b = (decltype(p.conv_b))(__attribute__((address_space(1))) float*)ldq(pb, 22);
    p.w_down = (decltype(p.w_down))(__attribute__((address_space(1))) float*)ldq(pb, 23);
    p.ple_norm = (decltype(p.ple_norm))(__attribute__((address_space(1))) float*)ldq(pb, 24);
    p.ple_w_gate = (decltype(p.ple_w_gate))(__attribute__((address_space(1))) float*)ldq(pb, 25);
    p.ple_w_proj = (decltype(p.ple_w_proj))(__attribute__((address_space(1))) float*)ldq(pb, 26);
    p.final_norm = (decltype(p.final_norm))(__attribute__((address_space(1))) float*)ldq(pb, 27);
    p.out = (decltype(p.out))(__attribute__((address_space(1))) float*)ldq(pb, 28);
    p.ws = (decltype(p.ws))(__attribute__((address_space(1))) unsigned char*)ldq(pb, 29);
    return p;
}
__device__ __forceinline__ void tr_item(const float* W, int K, int N, bf16_t* WT, const float* scale, int mode, int row_off, LAS float* scr, int item, int lane) {
    const int nblk = N / 32, kb = item / nblk, nb = item % nblk, k0 = 64 * kb, n0 = 32 * nb;
#pragma unroll 16
    for (int i = 0; i < 32; ++i) { const int kk = 2 * i + (lane >> 5); float w = W[(size_t)(k0 + kk) * N + n0 + (lane & 31)]; if (scale) w *= scale[k0 + kk]; scr[kk * 33 + (lane & 31)] = w; }
    asm volatile("s_waitcnt lgkmcnt(0)" ::: "memory");
    const int c = lane & 7;
    const int drow0 = mode == 0 ? row_off + n0 : ((n0 >> 7) * 256 + (mode == 2 ? 128 : 0) + (n0 & 127));
#pragma unroll
    for (int j = 0; j < 4; ++j) { const int n = (lane >> 3) + 8 * j; const LAS float* s = scr + (8 * c) * 33 + n;
        u32x4 o; o.x = cvt_pk_bf16(s[0 * 33], s[1 * 33]); o.y = cvt_pk_bf16(s[2 * 33], s[3 * 33]); o.z = cvt_pk_bf16(s[4 * 33], s[5 * 33]); o.w = cvt_pk_bf16(s[6 * 33], s[7 * 33]);
        *(u32x4*)(WT + (size_t)(drow0 + n) * K + k0 + 8 * c) = o; }
    asm volatile("s_waitcnt lgkmcnt(0)" ::: "memory");
}

__device__ __forceinline__ void conv_stage(LAS unsigned char* lds, int stage, int T, int wave0) {
    if ((int)blockIdx.x < T) return;
    const Params P = load_params(lds);
    const int tid = opaque_tid(wave0), lane = tid & 63, wave = tid >> 6;
    unsigned char* ws = P.ws;
    LAS float* scr = (LAS float*)(lds + wave * 16384);
    const int gw = ((int)blockIdx.x - T) * 8 + wave, NGW = (256 - T) * 8;
    const int nitems = stage == 0 ? 2048 : stage == 1 ? 1024 + 1408 : stage == 2 ? 1408 + 1408 + 512 + 128 : stage == 3 ? 512 + 128 + 512 : stage == 4 ? 512 + 128 : stage == 5 ? 1408 : stage == 7 ? 1408 : stage == 8 ? 1408 : 0;
    for (int it = gw; it < nitems; it += NGW) {
        int r = it; const float* W; int K, N; bf16_t* WT; const float* sc; int mode = 0, roff = 0;
        if (stage == 0) { W = P.gm_w_in; K = 1024; N = 4096; WT = (bf16_t*)(ws + WS_WIN); sc = P.norm_mix; }
        else if (stage == 1) {
            if (r < 1024) { W = P.gm_w_out; K = 2048; N = 1024; WT = (bf16_t*)(ws + WS_WOUT); sc = nullptr; }
            else { r -= 1024; W = P.w_gate; K = 1024; N = DFF; WT = (bf16_t*)(ws + WS_WGU0); sc = P.norm_ffn; mode = 1; }
        } else if (stage == 2) {
            if (r < 1408) { W = P.w_up; K = 1024; N = DFF; WT = (bf16_t*)(ws + WS_WGU0); sc = P.norm_ffn; mode = 2; }
            else if (r < 2816) { r -= 1408; W = P.w_down; K = DFF; N = 1024; WT = (bf16_t*)(ws + WS_WD0); sc = nullptr; }
            else if (r < 2816 + 512) { r -= 2816; W = P.ple_w_gate; K = 1024; N = 1024; WT = (bf16_t*)(ws + WS_WPG0); sc = P.ple_norm; }
            else { r -= 2816 + 512; W = P.ple_w_proj; K = 256; N = 1024; WT = (bf16_t*)(ws + WS_WPP0); sc = nullptr; }
        } else if (stage == 3) {
            if (r < 512) { W = P.w_q; K = 1024; N = 1024; WT = (bf16_t*)(ws + WS_WQKV); sc = P.norm_mix + 1024; }
            else if (r < 512 + 128) { r -= 512; W = P.w_kv; K = 1024; N = 256; WT = (bf16_t*)(ws + WS_WQKV); sc = P.kv_norm; roff = 1024; }
            else { r -= 512 + 128; W = P.w_o; K = 1024; N = 1024; WT = (bf16_t*)(ws + WS_WO); sc = nullptr; }
        } else if (stage == 4) {
            if (r < 512) { W = P.ple_w_gate + 1024 * 1024; K = 1024; N = 1024; WT = (bf16_t*)(ws + WS_WPG0 + 2 * MiB); sc = P.ple_norm + 1024; }
            else { r -= 512; W = P.ple_w_proj + 256 * 1024; K = 256; N = 1024; WT = (bf16_t*)(ws + WS_WPP0 + 512 * 1024); sc = nullptr; }
        } else if (stage == 7) { W = P.w_gate + (size_t)1024 * DFF; K = 1024; N = DFF; WT = (bf16_t*)(ws + WS_WGU0 + 11 * MiB); sc = P.norm_ffn + 1024; mode = 1; }
        else if (stage == 8) { W = P.w_up + (size_t)1024 * DFF; K = 1024; N = DFF; WT = (bf16_t*)(ws + WS_WGU0 + 11 * MiB); sc = P.norm_ffn + 1024; mode = 2; }
        else { W = P.w_down + (size_t)DFF * 1024; K = DFF; N = 1024; WT = (bf16_t*)(ws + WS_WD0 + 5632 * 1024); sc = nullptr; }
        tr_item(W, K, N, WT, sc, mode, roff, scr, r, lane);
    }
    if (stage == 0) {
        bf16_t* XBA = (bf16_t*)(ws + WS_XBA); float* SSA = (float*)(ws + WS_SSA);
        for (int m = gw; m < MT; m += 2 * NGW) {
            const int m2 = m + NGW; const bool has2 = m2 < MT; const int mb = has2 ? m2 : m;
            const float* src = m < MP ? P.x_prompt + (size_t)m * DM : P.x_sample + (size_t)(m - MP) * DM;
            const float* src2 = mb < MP ? P.x_prompt + (size_t)mb * DM : P.x_sample + (size_t)(mb - MP) * DM;
            f32x4 va[4], vb[4];
#pragma unroll
            for (int j = 0; j < 2; ++j) { va[2 * j] = *((const f32x4*)src + 128 * j + 2 * lane); va[2 * j + 1] = *((const f32x4*)src + 128 * j + 2 * lane + 1); vb[2 * j] = *((const f32x4*)src2 + 128 * j + 2 * lane); vb[2 * j + 1] = *((const f32x4*)src2 + 128 * j + 2 * lane + 1); }
            float s = 0.f, s2 = 0.f;
#pragma unroll
            for (int j = 0; j < 2; ++j) { s += dot4(va[2 * j]) + dot4(va[2 * j + 1]); s2 += dot4(vb[2 * j]) + dot4(vb[2 * j + 1]);
                *((u32x4*)(XBA + (size_t)m * DM) + 64 * j + lane) = pack8(va[2 * j], va[2 * j + 1]); if (has2) *((u32x4*)(XBA + (size_t)m2 * DM) + 64 * j + lane) = pack8(vb[2 * j], vb[2 * j + 1]); }
            s = wave_sum(s, lane); s2 = wave_sum(s2, lane);
            if (lane == 0) { ss_set(SSA, m, s); ss_set((float*)(ws + WS_SSB), m, 0.f); ss_set((float*)(ws + WS_VSS), m, 0.f); if (has2) { ss_set(SSA, m2, s2); ss_set((float*)(ws + WS_SSB), m2, 0.f); ss_set((float*)(ws + WS_VSS), m2, 0.f); } }
        }
        const int gt = blockIdx.x * 512 + tid, NGT = 256 * 512;
        bf16_t* WTT = (bf16_t*)(ws + WS_WTRIL);
        for (int i = gt; i < 8 * 128 * 128 / 2; i += NGT) { const int e = 2 * i, sx = e & 127, t = (e >> 7) & 127;
            const float a = sx <= t ? P.gm_w_s[e] : 0.f, b = (sx + 1) <= t ? P.gm_w_s[e + 1] : 0.f; ((unsigned*)WTT)[i] = cvt_pk_bf16(a, b); }
        float* rope = (float*)(ws + WS_ROPE);
        for (int i = gt; i < 8196 * 8; i += NGT) { const int pi = i >> 3, f = i & 7; const int pos = pi < SEQ ? pi : 16384 + (pi - SEQ);
            const float inv = __builtin_powf(500000.0f, -(float)f * 0.125f); const float ang = (float)pos * inv;
            double rev = (double)ang * 0.15915494309189535; rev -= __builtin_rint(rev); const float rf = (float)rev;
            rope[pi * 16 + f] = __builtin_amdgcn_cosf(rf); rope[pi * 16 + 8 + f] = __builtin_amdgcn_sinf(rf); }
    }
    if (stage == 4 || stage == 6) {
        const int L = stage == 6 ? 1 : 0;
        bf16_t* PB = (bf16_t*)(ws + WS_PB) + (size_t)L * MT * PLE;
        for (int m0 = gw; m0 < MT; m0 += 4 * NGW) {
            f32x4 v[4];
#pragma unroll
            for (int q = 0; q < 4; ++q) { const int m = m0 + q * NGW < MT ? m0 + q * NGW : m0;
                const float* src = m < MP ? P.p_prompt + ((size_t)L * MP + m) * PLE : P.p_sample + ((size_t)L * MS + (m - MP)) * PLE; v[q] = *((const f32x4*)src + lane); }
#pragma unroll
            for (int q = 0; q < 4; ++q) { const int m = m0 + q * NGW; if (m < MT) *((u32x2*)(PB + (size_t)m * PLE) + lane) = pack4(v[q]); }
        }
    }
}

__device__ __forceinline__ void gating_phase(LAS unsigned char* lds, int G, int wave0) {
    const Params P = load_params(lds);
    const int tid = opaque_tid(wave0), lane = tid & 63, wave = tid >> 6, fr = lane & 15, fq = lane >> 4;
    unsigned char* ws = P.ws;
    bf16_t* Z = (bf16_t*)(ws + WS_Z); const float* VSS = (const float*)(ws + WS_VSS); const bf16_t* WTR = (const bf16_t*)(ws + WS_WTRIL);
    LAS bf16_t* Vs = (LAS bf16_t*)lds;
    LAS float* rsb = (LAS float*)(lds + 128 * 264 * 2);
    LAS bf16_t* Wsl = (LAS bf16_t*)(lds + 69632);
    LAS float* vws = (LAS float*)(lds + 69632 + 128 * 136 * 2);
    LAS float* bsl = vws + 256;
    { const int g0 = (int)blockIdx.x & 7;
      for (int i = tid; i < 2048; i += 512) { const int row = i >> 4, c8 = (i & 15) * 8; *(LAS u32x4*)(Wsl + row * 136 + c8) = *(const u32x4*)(WTR + (size_t)(g0 * 128 + row) * 128 + c8); }
      if (tid < 64) *(LAS f32x4*)(vws + 4 * tid) = *(const f32x4*)(P.gm_v_norm + 256 * g0 + 4 * tid);
      else if (tid < 96) *(LAS f32x4*)(bsl + 4 * (tid - 64)) = *(const f32x4*)(P.gm_b_s + 128 * g0 + 4 * (tid - 64)); }
    u32x4 raw[8]; float rsn[8];
#define GATE_FETCH(un) do { const int ch_ = (un) >> 3, g_ = (un) & 7; _Pragma("unroll") for (int j = 0; j < 8; ++j) { const int idx = tid + 512 * j, r = idx >> 5, c8 = (idx & 31) * 8; \
        raw[j] = *(const u32x4*)(Z + (size_t)(ch_ * 128 + r) * 4096 + 2048 + 256 * g_ + c8); rsn[j] = ss_get(VSS, ch_ * 128 + r); } } while (0)
    if ((int)blockIdx.x < 2048) GATE_FETCH(blockIdx.x);
    __syncthreads();
    for (int unit = blockIdx.x; unit < 2048; unit += G) {
        const int ch = unit >> 3, g = unit & 7, row0 = ch * 128;
#pragma unroll
        for (int j = 0; j < 8; ++j) { const int idx = tid + 512 * j, r = idx >> 5, c8 = (idx & 31) * 8;
            const f32x4 wa = *(const LAS f32x4*)(vws + c8), wb = *(const LAS f32x4*)(vws + c8 + 4);
            const float rs = __builtin_amdgcn_rsqf(rsn[j] * (1.0f / 2048.0f) + EPS);
            const u32x4 rw = raw[j]; u32x4 o;
            o.x = cvt_pk_bf16(bf2f(rw.x & 0xffffu) * rs * wa[0], bf2f(rw.x >> 16) * rs * wa[1]);
            o.y = cvt_pk_bf16(bf2f(rw.y & 0xffffu) * rs * wa[2], bf2f(rw.y >> 16) * rs * wa[3]);
            o.z = cvt_pk_bf16(bf2f(rw.z & 0xffffu) * rs * wb[0], bf2f(rw.z >> 16) * rs * wb[1]);
            o.w = cvt_pk_bf16(bf2f(rw.w & 0xffffu) * rs * wb[2], bf2f(rw.w >> 16) * rs * wb[3]);
            *(LAS u32x4*)(Vs + r * 264 + c8) = o; }
        __syncthreads();
        if (unit + G < 2048) GATE_FETCH(unit + G);
        bf16x8 vf[4][2];
#pragma unroll
        for (int ks = 0; ks < 4; ++ks)
#pragma unroll
            for (int nt = 0; nt < 2; ++nt)
#pragma unroll
                for (int j = 0; j < 8; ++j) vf[ks][nt][j] = (short)Vs[(32 * ks + 8 * fq + j) * 264 + 32 * wave + 8 * (fr >> 2) + 4 * nt + (fr & 3)];
        u32x4 uu[8];
#pragma unroll
        for (int mt = 0; mt < 8; ++mt) uu[mt] = *(const u32x4*)(Z + (size_t)(row0 + 16 * mt + fr) * 4096 + 256 * g + 32 * wave + 8 * fq);
#pragma unroll
        for (int mt = 0; mt < 8; ++mt) {
            f32x4 a2[2] = {(f32x4){0.f, 0.f, 0.f, 0.f}, (f32x4){0.f, 0.f, 0.f, 0.f}};
#pragma unroll
            for (int ks = 0; ks < 4; ++ks) if (32 * ks <= 16 * mt + 15) {
                const bf16x8 wf = *(const LAS bf16x8*)(Wsl + (16 * mt + fr) * 136 + 32 * ks + 8 * fq);
#pragma unroll
                for (int nt = 0; nt < 2; ++nt) a2[nt] = __builtin_amdgcn_mfma_f32_16x16x32_bf16(vf[ks][nt], wf, a2[nt], 0, 0, 0);
            }
            const int t = 16 * mt + fr; const float bias = bsl[t];
            *(u32x4*)(Z + (size_t)(row0 + t) * 4096 + 256 * g + 32 * wave + 8 * fq) = pack8(unpack4((u32x2){uu[mt].x, uu[mt].y}) * (a2[0] + bias), unpack4((u32x2){uu[mt].z, uu[mt].w}) * (a2[1] + bias));
        }
        __syncthreads();
    }
#undef GATE_FETCH
    float* gmv = P.out + O_GMV;
    for (int b = blockIdx.x; b < 128; b += G) {
        const int row0 = MP + 4 * b;
        if (tid < 4) rsb[tid] = __builtin_amdgcn_rsqf(ss_get(VSS, row0 + tid) * (1.0f / 2048.0f) + EPS);
        __syncthreads();
        const int c = 4 * tid, g = c >> 8;
        const f32x4 vw = *(const f32x4*)(P.gm_v_norm + c);
        f32x4 v[4];
#pragma unroll
        for (int s = 0; s < 4; ++s) { v[s] = unpack4(*(const u32x2*)(Z + (size_t)(row0 + s) * 4096 + 2048 + c)) * rsb[s] * vw; *(f32x4*)(gmv + (size_t)(4 * b + s) * GH + c) = v[s]; }
#pragma unroll
        for (int t = 0; t < 4; ++t) { const float bias = P.gm_b_s[g * 128 + t]; f32x4 mx = (f32x4){bias, bias, bias, bias};
#pragma unroll
            for (int s = 0; s <= t; ++s) mx = mx + v[s] * P.gm_w_s[(g * 128 + t) * 128 + s];
            bf16_t* zp = Z + (size_t)(row0 + t) * 4096 + c; *(u32x2*)zp = pack4(unpack4(*(const u32x2*)zp) * mx); }
        __syncthreads();
    }
}

__device__ __forceinline__ void fixup_phase(LAS unsigned char* lds, int L, int G, int wave0) {
    const Params P = load_params(lds);
    unsigned char* ws = P.ws;
    const f32x4* HG = (const f32x4*)(ws + WS_HG); const f32x4* C0 = (const f32x4*)(ws + WS_C0); const f32x4* U0 = (const f32x4*)(ws + WS_U0);
    bf16_t* ACT = (bf16_t*)(ws + WS_Z);
    const f32x4* cw = (const f32x4*)(P.conv_w + (size_t)L * 3 * DFF);
    const int gt = blockIdx.x * 512 + opaque_tid(wave0), NGT = G * 512;
    for (int idx = gt; idx < 1024 * 704; idx += NGT) {
        const int gj = idx / 704, c4 = idx % 704, grp = gj >> 1, j = gj & 1, r = 64 * grp + j;
        f32x4 conv = C0[idx]; const f32x4 up = U0[idx];
        if ((grp & 127) != 0) { const f32x4 h0 = HG[(size_t)((grp - 1) * 2) * 704 + c4], h1 = HG[(size_t)((grp - 1) * 2 + 1) * 704 + c4]; const f32x4 w0 = cw[c4], w1 = cw[704 + c4];
            conv = conv + (j == 0 ? (w0 * h0 + w1 * h1) : (w0 * h1)); }
        *(u32x2*)(ACT + (size_t)r * DFF + 4 * c4) = pack4(gelu4(conv) * up);
    }
    for (int i = gt; i < MT; i += NGT) { ((unsigned*)(ws + WS_SSA))[i] = 0u; ((unsigned*)(ws + WS_SSB))[i] = 0u; }
    f32x4* ncp = (f32x4*)(P.out + O_NCP + (size_t)L * 4 * 2 * DFF);
    for (int idx = gt; idx < 8 * 704; idx += NGT) { const int bj = idx / 704, c4 = idx % 704, b = bj >> 1, j = bj & 1; ncp[idx] = HG[(size_t)((128 * b + 127) * 2 + j) * 704 + c4]; }
}

__device__ __forceinline__ void attn_phase(LAS unsigned char* lds, int G, int wave0, int odummy) {
    const Params P = load_params(lds);
    const int tid = opaque_tid(wave0), lane = tid & 63, wave = tid >> 6, fr = lane & 15, fq = lane >> 4;
    unsigned char* ws = P.ws;
    bf16_t* Q = (bf16_t*)(ws + WS_Z + 195 * MiB); bf16_t* Oout = odummy ? (bf16_t*)(ws + WS_Z + 130 * MiB) : Q; const bf16_t* KB = (const bf16_t*)(ws + WS_KB); const bf16_t* VB = (const bf16_t*)(ws + WS_VB);
    LAS bf16_t* Ks = (LAS bf16_t*)lds;
    LAS bf16_t* VTs = (LAS bf16_t*)(lds + 256 * 72 * 2);
    for (int i = blockIdx.x * 512 + tid; i < MT; i += G * 512) ((unsigned*)(ws + WS_SSB))[i] = 0u;
    for (int unit = blockIdx.x; unit < 768; unit += G) {
        const bool samp = unit >= 512;
        const int kvh = unit & 1;
        int b, qb;
        if (!samp) { b = unit >> 7; qb = (unit >> 1) & 63; } else { b = (unit - 512) >> 1; qb = 1; }
#pragma unroll
        for (int j = 0; j < 4; ++j) {
            const int idx = tid + 512 * j, r = idx >> 3, c8 = (idx & 7) * 8;
            u32x4 kv = (u32x4){0u, 0u, 0u, 0u}, vv = (u32x4){0u, 0u, 0u, 0u};
            if (!samp) { const int t = 128 * (qb - 1) + r; if (t >= 0) { const size_t go = (size_t)(b * SEQ + t) * KVD + kvh * 64 + c8; kv = *(const u32x4*)(KB + go); vv = *(const u32x4*)(VB + go); } }
            else if (r < 128) { const size_t go = ((size_t)(b * 128 + r) * 2 + kvh) * 64 + c8;
                const f32x4 k0 = *(const f32x4*)(P.cache_k + go), k1 = *(const f32x4*)(P.cache_k + go + 4), v0 = *(const f32x4*)(P.cache_v + go), v1 = *(const f32x4*)(P.cache_v + go + 4);
                kv = (u32x4){cvt_pk_bf16(k0[0], k0[1]), cvt_pk_bf16(k0[2], k0[3]), cvt_pk_bf16(k1[0], k1[1]), cvt_pk_bf16(k1[2], k1[3])};
                vv = (u32x4){cvt_pk_bf16(v0[0], v0[1]), cvt_pk_bf16(v0[2], v0[3]), cvt_pk_bf16(v1[0], v1[1]), cvt_pk_bf16(v1[2], v1[3])}; }
            else if (r < 132) { const size_t go = (size_t)(MP + 4 * b + (r - 128)) * KVD + kvh * 64 + c8; kv = *(const u32x4*)(KB + go); vv = *(const u32x4*)(VB + go); }
            *(LAS u32x4*)(Ks + r * 72 + c8) = kv;
            const int sp = r & 31, kk = (r & ~31) + 8 * ((sp & 15) >> 2) + 4 * (sp >> 4) + (sp & 3);
            LAS bf16_t* vt = VTs + c8 * 264 + kk;
            vt[0 * 264] = (bf16_t)(vv.x & 0xffffu); vt[1 * 264] = (bf16_t)(vv.x >> 16); vt[2 * 264] = (bf16_t)(vv.y & 0xffffu); vt[3 * 264] = (bf16_t)(vv.y >> 16);
            vt[4 * 264] = (bf16_t)(vv.z & 0xffffu); vt[5 * 264] = (bf16_t)(vv.z >> 16); vt[6 * 264] = (bf16_t)(vv.w & 0xffffu); vt[7 * 264] = (bf16_t)(vv.w >> 16);
        }
        __syncthreads();
        const int lane_ = lane; const int h = kvh * 8 + wave; const float sink = P.sinks[h] * LOG2E;
        const int nrt = samp ? 1 : 8;
        const bool fastp = !samp && qb > 0;
        const int dq = 4 * fq - fr;
#pragma unroll 1
        for (int rt2 = 0; rt2 < nrt; rt2 += 2) {
#pragma unroll
          for (int PAR = 0; PAR < 2; ++PAR) {
            const int rt = rt2 + PAR;
            if (rt >= nrt) break;
            const int rowq = samp ? (MP + 4 * b + (fr & 3)) : (b * SEQ + qb * 128 + rt * 16 + fr);
            const int qi = samp ? fr : 16 * rt + fr;
            const int kt0 = samp ? 0 : rt2;
            bf16x8 qf[2];
#pragma unroll
            for (int k = 0; k < 2; ++k) qf[k] = *(const bf16x8*)(Q + (size_t)rowq * 1024 + h * 64 + 32 * k + 8 * fq);
            f32x4 S[10];
#pragma unroll
            for (int i = 0; i < 10; ++i) { f32x4 a = (f32x4){0.f, 0.f, 0.f, 0.f};
                const int c = i - PAR;
                if (!(fastp && (c < 0 || c > 8))) {
#pragma unroll
                    for (int k = 0; k < 2; ++k) { const bf16x8 kf = *(const LAS bf16x8*)(Ks + (16 * (kt0 + i) + fr) * 72 + 32 * k + 8 * fq); a = __builtin_amdgcn_mfma_f32_16x16x32_bf16(kf, qf[k], a, 0, 0, 0); } }
                S[i] = a; }
            float mx = sink;
            if (fastp) {
#pragma unroll
                for (int i = 0; i < 10; ++i) { const int c = i - PAR;
                    if (c < 0 || c > 8) continue;
#pragma unroll
                    for (int j = 0; j < 4; ++j) {
                        if (c == 0) { if (!(dq + j > 0)) S[i][j] = -1e30f; }
                        else if (c == 8) { if (!(dq + j <= 0)) S[i][j] = -1e30f; }
                        mx = fmaxf(mx, S[i][j]); } }
            } else {
#pragma unroll
                for (int i = 0; i < 10; ++i)
#pragma unroll
                    for (int j = 0; j < 4; ++j) { const int kw = 16 * (kt0 + i) + 4 * fq + j;
                        const bool vis = (kw > qi) && (kw <= qi + 128) && (samp ? (kw < 132) : (qb > 0 || kw >= 128));
                        const float sv = vis ? S[i][j] : -1e30f; S[i][j] = sv; mx = fmaxf(mx, sv); }
            }
            mx = xmax16(mx); mx = xmax32(mx);
            float sum = 0.f;
#pragma unroll
            for (int i = 0; i < 10; ++i) { const int c = i - PAR;
                if (fastp && (c < 0 || c > 8)) { S[i] = (f32x4){0.f, 0.f, 0.f, 0.f}; continue; }
#pragma unroll
                for (int j = 0; j < 4; ++j) { const float e = __builtin_amdgcn_exp2f(S[i][j] - mx); S[i][j] = e; sum += e; } }
            sum = xsum16(sum); sum = xsum32(sum);
            const float inv = 1.0f / (sum + __builtin_amdgcn_exp2f(sink - mx));
            f32x4 o[4] = {(f32x4){0.f, 0.f, 0.f, 0.f}, (f32x4){0.f, 0.f, 0.f, 0.f}, (f32x4){0.f, 0.f, 0.f, 0.f}, (f32x4){0.f, 0.f, 0.f, 0.f}};
#pragma unroll
            for (int i = 0; i < 5; ++i) {
                const f32x4 p0 = S[2 * i] * inv, p1 = S[2 * i + 1] * inv;
                const u32x4 pw = (u32x4){cvt_pk_bf16(p0[0], p0[1]), cvt_pk_bf16(p0[2], p0[3]), cvt_pk_bf16(p1[0], p1[1]), cvt_pk_bf16(p1[2], p1[3])};
                const bf16x8 pf = __builtin_bit_cast(bf16x8, pw);
#pragma unroll
                for (int dt = 0; dt < 4; ++dt) { const bf16x8 vfr = *(const LAS bf16x8*)(VTs + (32 * (dt >> 1) + 8 * (fr >> 2) + 4 * (dt & 1) + (fr & 3)) * 264 + 32 * ((kt0 >> 1) + i) + 8 * fq); o[dt] = __builtin_amdgcn_mfma_f32_16x16x32_bf16(vfr, pf, o[dt], 0, 0, 0); }
            }
            if (!samp || fr < 4) {
#pragma unroll
                for (int dp = 0; dp < 2; ++dp) *(u32x4*)(Oout + (size_t)rowq * 1024 + h * 64 + 32 * dp + 8 * fq) = pack8(o[2 * dp], o[2 * dp + 1]);
            }
          }
        }
        __syncthreads();
    }
}

__device__ __forceinline__ void final_phase(LAS unsigned char* lds, int G, int wave0) {
    const Params P = load_params(lds);
    const int tid = opaque_tid(wave0), lane = tid & 63, wave = tid >> 6;
    const float* SSB = (const float*)(P.ws + WS_SSB);
    const bf16_t* XB = (const bf16_t*)(P.ws + WS_Z + 130 * MiB);
    const int gw = blockIdx.x * 8 + wave, NGW = G * 8;
    f32x4 w[4];
#pragma unroll
    for (int j = 0; j < 2; ++j) { w[2 * j] = *((const f32x4*)P.final_norm + 128 * j + 2 * lane); w[2 * j + 1] = *((const f32x4*)P.final_norm + 128 * j + 2 * lane + 1); }
    for (int m = gw; m < MT; m += 2 * NGW) {
        const int m2 = m + NGW < MT ? m + NGW : m;
        const float rs = rstd16(SSB, m), rs2 = rstd16(SSB, m2);
        u32x4 a[2], b[2];
#pragma unroll
        for (int j = 0; j < 2; ++j) { a[j] = *((const u32x4*)(XB + (size_t)m * DM) + 64 * j + lane); b[j] = *((const u32x4*)(XB + (size_t)m2 * DM) + 64 * j + lane); }
        f32x4* yr = (f32x4*)(P.out + (size_t)m * DM); f32x4* yr2 = (f32x4*)(P.out + (size_t)m2 * DM);
#pragma unroll
        for (int j = 0; j < 2; ++j) {
            yr[128 * j + 2 * lane] = unpack4((u32x2){a[j].x, a[j].y}) * rs * w[2 * j]; yr[128 * j + 2 * lane + 1] = unpack4((u32x2){a[j].z, a[j].w}) * rs * w[2 * j + 1];
            if (m2 != m) { yr2[128 * j + 2 * lane] = unpack4((u32x2){b[j].x, b[j].y}) * rs2 * w[2 * j]; yr2[128 * j + 2 * lane + 1] = unpack4((u32x2){b[j].z, b[j].w}) * rs2 * w[2 * j + 1]; }
        }
    }
}

#define XB_TMO      128
#define XB_XCNT(j)  (256  + 64 * (j))
#define XB_XSUB(j)  (1280 + 64 * (j))
#define XB_XGEN(j)  (2304 + 64 * (j))
#define XB_TOP      3328
#define XB_TOPGEN   3392
#define XCD_BAR_WORDS 3456
#define XB_SPIN_CAP (1u << 18)
__device__ __forceinline__ unsigned xb_ld(unsigned* p)              { return __hip_atomic_load(p, __ATOMIC_RELAXED, __HIP_MEMORY_SCOPE_AGENT); }
__device__ __forceinline__ unsigned xb_add(unsigned* p, unsigned v) { return __hip_atomic_fetch_add(p, v, __ATOMIC_RELAXED, __HIP_MEMORY_SCOPE_AGENT); }
__device__ __forceinline__ unsigned xb_xcc_id() { return (unsigned)__builtin_amdgcn_s_getreg((3 << 11) | 20) & 0xFu; }
#define XB_SPIN(cond, bar) do { unsigned _sp = 0; while (cond) { __builtin_amdgcn_s_sleep(1); \
    if ((++_sp & 255u) == 0u) { if (xb_ld(&(bar)[XB_TMO])) break; if (_sp > XB_SPIN_CAP) { atomicAdd(&(bar)[XB_TMO], 1u); break; } } } } while (0)
struct XcdBarrier { unsigned* bar; unsigned x; volatile LAS unsigned* st; };
__device__ __forceinline__ XcdBarrier xcd_barrier_post(unsigned* bar, volatile LAS unsigned* st) {
    XcdBarrier b; b.bar = bar; b.x = xb_xcc_id(); b.st = st;
    if (threadIdx.x == 0) (void)xb_add(&bar[XB_XCNT(b.x)], 1u);
    return b;
}
__device__ __forceinline__ void xcd_barrier_complete(unsigned* bar, unsigned x, unsigned& nloc, unsigned& nx) {
    const unsigned G = gridDim.x * gridDim.y * gridDim.z;
    unsigned sum, cnt, mine, sp = 0u;
    for (;;) {
        sum = 0u; cnt = 0u; mine = 0u;
#pragma unroll
        for (unsigned j = 0; j < 16; ++j) { const unsigned c = xb_ld(&bar[XB_XCNT(j)]); sum += c; cnt += (c > 0u) ? 1u : 0u; mine = (j == x) ? c : mine; }
        if (sum == G) break;
        __builtin_amdgcn_s_sleep(1);
        if ((++sp & 255u) == 0u) { if (xb_ld(&bar[XB_TMO])) break; if (sp > XB_SPIN_CAP) { atomicAdd(&bar[XB_TMO], 1u); break; } }
    }
    nloc = mine > 0u ? mine : 1u; nx = cnt > 0u ? cnt : 1u;
}
__device__ __forceinline__ void xcd_barrier(const XcdBarrier& b) {
    asm volatile("s_waitcnt vmcnt(0)" ::: "memory");
    __syncthreads();
    if (threadIdx.x == 0) {
        unsigned* bar = b.bar;
        __builtin_amdgcn_s_waitcnt(0);
        unsigned nloc = b.st[0], nx = b.st[1];
        if (nloc == 0u) { xcd_barrier_complete(bar, b.x, nloc, nx); b.st[0] = nloc; b.st[1] = nx; }
        const unsigned old = xb_add(&bar[XB_XSUB(b.x)], 1u);
        const unsigned gen = old / nloc;
        if (old + 1u == (gen + 1u) * nloc) {
            __builtin_amdgcn_fence(__ATOMIC_RELEASE, "agent");
            asm volatile("s_waitcnt vmcnt(0)" ::: "memory");
            const unsigned og = xb_add(&bar[XB_TOP], 1u);
            const unsigned tg = og / nx;
            if (og + 1u == (tg + 1u) * nx) xb_add(&bar[XB_TOPGEN], 1u);
            else XB_SPIN(xb_ld(&bar[XB_TOPGEN]) == tg, bar);
            __builtin_amdgcn_fence(__ATOMIC_ACQUIRE, "agent");
            xb_add(&bar[XB_XGEN(b.x)], 1u);
            asm volatile("s_waitcnt vmcnt(0)" ::: "memory");
        } else {
            XB_SPIN(xb_ld(&bar[XB_XGEN(b.x)]) == gen, bar);
            __builtin_amdgcn_fence(__ATOMIC_ACQUIRE, "agent");
            asm volatile("s_waitcnt vmcnt(0)" ::: "memory");
        }
    }
    __syncthreads();
}

constexpr int LDS_BYTES = 147456;
__global__ void __launch_bounds__(512, 2) yoco_fwd(Params Pk) {
    extern __shared__ __attribute__((aligned(16))) unsigned char lds_raw[];
    LAS unsigned char* lds = (LAS unsigned char*)lds_raw;
    cg::grid_group grid = cg::this_grid();
#ifndef PROBE_MASK
#define PROBE_MASK 0u
#endif
#if PROBE == 1
#define GSYNC() do { xcd_barrier(xbar); xcd_barrier(xbar); } while (0)
#elif PROBE_MASK != 0u
    int ph_ = 1; unsigned long long tprev_ = __builtin_amdgcn_s_memrealtime();
#define GSYNC() do { xcd_barrier(xbar); unsigned long long tn_ = __builtin_amdgcn_s_memrealtime(); \
        if ((PROBE_MASK >> ph_) & 1u) { if (blockIdx.x == 0) { while (__builtin_amdgcn_s_memrealtime() - tn_ < tn_ - tprev_) __builtin_amdgcn_s_sleep(8); } xcd_barrier(xbar); tn_ = __builtin_amdgcn_s_memrealtime(); } \
        tprev_ = tn_; ++ph_; } while (0)
#else
#define GSYNC() do { XcdBarrier xb_; { unsigned po_ = PARAM_OFF; asm volatile("" : "+v"(po_)); xb_.bar = (unsigned*)(__attribute__((address_space(1))) unsigned*)ldq(lds + po_, 29) + 4096; } xb_.x = xb_xcc_id(); xb_.st = (volatile LAS unsigned*)(lds + 131072 + 512); xcd_barrier(xb_); } while (0)
#endif
#ifndef PHM
#define PHM 0xffff
#endif
#if PROBE >= 3
#define REP_BEGIN(id) { int nrep_ = (PROBE == (id)) ? 2 : 1; asm volatile("" : "+s"(nrep_)); _Pragma("unroll 1") for (int r_ = 0; r_ < nrep_; ++r_) {
#define REP_END() } }
#else
#define REP_BEGIN(id) {
#define REP_END() }
#endif
    constexpr int G = 256;
    const int wave0 = __builtin_amdgcn_readfirstlane((int)threadIdx.x >> 6);
    volatile LAS unsigned* xst = (volatile LAS unsigned*)(lds + 131072 + 512);
    if (threadIdx.x < 2) xst[threadIdx.x] = 0u;
    if (threadIdx.x < 30) ((LAS unsigned long long*)(lds + PARAM_OFF))[threadIdx.x] = ((const unsigned long long*)&Pk)[threadIdx.x];
    __syncthreads();
    XcdBarrier xbar = xcd_barrier_post((unsigned*)Pk.ws + 4096, xst);

    if (PHM & 1) conv_stage(lds, 0, 0, wave0);
    if (Pk.ws == nullptr) grid.sync();
    xcd_barrier(xbar);
#if PROBE_MASK != 0u
    { unsigned long long tn_ = __builtin_amdgcn_s_memrealtime();
      if (PROBE_MASK & 1u) { if (blockIdx.x == 0) { while (__builtin_amdgcn_s_memrealtime() - tn_ < tn_ - tprev_) __builtin_amdgcn_s_sleep(8); } xcd_barrier(xbar); tn_ = __builtin_amdgcn_s_memrealtime(); }
      tprev_ = tn_; }
#endif
#pragma unroll 1
    for (int L = 0; L < 2; ++L) {
        pg8::StaticOrder S;
        if (L == 0) {
            { const Params P = load_params(lds); unsigned char* ws = P.ws;
              pg8::Gemm g{(const bf16_t*)(ws + WS_XBA), (const bf16_t*)(ws + WS_WIN), MT, 4096, 1024, 1024}; S.init(MP, 4096, G, blockIdx.x);
              EpiGm E{(const float*)(ws + WS_SSA), (bf16_t*)(ws + WS_Z), (float*)(ws + WS_VSS)}; if (PHM & 2) pg8::gemm_phase<EpiGm>(lds, g, S, E, wave0); }
            conv_stage(lds, 1, 64, wave0);
            GSYNC();
            if (PHM & 4) gating_phase(lds, G, wave0);
            GSYNC();
        } else {
            { const Params P = load_params(lds); unsigned char* ws = P.ws;
              pg8::Gemm g{(const bf16_t*)(ws + WS_Z + 130 * MiB), (const bf16_t*)(ws + WS_WQKV), MT, 1280, 1024, 1024}; S.init(MP, 1280, G, blockIdx.x);
              EpiQKV E{(const float*)(ws + WS_SSB), (const float*)(ws + WS_ROPE), (bf16_t*)(ws + WS_Z + 195 * MiB), (bf16_t*)(ws + WS_KB), (bf16_t*)(ws + WS_VB), P.out};
              if (PHM & 8) pg8::gemm_phase<EpiQKV>(lds, g, S, E, wave0); }
            GSYNC();
#if PROBE == 2
            attn_phase(lds, G, wave0, 1);
#endif
            if (PHM & 16) attn_phase(lds, G, wave0, 0);
            GSYNC();
        }
        { const Params P = load_params(lds); unsigned char* ws = P.ws;
          pg8::Gemm g{(const bf16_t*)(ws + WS_Z + (L == 0 ? 0 : 195 * MiB)), (const bf16_t*)(ws + (L == 0 ? WS_WOUT : WS_WO)), MT, 1024, L == 0 ? 2048 : 1024, L == 0 ? 4096 : 1024}; S.init(MP, 1024, G, blockIdx.x);
          EpiRes E{(const bf16_t*)(ws + (L == 0 ? WS_XBA : WS_Z + 130 * MiB)), (bf16_t*)(ws + WS_XBA), (float*)(ws + WS_SSB)}; if (PHM & 32) pg8::gemm_phase<EpiRes>(lds, g, S, E, wave0); }
        if (L == 0) conv_stage(lds, 2, 16, wave0); else conv_stage(lds, 8, 16, wave0);
        GSYNC();
        { const Params P = load_params(lds); unsigned char* ws = P.ws;
          pg8::Gemm g{(const bf16_t*)(ws + WS_XBA), (const bf16_t*)(ws + WS_WGU0 + (size_t)L * 11 * MiB), MT, 2 * DFF, 1024, 1024}; S.init(MP, 2 * DFF, G, blockIdx.x);
          EpiGU E{(const float*)(ws + WS_SSB), (bf16_t*)(ws + WS_Z), P.conv_w + (size_t)L * 3 * DFF, P.conv_b + (size_t)L * DFF, (float*)(ws + WS_HG), (float*)(ws + WS_C0), (float*)(ws + WS_U0),
                  P.state + (size_t)L * 128 * 2 * DFF, P.out + O_NCS + (size_t)L * 128 * 2 * DFF};
          REP_BEGIN(3) if (PHM & 64) pg8::gemm_phase<EpiGU>(lds, g, S, E, wave0); REP_END()
        }
        if (L == 0) conv_stage(lds, 3, 88, wave0); else conv_stage(lds, 5, 88, wave0);
        GSYNC();
        if (PHM & 128) fixup_phase(lds, L, G, wave0);
        GSYNC();
        { const Params P = load_params(lds); unsigned char* ws = P.ws;
          pg8::Gemm g{(const bf16_t*)(ws + WS_Z), (const bf16_t*)(ws + WS_WD0 + (size_t)L * 5632 * 1024), MT, 1024, DFF, DFF}; S.init(MP, 1024, G, blockIdx.x);
          EpiRes E{(const bf16_t*)(ws + WS_XBA), (bf16_t*)(ws + WS_XBA), (float*)(ws + WS_SSA)}; if (PHM & 256) pg8::gemm_phase<EpiRes>(lds, g, S, E, wave0); }
        if (L == 0) conv_stage(lds, 4, 16, wave0); else conv_stage(lds, 6, 16, wave0);
        GSYNC();
        { const Params P = load_params(lds); unsigned char* ws = P.ws;
          pg8::Gemm g{(const bf16_t*)(ws + WS_PB) + (size_t)L * MT * PLE, (const bf16_t*)(ws + WS_WPP0 + (size_t)L * 512 * 1024), MT, 1024, 256, 256}; S.init(MP, 1024, G, blockIdx.x);
          EpiBf E{(bf16_t*)(ws + WS_Z)}; if (PHM & 512) pg8::gemm_phase<EpiBf>(lds, g, S, E, wave0); }
        { const Params P = load_params(lds); unsigned char* ws = P.ws;
          pg8::Gemm g{(const bf16_t*)(ws + WS_XBA), (const bf16_t*)(ws + WS_WPG0 + (size_t)L * 2 * MiB), MT, 1024, 1024, 1024}; S.init(MP, 1024, G, blockIdx.x);
          EpiPle E{(const float*)(ws + WS_SSA), (const bf16_t*)(ws + WS_Z), (const bf16_t*)(ws + WS_XBA), (bf16_t*)(ws + WS_Z + 130 * MiB), (float*)(ws + WS_SSB)}; if (PHM & 1024) pg8::gemm_phase<EpiPle>(lds, g, S, E, wave0); }
        if (L == 0) conv_stage(lds, 7, 16, wave0);
        GSYNC();
    }
    if (PHM & 2048) final_phase(lds, G, wave0);
#if PROBE_MASK != 0u
    if ((PROBE_MASK >> 15) & 1u) { asm volatile("s_waitcnt vmcnt(0)" ::: "memory"); const unsigned long long tn_ = __builtin_amdgcn_s_memrealtime(); if (blockIdx.x == 0) { while (__builtin_amdgcn_s_memrealtime() - tn_ < tn_ - tprev_) __builtin_amdgcn_s_sleep(8); } }
#endif
}

extern "C" void kernel_launch(void* const* d_in, const int* in_sizes, int n_in, void* d_out, int out_size, void* d_ws, size_t ws_size, hipStream_t stream) {
    static int grid = 0;
    if (grid == 0) {
        if (n_in != 28 || ws_size < WS_END) { fprintf(stderr, "kernel_launch: unexpected n_in %d / ws_size %zu\n", n_in, ws_size); grid = -1; return; }
        int dev = 0, cus = 0, per_cu = 0;
        hipGetDevice(&dev); hipDeviceGetAttribute(&cus, hipDeviceAttributeMultiprocessorCount, dev);
        hipFuncSetAttribute((const void*)yoco_fwd, hipFuncAttributeMaxDynamicSharedMemorySize, LDS_BYTES);
        hipOccupancyMaxActiveBlocksPerMultiprocessor(&per_cu, (const void*)yoco_fwd, 512, LDS_BYTES);
        if (per_cu < 1) { fprintf(stderr, "kernel_launch: occupancy query says %d blocks/CU\n", per_cu); per_cu = 1; }
        (void)hipGetLastError();
        if (cus < 256) { fprintf(stderr, "kernel_launch: needs 256 CUs, device has %d\n", cus); grid = -1; return; }
        grid = 256;
    }
    if (grid < 0) return;
    if (hipMemsetAsync(d_ws, 0, 65536, stream) != hipSuccess) { fprintf(stderr, "kernel_launch: memset failed\n"); return; }
    Params p{};
    const float** pp = (const float**)&p;
    for (int i = 0; i < 28; ++i) pp[i] = (const float*)d_in[i];
    p.out = (float*)d_out; p.ws = (unsigned char*)d_ws;
    void* args[] = {&p};
    hipError_t e = hipLaunchCooperativeKernel((const void*)yoco_fwd, dim3(grid), dim3(512), args, LDS_BYTES, stream);
    if (e != hipSuccess) fprintf(stderr, "cooperative launch failed: %s (grid %d)\n", hipGetErrorString(e), grid);
}
```

```cpp
#include <hip/hip_runtime.h>
#include <hip/hip_cooperative_groups.h>
#include <cstdio>
#include <cstdint>
namespace cg = cooperative_groups;
#ifndef PROBE
#define PROBE 0
#endif

#define LAS __attribute__((address_space(3)))
typedef unsigned short bf16_t;
typedef short bf16x8 __attribute__((ext_vector_type(8)));
typedef float f32x4 __attribute__((ext_vector_type(4)));
typedef float f32x2 __attribute__((ext_vector_type(2)));
typedef unsigned u32x4 __attribute__((ext_vector_type(4)));
typedef unsigned u32x2 __attribute__((ext_vector_type(2)));

constexpr int DM = 1024, SEQ = 8192, MP = 32768, MS = 512, MT = MP + MS;
constexpr int GH = 2048, DFF = 2816, PLE = 256, KVD = 128;
constexpr float EPS = 1e-6f;
constexpr float LOG2E = 1.4426950408889634f;

constexpr size_t MiB = 1u << 20;
constexpr size_t WS_ROPE = 1 * MiB;
constexpr size_t WS_WTRIL = 2 * MiB;
constexpr size_t WS_SSA = 3 * MiB;
constexpr size_t WS_SSB = 6 * MiB;
constexpr size_t WS_VSS = 9 * MiB;
constexpr size_t WS_HG = 14 * MiB;
constexpr size_t WS_C0 = 25 * MiB;
constexpr size_t WS_U0 = 36 * MiB;
constexpr size_t WS_KB = 47 * MiB;
constexpr size_t WS_VB = 56 * MiB;
constexpr size_t WS_WIN = 66 * MiB;
constexpr size_t WS_WOUT = 74 * MiB;
constexpr size_t WS_WGU0 = 78 * MiB;
constexpr size_t WS_WD0 = 100 * MiB;
constexpr size_t WS_WPG0 = 111 * MiB;
constexpr size_t WS_WPP0 = 115 * MiB;
constexpr size_t WS_WQKV = 116 * MiB;
constexpr size_t WS_WO = 119 * MiB;
constexpr size_t WS_XBA = 121 * MiB;
constexpr size_t WS_PB = 186 * MiB;
constexpr size_t WS_Z = 219 * MiB;
constexpr size_t WS_END = 479 * MiB;

constexpr size_t O_Y = 0, O_GMV = 34078720, O_NCP = 35127296, O_NCS = 35172352, O_NKP = 36614144, O_NVP = 36679680, O_KS = 36745216, O_VS = 36810752;

__device__ __forceinline__ unsigned cvt_pk_bf16(float lo, float hi) { unsigned r; asm volatile("v_cvt_pk_bf16_f32 %0, %1, %2" : "=v"(r) : "v"(lo), "v"(hi)); return r; }
__device__ __forceinline__ float bf2f(unsigned h) { return __uint_as_float(h << 16); }
__device__ __forceinline__ u32x2 pack4(f32x4 v) { u32x2 w; w.x = cvt_pk_bf16(v[0], v[1]); w.y = cvt_pk_bf16(v[2], v[3]); return w; }
__device__ __forceinline__ f32x4 unpack4(u32x2 w) { return (f32x4){bf2f(w.x & 0xffffu), bf2f(w.x >> 16), bf2f(w.y & 0xffffu), bf2f(w.y >> 16)}; }
__device__ __forceinline__ float gelu1(float x) {
    const float z = x * (0.7978845608f + 0.0356774081f * x * x);
    const float e = __builtin_amdgcn_exp2f(-2.0f * LOG2E * z);
    return x * __builtin_amdgcn_rcpf(1.0f + e);
}
__device__ __forceinline__ f32x2 gelu_pk2(f32x2 v) {
    const f32x2 t = (v * v) * (-0.10294325f) + (-2.3022082f);
    const f32x2 y = v * t;
    f32x2 e; e.x = __builtin_amdgcn_exp2f(y.x); e.y = __builtin_amdgcn_exp2f(y.y);
    const f32x2 d = e + 1.0f;
    f32x2 r; r.x = __builtin_amdgcn_rcpf(d.x); r.y = __builtin_amdgcn_rcpf(d.y);
    return v * r;
}
__device__ __forceinline__ f32x4 gelu4(f32x4 v) { const f32x2 a = gelu_pk2((f32x2){v[0], v[1]}), b = gelu_pk2((f32x2){v[2], v[3]}); return (f32x4){a.x, a.y, b.x, b.y}; }
__device__ __forceinline__ f32x4 sigmoid4(f32x4 v) {
    const f32x4 y = v * (-LOG2E);
    const f32x4 e = (f32x4){__builtin_amdgcn_exp2f(y[0]), __builtin_amdgcn_exp2f(y[1]), __builtin_amdgcn_exp2f(y[2]), __builtin_amdgcn_exp2f(y[3])} + 1.0f;
    return (f32x4){__builtin_amdgcn_rcpf(e[0]), __builtin_amdgcn_rcpf(e[1]), __builtin_amdgcn_rcpf(e[2]), __builtin_amdgcn_rcpf(e[3])};
}
__device__ __forceinline__ float sigmoid1(float x) { return __builtin_amdgcn_rcpf(1.0f + __builtin_amdgcn_exp2f(-LOG2E * x)); }
__device__ __forceinline__ u32x4 pack8(f32x4 a, f32x4 b) { u32x4 w; w.x = cvt_pk_bf16(a[0], a[1]); w.y = cvt_pk_bf16(a[2], a[3]); w.z = cvt_pk_bf16(b[0], b[1]); w.w = cvt_pk_bf16(b[2], b[3]); return w; }
__device__ __forceinline__ float dot4(f32x4 v) { return (v[0] * v[0] + v[1] * v[1]) + (v[2] * v[2] + v[3] * v[3]); }
constexpr float SS_SCALE = 512.0f, SS_INV = 1.0f / 512.0f;
__device__ __forceinline__ float ss_get(const float* ss, int row) { return (float)((const unsigned*)ss)[row] * SS_INV; }
__device__ __forceinline__ void ss_set(float* ss, int row, float v) { ((unsigned*)ss)[row] = (unsigned)__builtin_rintf(v * SS_SCALE); }
__device__ __forceinline__ void ss_add(float* ss, int row, float v) { (void)__hip_atomic_fetch_add((unsigned*)ss + row, (unsigned)__builtin_rintf(v * SS_SCALE), __ATOMIC_RELAXED, __HIP_MEMORY_SCOPE_AGENT); }
__device__ __forceinline__ float rstd16(const float* ss, int row) { return __builtin_amdgcn_rsqf(ss_get(ss, row) * (1.0f / 1024.0f) + EPS); }
#define EPI_FENCE() asm volatile("" ::: "memory")
__device__ __forceinline__ int opaque_tid(int wave0) { int l; asm volatile("v_mbcnt_lo_u32_b32 %0, -1, 0\n\tv_mbcnt_hi_u32_b32 %0, -1, %0" : "=v"(l)); return wave0 * 64 + l; }
__device__ __forceinline__ float bperm(float v, int src) { return __int_as_float(__builtin_amdgcn_ds_bpermute(src << 2, __float_as_int(v))); }
__device__ __forceinline__ float xsum16(float v) { const auto r = __builtin_amdgcn_permlane16_swap(__float_as_uint(v), __float_as_uint(v), false, false); return __uint_as_float(r[0]) + __uint_as_float(r[1]); }
__device__ __forceinline__ float xsum32(float v) { const auto r = __builtin_amdgcn_permlane32_swap(__float_as_uint(v), __float_as_uint(v), false, false); return __uint_as_float(r[0]) + __uint_as_float(r[1]); }
__device__ __forceinline__ float xmax16(float v) { const auto r = __builtin_amdgcn_permlane16_swap(__float_as_uint(v), __float_as_uint(v), false, false); return fmaxf(__uint_as_float(r[0]), __uint_as_float(r[1])); }
__device__ __forceinline__ float xmax32(float v) { const auto r = __builtin_amdgcn_permlane32_swap(__float_as_uint(v), __float_as_uint(v), false, false); return fmaxf(__uint_as_float(r[0]), __uint_as_float(r[1])); }
__device__ __forceinline__ float xpartner16(float v, int fq) { const auto r = __builtin_amdgcn_permlane16_swap(__float_as_uint(v), __float_as_uint(v), false, false); return __uint_as_float((fq & 1) ? r[0] : r[1]); }
__device__ __forceinline__ f32x4 shfl4(f32x4 v, int src) { return (f32x4){bperm(v[0], src), bperm(v[1], src), bperm(v[2], src), bperm(v[3], src)}; }
__device__ __forceinline__ float wave_sum(float v, int lane_) {
#pragma unroll
    for (int o = 1; o < 64; o <<= 1) v += bperm(v, lane_ ^ o);
    return v;
}

namespace pg8 {
constexpr int BM = 256, BK = 64, HALF = 128, HTB = HALF * BK * 2, STAGE_BYTES = 8 * HTB, NXCD = 8, WGM = 8;
__host__ __device__ __forceinline__ int lds_byte(int r, int c) { const int st = (r >> 4) * 2 + (c >> 5), rr = r & 15, cc = c & 31, ob = rr * 64 + cc * 2; return st * 1024 + (ob ^ (((ob >> 9) & 1) << 5)); }
__host__ __device__ __forceinline__ void stage_rc(int b, int& R, int& C) { const int st = b / 1024, sb = b % 1024, swz = sb ^ (((sb >> 9) & 1) << 5); R = (st >> 1) * 16 + swz / 64; C = (st & 1) * 32 + (swz % 64) / 2; }

__host__ __device__ __forceinline__ int perm32(int rho) { const int n = rho >> 4, i = rho & 15; return 8 * (i >> 2) + 4 * n + (i & 3); }
template <class E> constexpr auto epi_perm(int) -> decltype(E::PERM) { return E::PERM; }
template <class E> constexpr bool epi_perm(long) { return false; }
struct Unit { int row0, pn, half; };
struct Gemm { const bf16_t* A; const bf16_t* Bt; int M, N, K, lda; };

struct StaticOrder {
    int nM, nN, nwg, G, c;
    __device__ void init(int M, int N, int G_, int c_) { nM = M / BM; nN = N / BM; nwg = nM * nN; G = G_; c = c_; }
    __device__ bool next(int i, Unit& u) const {
        const long L = (long)i * G + c;
        if (L >= nwg) { const int q = (int)(L - nwg); if (q >= 4 * nN) return false; u.row0 = MP + (q & 3) * 128; u.pn = q >> 2; u.half = 1; return true; }
        int wgid = (int)L; { const int q = nwg / NXCD, r = nwg % NXCD, xcd = wgid % NXCD, off = wgid / NXCD; wgid = (xcd < r ? xcd * (q + 1) : r * (q + 1) + (xcd - r) * q) + off; }
        const int nig = WGM * nN, gid = wgid / nig, fm = gid * WGM, gsz = (nM - fm) < WGM ? (nM - fm) : WGM;
        u.row0 = (fm + ((wgid % nig) % gsz)) * BM; u.pn = (wgid % nig) / gsz; u.half = 0; return true;
    }
};

template <class Epi> __device__ __forceinline__ auto acc_init(const Epi& E, f32x4 (&acc)[2][2][4][2], const Unit& u, int wr, int wc, int fr, int fq, int) -> decltype(E.init(acc, u, wr, wc, fr, fq), void()) { E.init(acc, u, wr, wc, fr, fq); }
template <class Epi> __device__ __forceinline__ void acc_init(const Epi&, f32x4 (&acc)[2][2][4][2], const Unit&, int, int, int, int, long) {
#pragma unroll
    for (int a = 0; a < 2; ++a)
#pragma unroll
        for (int b = 0; b < 2; ++b)
#pragma unroll
            for (int m = 0; m < 4; ++m)
#pragma unroll
                for (int n = 0; n < 2; ++n) acc[a][b][m][n] = (f32x4){0.f, 0.f, 0.f, 0.f};
}
template <class Epi, bool ALIGN_EPI = true, bool SP2 = true>
__device__ __forceinline__ void gemm_phase(LAS unsigned char* lds, const Gemm g, const StaticOrder& S_in, const Epi& E, int wave0) {
    StaticOrder S = S_in; asm volatile("" : "+s"(S.c));
    const int tid = opaque_tid(wave0), wid = __builtin_amdgcn_readfirstlane(tid >> 6), lane = tid & 63, wr = wid >> 2, wc = wid & 3, fr = lane & 15, fq = lane >> 4;
    const int K = g.K, nt = K / BK;
    unsigned voffA[2], voffB[2];
#pragma unroll
    for (int i = 0; i < 2; ++i) { int R, C; stage_rc(tid * 16 + i * 8192, R, C);
        const int Rb = epi_perm<Epi>(0) ? ((R & ~31) + perm32(R & 31)) : R;
        voffA[i] = (unsigned)(R * g.lda + C) * 2u; voffB[i] = (unsigned)(Rb * K + C) * 2u; }
    const size_t kstep = (size_t)(BK * 2);
    const size_t hstepA = (size_t)HALF * g.lda * 2, hstepB = (size_t)HALF * K * 2;
    const size_t tstepA = 2 * hstepA, tstepB = 2 * hstepB;
    const unsigned ldsw = (unsigned)wid * 1024u;
    const int aoff = lds_byte(wr * 64 + fr, fq * 8), boff = lds_byte(wc * 32 + fr, fq * 8);
#define PG8_SA(b, h) (((b) * 2 + (h)) * HTB)
#define PG8_SB(b, h) ((4 + (b) * 2 + (h)) * HTB)
#define PG8_STAGE(bufoff, gbase, voff) do { _Pragma("unroll") for (int _i = 0; _i < 2; ++_i) \
        __builtin_amdgcn_global_load_lds((const unsigned*)((const char*)(gbase) + (voff)[_i]), (LAS unsigned*)(lds + (bufoff) + ldsw + _i * 8192), 16, 0, 0); } while (0)
#define PG8_LDA(dst, b, h) do { _Pragma("unroll") for (int m = 0; m < 4; ++m) _Pragma("unroll") for (int k = 0; k < 2; ++k) dst[m][k] = *(const LAS bf16x8*)(lds + PG8_SA(b, h) + aoff + m * 2048 + k * 1024); } while (0)
#define PG8_LDB(dst, b, h) do { _Pragma("unroll") for (int n = 0; n < 2; ++n) _Pragma("unroll") for (int k = 0; k < 2; ++k) dst[n][k] = *(const LAS bf16x8*)(lds + PG8_SB(b, h) + boff + n * 2048 + k * 1024); } while (0)
#define PG8_MMA(ai, bj, At, Bt) do { __builtin_amdgcn_s_setprio(1); _Pragma("unroll") for (int m = 0; m < 4; ++m) _Pragma("unroll") for (int n = 0; n < 2; ++n) _Pragma("unroll") for (int k = 0; k < 2; ++k) \
        acc[ai][bj][m][n] = __builtin_amdgcn_mfma_f32_16x16x32_bf16(Bt[n][k], At[m][k], acc[ai][bj][m][n], 0, 0, 0); __builtin_amdgcn_s_setprio(0); } while (0)
#define PG8_WAIT_V(n) asm volatile("s_waitcnt vmcnt(" #n ")" ::: "memory")
#define PG8_WAIT_L(n) asm volatile("s_waitcnt lgkmcnt(" #n ")" ::: "memory")
#define PG8_BAR __builtin_amdgcn_s_barrier()
#define PG8_SCHED __builtin_amdgcn_sched_barrier(0)
    Unit cur, nxt; int ui = 0;
    if (!S.next(0, cur)) return;
    f32x4 acc[2][2][4][2];
    acc_init(E, acc, cur, wr, wc, fr, fq, 0);
    bf16x8 At[4][2], B0[2][2], B1[2][2];
    const char* cA = (const char*)g.A + (size_t)cur.row0 * g.lda * 2; const char* cB = (const char*)g.Bt + (size_t)cur.pn * tstepB;
    if constexpr (SP2) {
        PG8_STAGE(PG8_SB(0, 0), cB, voffB); PG8_STAGE(PG8_SB(0, 1), cB + hstepB, voffB); PG8_STAGE(PG8_SA(0, 0), cA, voffA); PG8_STAGE(PG8_SA(0, 1), cA + hstepA, voffA);
        if (wr == 1) PG8_BAR;
        PG8_WAIT_V(2); PG8_BAR;
        PG8_STAGE(PG8_SB(1, 0), cB + kstep, voffB); PG8_STAGE(PG8_SA(1, 0), cA + kstep, voffA); PG8_STAGE(PG8_SB(1, 1), cB + hstepB + kstep, voffB);
        PG8_WAIT_V(6); PG8_BAR;
    } else {
        PG8_STAGE(PG8_SB(0, 0), cB, voffB); PG8_STAGE(PG8_SA(0, 0), cA, voffA); PG8_STAGE(PG8_SB(0, 1), cB + hstepB, voffB); PG8_STAGE(PG8_SA(0, 1), cA + hstepA, voffA);
        if (wr == 1) PG8_BAR;
        PG8_WAIT_V(4); PG8_BAR;
        PG8_STAGE(PG8_SB(1, 0), cB + kstep, voffB); PG8_STAGE(PG8_SA(1, 0), cA + kstep, voffA); PG8_STAGE(PG8_SB(1, 1), cB + hstepB + kstep, voffB);
        PG8_WAIT_V(6); PG8_BAR;
    }
    for (;;) {
        const bool has_next = S.next(ui + 1, nxt);
        const char* nA = has_next ? (const char*)g.A + (size_t)nxt.row0 * g.lda * 2 : cA; const char* nB = has_next ? (const char*)g.Bt + (size_t)nxt.pn * tstepB : cB;
        for (int t = 0; t < nt; t += 2) {
            const bool last = (t == nt - 2);
            const char* a1 = cA + (size_t)(t + 1) * kstep;
            const char* a2 = last ? nA : cA + (size_t)(t + 2) * kstep; const char* b2 = last ? nB : cB + (size_t)(t + 2) * kstep;
            const char* a3 = a2 + kstep; const char* b3 = b2 + kstep;
            if constexpr (SP2) {
            PG8_LDB(B0, 0, 0); PG8_LDB(B1, 0, 1); PG8_SCHED; PG8_LDA(At, 0, 0); PG8_STAGE(PG8_SA(1, 1), a1 + hstepA, voffA);
            PG8_WAIT_V(8); PG8_WAIT_L(0); PG8_BAR; PG8_MMA(0, 0, At, B0); PG8_MMA(0, 1, At, B1); PG8_BAR; PG8_SCHED;
            PG8_LDA(At, 0, 1); PG8_STAGE(PG8_SB(0, 0), b2, voffB); PG8_STAGE(PG8_SB(0, 1), b2 + hstepB, voffB); PG8_STAGE(PG8_SA(0, 0), a2, voffA);
            PG8_WAIT_V(8); PG8_WAIT_L(0); PG8_BAR; if (!cur.half) { PG8_MMA(1, 0, At, B0); PG8_MMA(1, 1, At, B1); } PG8_BAR; PG8_SCHED;
            PG8_LDB(B0, 1, 0); PG8_LDB(B1, 1, 1); PG8_SCHED; PG8_LDA(At, 1, 0); PG8_STAGE(PG8_SA(0, 1), a2 + hstepA, voffA);
            PG8_WAIT_V(8); PG8_WAIT_L(0); PG8_BAR; PG8_MMA(0, 0, At, B0); PG8_MMA(0, 1, At, B1); PG8_BAR; PG8_SCHED;
            PG8_LDA(At, 1, 1); PG8_STAGE(PG8_SB(1, 0), b3, voffB); PG8_STAGE(PG8_SB(1, 1), b3 + hstepB, voffB); PG8_STAGE(PG8_SA(1, 0), a3, voffA);
            PG8_WAIT_V(8); PG8_WAIT_L(0); PG8_BAR; if (!cur.half) { PG8_MMA(1, 0, At, B0); PG8_MMA(1, 1, At, B1); } PG8_BAR; PG8_SCHED;
            } else {
            PG8_LDB(B0, 0, 0); PG8_SCHED; PG8_LDA(At, 0, 0); PG8_STAGE(PG8_SA(1, 1), a1 + hstepA, voffA);
            PG8_WAIT_L(8); PG8_BAR; PG8_WAIT_L(0); PG8_MMA(0, 0, At, B0); PG8_BAR; PG8_SCHED;
            PG8_LDB(B1, 0, 1); PG8_STAGE(PG8_SB(0, 0), b2, voffB);
            PG8_BAR; PG8_WAIT_L(0); PG8_MMA(0, 1, At, B1); PG8_BAR;
            PG8_LDA(At, 0, 1); PG8_STAGE(PG8_SA(0, 0), a2, voffA);
            PG8_BAR; PG8_WAIT_L(0); if (!cur.half) { PG8_MMA(1, 0, At, B0); } PG8_BAR; PG8_SCHED;
            PG8_STAGE(PG8_SB(0, 1), b2 + hstepB, voffB);
            PG8_WAIT_V(6); PG8_BAR; if (!cur.half) { PG8_MMA(1, 1, At, B1); } PG8_BAR;
            PG8_LDB(B0, 1, 0); PG8_SCHED; PG8_LDA(At, 1, 0); PG8_STAGE(PG8_SA(0, 1), a2 + hstepA, voffA);
            PG8_WAIT_L(8); PG8_BAR; PG8_WAIT_L(0); PG8_MMA(0, 0, At, B0); PG8_BAR; PG8_SCHED;
            PG8_LDB(B1, 1, 1); PG8_STAGE(PG8_SB(1, 0), b3, voffB);
            PG8_BAR; PG8_WAIT_L(0); PG8_MMA(0, 1, At, B1); PG8_BAR;
            PG8_LDA(At, 1, 1); PG8_STAGE(PG8_SA(1, 0), a3, voffA);
            PG8_BAR; PG8_WAIT_L(0); if (!cur.half) { PG8_MMA(1, 0, At, B0); } PG8_BAR; PG8_SCHED;
            PG8_STAGE(PG8_SB(1, 1), b3 + hstepB, voffB);
            PG8_WAIT_V(6); PG8_BAR; if (!cur.half) { PG8_MMA(1, 1, At, B1); } PG8_BAR;
            }
        }
        if constexpr (ALIGN_EPI) { if (wr == 0) PG8_BAR; }
        E(acc, cur, wr, wc, fr, fq);
        if (!has_next) break;
        cur = nxt; cA = nA; cB = nB; ++ui;
        acc_init(E, acc, cur, wr, wc, fr, fq, 0);
        if constexpr (ALIGN_EPI) { if (wr == 1) PG8_BAR; }
    }
    PG8_WAIT_V(0);
    if constexpr (!ALIGN_EPI) { if (wr == 0) PG8_BAR; }
    PG8_BAR;
#undef PG8_SA
#undef PG8_SB
#undef PG8_STAGE
#undef PG8_LDA
#undef PG8_LDB
#undef PG8_MMA
#undef PG8_WAIT_V
#undef PG8_WAIT_L
#undef PG8_BAR
#undef PG8_SCHED
}
}
using pg8::Unit;
typedef f32x4 Acc[2][2][4][2];

struct EpiGm {
    static constexpr bool PERM = true;
    const float* ss; bf16_t* Z; float* vss;
    __device__ __forceinline__ void operator()(Acc& acc, const Unit& u, int wr, int wc, int fr, int fq) const {
        asm volatile("" : "+v"(fr), "+v"(fq));
        const int lane_ = fq * 16 + fr; (void)lane_;
        const int rowb = u.row0 + wr * 64 + fr, colb = u.pn * 256 + wc * 32 + 8 * fq;
        float rs[8];
#pragma unroll
        for (int g = 0; g < 8; ++g) rs[g] = ss_get(ss, rowb + (g >> 2) * 128 + (g & 3) * 16);
        EPI_FENCE();
#pragma unroll
        for (int g = 0; g < 8; ++g) {
            if (u.half && g >= 4) break;
            const int ai = g >> 2, m = g & 3, row = rowb + ai * 128 + m * 16;
            const float r = __builtin_amdgcn_rsqf(rs[g] * (1.0f / 1024.0f) + EPS); float s = 0.f;
#pragma unroll
            for (int bj = 0; bj < 2; ++bj) {
                const f32x4 v0 = gelu4(acc[ai][bj][m][0] * r), v1 = gelu4(acc[ai][bj][m][1] * r);
                *(u32x4*)(Z + (size_t)row * 4096 + colb + bj * 128) = pack8(v0, v1);
                s += dot4(v0) + dot4(v1);
            }
            if (u.pn >= 8) { s = xsum16(s); s = xsum32(s); if (fq == 0) ss_add(vss, row, s); }
        }
        EPI_FENCE();
    }
};
struct EpiRes {
    static constexpr bool PERM = true;
    const bf16_t* src; bf16_t* dst; float* sso;
    __device__ __forceinline__ void init(Acc& acc, const Unit& u, int wr, int wc, int fr, int fq) const {
        asm volatile("" : "+v"(fr), "+v"(fq));
        const int rowb = u.row0 + wr * 64 + fr, colb = u.pn * 256 + wc * 32 + 8 * fq;
#pragma unroll
        for (int g = 0; g < 8; ++g) { const int ai = g >> 2, m = g & 3;
#pragma unroll
            for (int bj = 0; bj < 2; ++bj) {
                if (u.half && ai == 1) { acc[ai][bj][m][0] = (f32x4){0.f, 0.f, 0.f, 0.f}; acc[ai][bj][m][1] = (f32x4){0.f, 0.f, 0.f, 0.f}; }
                else { const u32x4 w = *(const u32x4*)(src + (size_t)(rowb + ai * 128 + m * 16) * 1024 + colb + bj * 128);
                    acc[ai][bj][m][0] = unpack4((u32x2){w.x, w.y}); acc[ai][bj][m][1] = unpack4((u32x2){w.z, w.w}); } } }
    }
    __device__ __forceinline__ void operator()(Acc& acc, const Unit& u, int wr, int wc, int fr, int fq) const {
        asm volatile("" : "+v"(fr), "+v"(fq));
        const int lane_ = fq * 16 + fr; (void)lane_;
        const int rowb = u.row0 + wr * 64 + fr, colb = u.pn * 256 + wc * 32 + 8 * fq;
#pragma unroll
        for (int g = 0; g < 8; ++g) {
            if (u.half && g >= 4) break;
            const int ai = g >> 2, m = g & 3, row = rowb + ai * 128 + m * 16;
            float s = 0.f;
#pragma unroll
            for (int bj = 0; bj < 2; ++bj) { const f32x4 v0 = acc[ai][bj][m][0], v1 = acc[ai][bj][m][1];
                *(u32x4*)(dst + (size_t)row * 1024 + colb + bj * 128) = pack8(v0, v1); s += dot4(v0) + dot4(v1); }
            s = xsum16(s); s = xsum32(s); if (fq == 0) ss_add(sso, row, s);
        }
        EPI_FENCE();
    }
};
struct EpiBf {
    static constexpr bool PERM = true;
    bf16_t* C;
    __device__ __forceinline__ void operator()(Acc& acc, const Unit& u, int wr, int wc, int fr, int fq) const {
        asm volatile("" : "+v"(fr), "+v"(fq));
        const int rowb = u.row0 + wr * 64 + fr, colb = u.pn * 256 + wc * 32 + 8 * fq;
#pragma unroll
        for (int g = 0; g < 8; ++g) { if (u.half && g >= 4) break; const int ai = g >> 2, m = g & 3, row = rowb + ai * 128 + m * 16;
#pragma unroll
            for (int bj = 0; bj < 2; ++bj) *(u32x4*)(C + (size_t)row * 1024 + colb + bj * 128) = pack8(acc[ai][bj][m][0], acc[ai][bj][m][1]); }
        EPI_FENCE();
    }
};
struct EpiPle {
    static constexpr bool PERM = true;
    const float* ss; const bf16_t* PR; const bf16_t* src; bf16_t* dstb; float* sso;
    __device__ __forceinline__ void operator()(Acc& acc, const Unit& u, int wr, int wc, int fr, int fq) const {
        asm volatile("" : "+v"(fr), "+v"(fq));
        const int lane_ = fq * 16 + fr; (void)lane_;
        const int rowb = u.row0 + wr * 64 + fr, colb = u.pn * 256 + wc * 32 + 8 * fq;
        float rs[8];
#pragma unroll
        for (int g = 0; g < 8; ++g) rs[g] = ss_get(ss, rowb + (g >> 2) * 128 + (g & 3) * 16);
        u32x4 nx[2], np[2];
#pragma unroll
        for (int bj = 0; bj < 2; ++bj) { const size_t off = (size_t)rowb * 1024 + colb + bj * 128; nx[bj] = *(const u32x4*)(src + off); np[bj] = *(const u32x4*)(PR + off); }
        EPI_FENCE();
#pragma unroll
        for (int g = 0; g < 8; ++g) {
            if (u.half && g >= 4) break;
            const int ai = g >> 2, m = g & 3, row = rowb + ai * 128 + m * 16;
            u32x4 cx[2], cp[2];
#pragma unroll
            for (int bj = 0; bj < 2; ++bj) { cx[bj] = nx[bj]; cp[bj] = np[bj]; }
            if (g < 7) { const int row2 = rowb + ((g + 1) >> 2) * 128 + ((g + 1) & 3) * 16;
#pragma unroll
                for (int bj = 0; bj < 2; ++bj) { const size_t off = (size_t)row2 * 1024 + colb + bj * 128; nx[bj] = *(const u32x4*)(src + off); np[bj] = *(const u32x4*)(PR + off); } }
            EPI_FENCE();
            const float r = __builtin_amdgcn_rsqf(rs[g] * (1.0f / 1024.0f) + EPS); float s = 0.f;
#pragma unroll
            for (int bj = 0; bj < 2; ++bj) { const size_t off = (size_t)row * 1024 + colb + bj * 128;
                const f32x4 v0 = unpack4((u32x2){cx[bj].x, cx[bj].y}) + unpack4((u32x2){cp[bj].x, cp[bj].y}) * sigmoid4(acc[ai][bj][m][0] * r);
                const f32x4 v1 = unpack4((u32x2){cx[bj].z, cx[bj].w}) + unpack4((u32x2){cp[bj].z, cp[bj].w}) * sigmoid4(acc[ai][bj][m][1] * r);
                *(u32x4*)(dstb + off) = pack8(v0, v1);
                s += dot4(v0) + dot4(v1); }
            s = xsum16(s); s = xsum32(s); if (fq == 0) ss_add(sso, row, s);
            EPI_FENCE();
        }
    }
};
struct EpiGU {
    static constexpr bool PERM = true;
    const float* ss; bf16_t* act; const float* cw; const float* cb; float* hg; float* c0; float* u0; const float* state; float* ncs;
    __device__ __forceinline__ void operator()(Acc& acc, const Unit& u, int wr, int wc, int fr, int fq) const {
        asm volatile("" : "+v"(fr), "+v"(fq));
        const int lane_ = fq * 16 + fr; (void)lane_;
        const int src1 = (fq << 4) | ((fr + 15) & 15), src2 = (fq << 4) | ((fr + 14) & 15);
        const bool samp = u.row0 >= MP;
#pragma unroll
        for (int ai = 0; ai < 2; ++ai)
#pragma unroll
            for (int m = 0; m < 4; ++m) {
                const int row = u.row0 + ai * 128 + wr * 64 + m * 16 + fr; const float rs = rstd16(ss, row);
#pragma unroll
                for (int bj = 0; bj < 2; ++bj)
#pragma unroll
                    for (int n = 0; n < 2; ++n) acc[ai][bj][m][n] = acc[ai][bj][m][n] * rs;
            }
        const int colg = u.pn * 128 + wc * 32 + 8 * fq;
        f32x4 w0[2], w1[2], w2[2], bb[2];
#pragma unroll
        for (int n = 0; n < 2; ++n) { w0[n] = *(const f32x4*)(cw + colg + 4 * n); w1[n] = *(const f32x4*)(cw + DFF + colg + 4 * n); w2[n] = *(const f32x4*)(cw + 2 * DFF + colg + 4 * n); bb[n] = *(const f32x4*)(cb + colg + 4 * n); }
#pragma unroll
        for (int ai = 0; ai < 2; ++ai)
#pragma unroll
            for (int m = 0; m < 4; ++m) {
                if (u.half && ai == 1) break;
                const int row = u.row0 + ai * 128 + wr * 64 + m * 16 + fr;
                f32x4 a2[2];
#pragma unroll
                for (int n = 0; n < 2; ++n) {
                    const f32x4 g = acc[ai][0][m][n], gp = (m > 0) ? acc[ai][0][m > 0 ? m - 1 : 0][n] : g;
                    const f32x4 t1 = (fr == 15) ? gp : g, t2 = (fr >= 14) ? gp : g;
                    f32x4 g1 = shfl4(t1, src1), g2 = shfl4(t2, src2);
                    if (samp) {
                        const int t = fr & 3, b = (row - MP) >> 2;
                        if (t == 0) { g1 = *(const f32x4*)(state + (size_t)(b * 2 + 1) * DFF + colg + 4 * n); g2 = *(const f32x4*)(state + (size_t)(b * 2) * DFF + colg + 4 * n); }
                        else if (t == 1) { g2 = *(const f32x4*)(state + (size_t)(b * 2 + 1) * DFF + colg + 4 * n); }
                        else { *(f32x4*)(ncs + (size_t)(b * 2 + t - 2) * DFF + colg + 4 * n) = g; }
                    }
                    const f32x4 conv = bb[n] + w0[n] * g2 + w1[n] * g1 + w2[n] * g;
                    const f32x4 up = acc[ai][1][m][n];
                    a2[n] = gelu4(conv) * up;
                    if (!samp) {
                        if (m == 0 && fr < 2) { const int gj = (row >> 6) * 2 + fr; f32x4 c = bb[n] + w2[n] * g; if (fr == 1) c = c + w1[n] * g1;
                            *(f32x4*)(c0 + (size_t)gj * DFF + colg + 4 * n) = c; *(f32x4*)(u0 + (size_t)gj * DFF + colg + 4 * n) = up; }
                        if (m == 3 && fr >= 14) { const int gj = (row >> 6) * 2 + (fr - 14); *(f32x4*)(hg + (size_t)gj * DFF + colg + 4 * n) = g; }
                    }
                }
                *(u32x4*)(act + (size_t)row * DFF + colg) = pack8(a2[0], a2[1]);
                EPI_FENCE();
            }
    }
};
struct EpiQKV {
    static constexpr bool PERM = true;
    const float* ss; const float* rope; bf16_t* Q; bf16_t* KB; bf16_t* VB; float* out;
    __device__ __forceinline__ void operator()(Acc& acc, const Unit& u, int wr, int wc, int fr, int fq) const {
        asm volatile("" : "+v"(fr), "+v"(fq));
        const int lane_ = fq * 16 + fr; (void)lane_;
        float rsq[8];
#pragma unroll
        for (int g = 0; g < 8; ++g) rsq[g] = ss_get(ss, u.row0 + wr * 64 + fr + (g >> 2) * 128 + (g & 3) * 16);
        EPI_FENCE();
#pragma unroll
        for (int ai = 0; ai < 2; ++ai)
#pragma unroll
            for (int m = 0; m < 4; ++m) {
                if (u.half && ai == 1) break;
                const int row = u.row0 + ai * 128 + wr * 64 + m * 16 + fr; const float rs = __builtin_amdgcn_rsqf(rsq[ai * 4 + m] * (1.0f / 1024.0f) + EPS);
                const int posidx = row < MP ? (row & (SEQ - 1)) : SEQ + (row & 3);
                f32x4 cs[2], sn[2];
#pragma unroll
                for (int n = 0; n < 2; ++n) { cs[n] = *(const f32x4*)(rope + (size_t)posidx * 16 + 4 * n); sn[n] = *(const f32x4*)(rope + (size_t)posidx * 16 + 8 + 4 * n); }
#pragma unroll
                for (int bj = 0; bj < 2; ++bj) {
                    const bool isV = (u.pn == 4) && (bj == 1);
                    f32x4 v[2];
#pragma unroll
                    for (int n = 0; n < 2; ++n) {
                        v[n] = acc[ai][bj][m][n] * rs;
                        if ((wc & 1) == 0 && !isV) {
                            const f32x4 pt = (f32x4){xpartner16(v[n][0], fq), xpartner16(v[n][1], fq), xpartner16(v[n][2], fq), xpartner16(v[n][3], fq)};
                            if (fq == 0) v[n] = v[n] * cs[n] - pt * sn[n]; else if (fq == 1) v[n] = v[n] * cs[n] + pt * sn[n];
                        }
                    }
                    const int cu = bj * 128 + wc * 32 + 8 * fq;
                    if (u.pn < 4) { *(u32x4*)(Q + (size_t)row * 1024 + u.pn * 256 + cu) = pack8(v[0] * (0.125f * LOG2E), v[1] * (0.125f * LOG2E)); }
                    else {
                        const int c2 = cu & 127; bf16_t* dst = bj == 0 ? KB : VB;
                        *(u32x4*)(dst + (size_t)row * KVD + c2) = pack8(v[0], v[1]);
                        float* fo = nullptr;
                        if (row >= MP) fo = out + (bj == 0 ? O_KS : O_VS) + (size_t)(row - MP) * KVD + c2;
                        else if ((row & (SEQ - 1)) >= SEQ - 128) fo = out + (bj == 0 ? O_NKP : O_NVP) + (size_t)((row >> 13) * 128 + (row & (SEQ - 1)) - (SEQ - 128)) * KVD + c2;
                        if (fo) { *(f32x4*)fo = v[0]; *(f32x4*)(fo + 4) = v[1]; }
                    }
                }
                EPI_FENCE();
            }
    }
};

struct Params {
    const float *x_prompt, *x_sample, *state, *cache_k, *cache_v, *p_prompt, *p_sample, *norm_mix, *gm_w_in, *gm_v_norm, *gm_w_s, *gm_b_s, *gm_w_out, *kv_norm, *w_kv, *w_q, *sinks, *w_o,
        *norm_ffn, *w_gate, *w_up, *conv_w, *conv_b, *w_down, *ple_norm, *ple_w_gate, *ple_w_proj, *final_norm;
    float* out; unsigned char* ws;
};

constexpr int PARAM_OFF = 131072 + 1024;
__device__ __forceinline__ unsigned long long ldq(const LAS unsigned char* pbase, int i) {
    const unsigned long long v = ((const LAS unsigned long long*)pbase)[i];
    const unsigned lo = __builtin_amdgcn_readfirstlane((unsigned)v), hi = __builtin_amdgcn_readfirstlane((unsigned)(v >> 32));
    return ((unsigned long long)hi << 32) | lo;
}
__device__ __forceinline__ Params load_params(LAS unsigned char* lds) {
    Params p;
    unsigned poff = PARAM_OFF; asm volatile("" : "+v"(poff));
    const LAS unsigned char* pb = lds + poff;
    p.x_prompt = (decltype(p.x_prompt))(__attribute__((address_space(1))) float*)ldq(pb, 0);
    p.x_sample = (decltype(p.x_sample))(__attribute__((address_space(1))) float*)ldq(pb, 1);
    p.state = (decltype(p.state))(__attribute__((address_space(1))) float*)ldq(pb, 2);
    p.cache_k = (decltype(p.cache_k))(__attribute__((address_space(1))) float*)ldq(pb, 3);
    p.cache_v = (decltype(p.cache_v))(__attribute__((address_space(1))) float*)ldq(pb, 4);
    p.p_prompt = (decltype(p.p_prompt))(__attribute__((address_space(1))) float*)ldq(pb, 5);
    p.p_sample = (decltype(p.p_sample))(__attribute__((address_space(1))) float*)ldq(pb, 6);
    p.norm_mix = (decltype(p.norm_mix))(__attribute__((address_space(1))) float*)ldq(pb, 7);
    p.gm_w_in = (decltype(p.gm_w_in))(__attribute__((address_space(1))) float*)ldq(pb, 8);
    p.gm_v_norm = (decltype(p.gm_v_norm))(__attribute__((address_space(1))) float*)ldq(pb, 9);
    p.gm_w_s = (decltype(p.gm_w_s))(__attribute__((address_space(1))) float*)ldq(pb, 10);
    p.gm_b_s = (decltype(p.gm_b_s))(__attribute__((address_space(1))) float*)ldq(pb, 11);
    p.gm_w_out = (decltype(p.gm_w_out))(__attribute__((address_space(1))) float*)ldq(pb, 12);
    p.kv_norm = (decltype(p.kv_norm))(__attribute__((address_space(1))) float*)ldq(pb, 13);
    p.w_kv = (decltype(p.w_kv))(__attribute__((address_space(1))) float*)ldq(pb, 14);
    p.w_q = (decltype(p.w_q))(__attribute__((address_space(1))) float*)ldq(pb, 15);
    p.sinks = (decltype(p.sinks))(__attribute__((address_space(1))) float*)ldq(pb, 16);
    p.w_o = (decltype(p.w_o))(__attribute__((address_space(1))) float*)ldq(pb, 17);
    p.norm_ffn = (decltype(p.norm_ffn))(__attribute__((address_space(1))) float*)ldq(pb, 18);
    p.w_gate = (decltype(p.w_gate))(__attribute__((address_space(1))) float*)ldq(pb, 19);
    p.w_up = (decltype(p.w_up))(__attribute__((address_space(1))) float*)ldq(pb, 20);
    p.conv_w = (decltype(p.conv_w))(__attribute__((address_space(1))) float*)ldq(pb, 21);
    p.conv_b = (decltype(p.conv_b))(__attribute__((address_space(1))) float*)ldq(pb, 22);
    p.w_down = (decltype(p.w_down))(__attribute__((address_space(1))) float*)ldq(pb, 23);
    p.ple_norm = (decltype(p.ple_norm))(__attribute__((address_space(1))) float*)ldq(pb, 24);
    p.ple_w_gate = (decltype(p.ple_w_gate))(__attribute__((address_space(1))) float*)ldq(pb, 25);
    p.ple_w_proj = (decltype(p.ple_w_proj))(__attribute__((address_space(1))) float*)ldq(pb, 26);
    p.final_norm = (decltype(p.final_norm))(__attribute__((address_space(1))) float*)ldq(pb, 27);
    p.out = (decltype(p.out))(__attribute__((address_space(1))) float*)ldq(pb, 28);
    p.ws = (decltype(p.ws))(__attribute__((address_space(1))) unsigned char*)ldq(pb, 29);
    return p;
}
__device__ __forceinline__ void tr_item(const float* W, int K, int N, bf16_t* WT, const float* scale, int mode, int row_off, LAS float* scr, int item, int lane) {
    const int nblk = N / 32, kb = item / nblk, nb = item % nblk, k0 = 64 * kb, n0 = 32 * nb;
#pragma unroll 16
    for (int i = 0; i < 32; ++i) { const int kk = 2 * i + (lane >> 5); float w = W[(size_t)(k0 + kk) * N + n0 + (lane & 31)]; if (scale) w *= scale[k0 + kk]; scr[kk * 33 + (lane & 31)] = w; }
    asm volatile("s_waitcnt lgkmcnt(0)" ::: "memory");
    const int c = lane & 7;
    const int drow0 = mode == 0 ? row_off + n0 : ((n0 >> 7) * 256 + (mode == 2 ? 128 : 0) + (n0 & 127));
#pragma unroll
    for (int j = 0; j < 4; ++j) { const int n = (lane >> 3) + 8 * j; const LAS float* s = scr + (8 * c) * 33 + n;
        u32x4 o; o.x = cvt_pk_bf16(s[0 * 33], s[1 * 33]); o.y = cvt_pk_bf16(s[2 * 33], s[3 * 33]); o.z = cvt_pk_bf16(s[4 * 33], s[5 * 33]); o.w = cvt_pk_bf16(s[6 * 33], s[7 * 33]);
        *(u32x4*)(WT + (size_t)(drow0 + n) * K + k0 + 8 * c) = o; }
    asm volatile("s_waitcnt lgkmcnt(0)" ::: "memory");
}

__device__ __forceinline__ void conv_stage(LAS unsigned char* lds, int stage, int T, int wave0) {
    if ((int)blockIdx.x < T) return;
    const Params P = load_params(lds);
    const int tid = opaque_tid(wave0), lane = tid & 63, wave = tid >> 6;
    unsigned char* ws = P.ws;
    LAS float* scr = (LAS float*)(lds + wave * 16384);
    const int gw = ((int)blockIdx.x - T) * 8 + wave, NGW = (256 - T) * 8;
    const int nitems = stage == 0 ? 2048 : stage == 1 ? 1024 + 1408 : stage == 2 ? 1408 + 1408 + 512 + 128 : stage == 3 ? 512 + 128 + 512 : stage == 4 ? 512 + 128 : stage == 5 ? 1408 : stage == 7 ? 1408 : stage == 8 ? 1408 : 0;
    for (int it = gw; it < nitems; it += NGW) {
        int r = it; const float* W; int K, N; bf16_t* WT; const float* sc; int mode = 0, roff = 0;
        if (stage == 0) { W = P.gm_w_in; K = 1024; N = 4096; WT = (bf16_t*)(ws + WS_WIN); sc = P.norm_mix; }
        else if (stage == 1) {
            if (r < 1024) { W = P.gm_w_out; K = 2048; N = 1024; WT = (bf16_t*)(ws + WS_WOUT); sc = nullptr; }
            else { r -= 1024; W = P.w_gate; K = 1024; N = DFF; WT = (bf16_t*)(ws + WS_WGU0); sc = P.norm_ffn; mode = 1; }
        } else if (stage == 2) {
            if (r < 1408) { W = P.w_up; K = 1024; N = DFF; WT = (bf16_t*)(ws + WS_WGU0); sc = P.norm_ffn; mode = 2; }
            else if (r < 2816) { r -= 1408; W = P.w_down; K = DFF; N = 1024; WT = (bf16_t*)(ws + WS_WD0); sc = nullptr; }
            else if (r < 2816 + 512) { r -= 2816; W = P.ple_w_gate; K = 1024; N = 1024; WT = (bf16_t*)(ws + WS_WPG0); sc = P.ple_norm; }
            else { r -= 2816 + 512; W = P.ple_w_proj; K = 256; N = 1024; WT = (bf16_t*)(ws + WS_WPP0); sc = nullptr; }
        } else if (stage == 3) {
            if (r < 512) { W = P.w_q; K = 1024; N = 1024; WT = (bf16_t*)(ws + WS_WQKV); sc = P.norm_mix + 1024; }
            else if (r < 512 + 128) { r -= 512; W = P.w_kv; K = 1024; N = 256; WT = (bf16_t*)(ws + WS_WQKV); sc = P.kv_norm; roff = 1024; }
            else { r -= 512 + 128; W = P.w_o; K = 1024; N = 1024; WT = (bf16_t*)(ws + WS_WO); sc = nullptr; }
        } else if (stage == 4) {
            if (r < 512) { W = P.ple_w_gate + 1024 * 1024; K = 1024; N = 1024; WT = (bf16_t*)(ws + WS_WPG0 + 2 * MiB); sc = P.ple_norm + 1024; }
            else { r -= 512; W = P.ple_w_proj + 256 * 1024; K = 256; N = 1024; WT = (bf16_t*)(ws + WS_WPP0 + 512 * 1024); sc = nullptr; }
        } else if (stage == 7) { W = P.w_gate + (size_t)1024 * DFF; K = 1024; N = DFF; WT = (bf16_t*)(ws + WS_WGU0 + 11 * MiB); sc = P.norm_ffn + 1024; mode = 1; }
        else if (stage == 8) { W = P.w_up + (size_t)1024 * DFF; K = 1024; N = DFF; WT = (bf16_t*)(ws + WS_WGU0 + 11 * MiB); sc = P.norm_ffn + 1024; mode = 2; }
        else { W = P.w_down + (size_t)DFF * 1024; K = DFF; N = 1024; WT = (bf16_t*)(ws + WS_WD0 + 5632 * 1024); sc = nullptr; }
        tr_item(W, K, N, WT, sc, mode, roff, scr, r, lane);
    }
    if (stage == 0) {
        bf16_t* XBA = (bf16_t*)(ws + WS_XBA); float* SSA = (float*)(ws + WS_SSA);
        for (int m = gw; m < MT; m += 2 * NGW) {
            const int m2 = m + NGW; const bool has2 = m2 < MT; const int mb = has2 ? m2 : m;
            const float* src = m < MP ? P.x_prompt + (size_t)m * DM : P.x_sample + (size_t)(m - MP) * DM;
            const float* src2 = mb < MP ? P.x_prompt + (size_t)mb * DM : P.x_sample + (size_t)(mb - MP) * DM;
            f32x4 va[4], vb[4];
#pragma unroll
            for (int j = 0; j < 2; ++j) { va[2 * j] = *((const f32x4*)src + 128 * j + 2 * lane); va[2 * j + 1] = *((const f32x4*)src + 128 * j + 2 * lane + 1); vb[2 * j] = *((const f32x4*)src2 + 128 * j + 2 * lane); vb[2 * j + 1] = *((const f32x4*)src2 + 128 * j + 2 * lane + 1); }
            float s = 0.f, s2 = 0.f;
#pragma unroll
            for (int j = 0; j < 2; ++j) { s += dot4(va[2 * j]) + dot4(va[2 * j + 1]); s2 += dot4(vb[2 * j]) + dot4(vb[2 * j + 1]);
                *((u32x4*)(XBA + (size_t)m * DM) + 64 * j + lane) = pack8(va[2 * j], va[2 * j + 1]); if (has2) *((u32x4*)(XBA + (size_t)m2 * DM) + 64 * j + lane) = pack8(vb[2 * j], vb[2 * j + 1]); }
            s = wave_sum(s, lane); s2 = wave_sum(s2, lane);
            if (lane == 0) { ss_set(SSA, m, s); ss_set((float*)(ws + WS_SSB), m, 0.f); ss_set((float*)(ws + WS_VSS), m, 0.f); if (has2) { ss_set(SSA, m2, s2); ss_set((float*)(ws + WS_SSB), m2, 0.f); ss_set((float*)(ws + WS_VSS), m2, 0.f); } }
        }
        const int gt = blockIdx.x * 512 + tid, NGT = 256 * 512;
        bf16_t* WTT = (bf16_t*)(ws + WS_WTRIL);
        for (int i = gt; i < 8 * 128 * 128 / 2; i += NGT) { const int e = 2 * i, sx = e & 127, t = (e >> 7) & 127;
            const float a = sx <= t ? P.gm_w_s[e] : 0.f, b = (sx + 1) <= t ? P.gm_w_s[e + 1] : 0.f; ((unsigned*)WTT)[i] = cvt_pk_bf16(a, b); }
        float* rope = (float*)(ws + WS_ROPE);
        for (int i = gt; i < 8196 * 8; i += NGT) { const int pi = i >> 3, f = i & 7; const int pos = pi < SEQ ? pi : 16384 + (pi - SEQ);
            const float inv = __builtin_powf(500000.0f, -(float)f * 0.125f); const float ang = (float)pos * inv;
            double rev = (double)ang * 0.15915494309189535; rev -= __builtin_rint(rev); const float rf = (float)rev;
            rope[pi * 16 + f] = __builtin_amdgcn_cosf(rf); rope[pi * 16 + 8 + f] = __builtin_amdgcn_sinf(rf); }
    }
    if (stage == 4 || stage == 6) {
        const int L = stage == 6 ? 1 : 0;
        bf16_t* PB = (bf16_t*)(ws + WS_PB) + (size_t)L * MT * PLE;
        for (int m0 = gw; m0 < MT; m0 += 4 * NGW) {
            f32x4 v[4];
#pragma unroll
            for (int q = 0; q < 4; ++q) { const int m = m0 + q * NGW < MT ? m0 + q * NGW : m0;
                const float* src = m < MP ? P.p_prompt + ((size_t)L * MP + m) * PLE : P.p_sample + ((size_t)L * MS + (m - MP)) * PLE; v[q] = *((const f32x4*)src + lane); }
#pragma unroll
            for (int q = 0; q < 4; ++q) { const int m = m0 + q * NGW; if (m < MT) *((u32x2*)(PB + (size_t)m * PLE) + lane) = pack4(v[q]); }
        }
    }
}

__device__ __forceinline__ void gating_phase(LAS unsigned char* lds, int G, int wave0) {
    const Params P = load_params(lds);
    const int tid = opaque_tid(wave0), lane = tid & 63, wave = tid >> 6, fr = lane & 15, fq = lane >> 4;
    unsigned char* ws = P.ws;
    bf16_t* Z = (bf16_t*)(ws + WS_Z); const float* VSS = (const float*)(ws + WS_VSS); const bf16_t* WTR = (const bf16_t*)(ws + WS_WTRIL);
    LAS bf16_t* Vs = (LAS bf16_t*)lds;
    LAS float* rsb = (LAS float*)(lds + 128 * 264 * 2);
    LAS bf16_t* Wsl = (LAS bf16_t*)(lds + 69632);
    LAS float* vws = (LAS float*)(lds + 69632 + 128 * 136 * 2);
    LAS float* bsl = vws + 256;
    { const int g0 = (int)blockIdx.x & 7;
      for (int i = tid; i < 2048; i += 512) { const int row = i >> 4, c8 = (i & 15) * 8; *(LAS u32x4*)(Wsl + row * 136 + c8) = *(const u32x4*)(WTR + (size_t)(g0 * 128 + row) * 128 + c8); }
      if (tid < 64) *(LAS f32x4*)(vws + 4 * tid) = *(const f32x4*)(P.gm_v_norm + 256 * g0 + 4 * tid);
      else if (tid < 96) *(LAS f32x4*)(bsl + 4 * (tid - 64)) = *(const f32x4*)(P.gm_b_s + 128 * g0 + 4 * (tid - 64)); }
    u32x4 raw[8]; float rsn[8];
#define GATE_FETCH(un) do { const int ch_ = (un) >> 3, g_ = (un) & 7; _Pragma("unroll") for (int j = 0; j < 8; ++j) { const int idx = tid + 512 * j, r = idx >> 5, c8 = (idx & 31) * 8; \
        raw[j] = *(const u32x4*)(Z + (size_t)(ch_ * 128 + r) * 4096 + 2048 + 256 * g_ + c8); rsn[j] = ss_get(VSS, ch_ * 128 + r); } } while (0)
    if ((int)blockIdx.x < 2048) GATE_FETCH(blockIdx.x);
    __syncthreads();
    for (int unit = blockIdx.x; unit < 2048; unit += G) {
        const int ch = unit >> 3, g = unit & 7, row0 = ch * 128;
#pragma unroll
        for (int j = 0; j < 8; ++j) { const int idx = tid + 512 * j, r = idx >> 5, c8 = (idx & 31) * 8;
            const f32x4 wa = *(const LAS f32x4*)(vws + c8), wb = *(const LAS f32x4*)(vws + c8 + 4);
            const float rs = __builtin_amdgcn_rsqf(rsn[j] * (1.0f / 2048.0f) + EPS);
            const u32x4 rw = raw[j]; u32x4 o;
            o.x = cvt_pk_bf16(bf2f(rw.x & 0xffffu) * rs * wa[0], bf2f(rw.x >> 16) * rs * wa[1]);
            o.y = cvt_pk_bf16(bf2f(rw.y & 0xffffu) * rs * wa[2], bf2f(rw.y >> 16) * rs * wa[3]);
            o.z = cvt_pk_bf16(bf2f(rw.z & 0xffffu) * rs * wb[0], bf2f(rw.z >> 16) * rs * wb[1]);
            o.w = cvt_pk_bf16(bf2f(rw.w & 0xffffu) * rs * wb[2], bf2f(rw.w >> 16) * rs * wb[3]);
            *(LAS u32x4*)(Vs + r * 264 + c8) = o; }
        __syncthreads();
        if (unit + G < 2048) GATE_FETCH(unit + G);
        bf16x8 vf[4][2];
#pragma unroll
        for (int ks = 0; ks < 4; ++ks)
#pragma unroll
            for (int nt = 0; nt < 2; ++nt)
#pragma unroll
                for (int j = 0; j < 8; ++j) vf[ks][nt][j] = (short)Vs[(32 * ks + 8 * fq + j) * 264 + 32 * wave + 8 * (fr >> 2) + 4 * nt + (fr & 3)];
        u32x4 uu[8];
#pragma unroll
        for (int mt = 0; mt < 8; ++mt) uu[mt] = *(const u32x4*)(Z + (size_t)(row0 + 16 * mt + fr) * 4096 + 256 * g + 32 * wave + 8 * fq);
#pragma unroll
        for (int mt = 0; mt < 8; ++mt) {
            f32x4 a2[2] = {(f32x4){0.f, 0.f, 0.f, 0.f}, (f32x4){0.f, 0.f, 0.f, 0.f}};
#pragma unroll
            for (int ks = 0; ks < 4; ++ks) if (32 * ks <= 16 * mt + 15) {
                const bf16x8 wf = *(const LAS bf16x8*)(Wsl + (16 * mt + fr) * 136 + 32 * ks + 8 * fq);
#pragma unroll
                for (int nt = 0; nt < 2; ++nt) a2[nt] = __builtin_amdgcn_mfma_f32_16x16x32_bf16(vf[ks][nt], wf, a2[nt], 0, 0, 0);
            }
            const int t = 16 * mt + fr; const float bias = bsl[t];
            *(u32x4*)(Z + (size_t)(row0 + t) * 4096 + 256 * g + 32 * wave + 8 * fq) = pack8(unpack4((u32x2){uu[mt].x, uu[mt].y}) * (a2[0] + bias), unpack4((u32x2){uu[mt].z, uu[mt].w}) * (a2[1] + bias));
        }
        __syncthreads();
    }
#undef GATE_FETCH
    float* gmv = P.out + O_GMV;
    for (int b = blockIdx.x; b < 128; b += G) {
        const int row0 = MP + 4 * b;
        if (tid < 4) rsb[tid] = __builtin_amdgcn_rsqf(ss_get(VSS, row0 + tid) * (1.0f / 2048.0f) + EPS);
        __syncthreads();
        const int c = 4 * tid, g = c >> 8;
        const f32x4 vw = *(const f32x4*)(P.gm_v_norm + c);
        f32x4 v[4];
#pragma unroll
        for (int s = 0; s < 4; ++s) { v[s] = unpack4(*(const u32x2*)(Z + (size_t)(row0 + s) * 4096 + 2048 + c)) * rsb[s] * vw; *(f32x4*)(gmv + (size_t)(4 * b + s) * GH + c) = v[s]; }
#pragma unroll
        for (int t = 0; t < 4; ++t) { const float bias = P.gm_b_s[g * 128 + t]; f32x4 mx = (f32x4){bias, bias, bias, bias};
#pragma unroll
            for (int s = 0; s <= t; ++s) mx = mx + v[s] * P.gm_w_s[(g * 128 + t) * 128 + s];
            bf16_t* zp = Z + (size_t)(row0 + t) * 4096 + c; *(u32x2*)zp = pack4(unpack4(*(const u32x2*)zp) * mx); }
        __syncthreads();
    }
}

__device__ __forceinline__ void fixup_phase(LAS unsigned char* lds, int L, int G, int wave0) {
    const Params P = load_params(lds);
    unsigned char* ws = P.ws;
    const f32x4* HG = (const f32x4*)(ws + WS_HG); const f32x4* C0 = (const f32x4*)(ws + WS_C0); const f32x4* U0 = (const f32x4*)(ws + WS_U0);
    bf16_t* ACT = (bf16_t*)(ws + WS_Z);
    const f32x4* cw = (const f32x4*)(P.conv_w + (size_t)L * 3 * DFF);
    const int gt = blockIdx.x * 512 + opaque_tid(wave0), NGT = G * 512;
    for (int idx = gt; idx < 1024 * 704; idx += NGT) {
        const int gj = idx / 704, c4 = idx % 704, grp = gj >> 1, j = gj & 1, r = 64 * grp + j;
        f32x4 conv = C0[idx]; const f32x4 up = U0[idx];
        if ((grp & 127) != 0) { const f32x4 h0 = HG[(size_t)((grp - 1) * 2) * 704 + c4], h1 = HG[(size_t)((grp - 1) * 2 + 1) * 704 + c4]; const f32x4 w0 = cw[c4], w1 = cw[704 + c4];
            conv = conv + (j == 0 ? (w0 * h0 + w1 * h1) : (w0 * h1)); }
        *(u32x2*)(ACT + (size_t)r * DFF + 4 * c4) = pack4(gelu4(conv) * up);
    }
    for (int i = gt; i < MT; i += NGT) { ((unsigned*)(ws + WS_SSA))[i] = 0u; ((unsigned*)(ws + WS_SSB))[i] = 0u; }
    f32x4* ncp = (f32x4*)(P.out + O_NCP + (size_t)L * 4 * 2 * DFF);
    for (int idx = gt; idx < 8 * 704; idx += NGT) { const int bj = idx / 704, c4 = idx % 704, b = bj >> 1, j = bj & 1; ncp[idx] = HG[(size_t)((128 * b + 127) * 2 + j) * 704 + c4]; }
}

template <int PAR> __device__ __forceinline__ float attn_softmax(f32x4 (&S)[10], bool fastp, bool samp, int qb, int qi, int kt0, int fq, int dq, float sink) {
    float mx = sink;
    if (fastp) {
#pragma unroll
        for (int i = 0; i < 10; ++i) { const int c = i - PAR;
            if (c < 0 || c > 8) continue;
#pragma unroll
            for (int j = 0; j < 4; ++j) {
                if (c == 0) { if (!(dq + j > 0)) S[i][j] = -1e30f; }
                else if (c == 8) { if (!(dq + j <= 0)) S[i][j] = -1e30f; }
                mx = fmaxf(mx, S[i][j]); } }
    } else {
#pragma unroll
        for (int i = 0; i < 10; ++i)
#pragma unroll
            for (int j = 0; j < 4; ++j) { const int kw = 16 * (kt0 + i) + 4 * fq + j;
                const bool vis = (kw > qi) && (kw <= qi + 128) && (samp ? (kw < 132) : (qb > 0 || kw >= 128));
                const float sv = vis ? S[i][j] : -1e30f; S[i][j] = sv; mx = fmaxf(mx, sv); }
    }
    mx = xmax16(mx); mx = xmax32(mx);
    float sum = 0.f;
#pragma unroll
    for (int i = 0; i < 10; ++i) { const int c = i - PAR;
        if (fastp && (c < 0 || c > 8)) { S[i] = (f32x4){0.f, 0.f, 0.f, 0.f}; continue; }
#pragma unroll
        for (int j = 0; j < 4; ++j) { const float e = __builtin_amdgcn_exp2f(S[i][j] - mx); S[i][j] = e; sum += e; } }
    sum = xsum16(sum); sum = xsum32(sum);
    return 1.0f / (sum + __builtin_amdgcn_exp2f(sink - mx));
}
__device__ __forceinline__ bf16x8 attn_pfrag(const f32x4& a, const f32x4& b, float inv) {
    const f32x4 p0 = a * inv, p1 = b * inv;
    const u32x4 pw = (u32x4){cvt_pk_bf16(p0[0], p0[1]), cvt_pk_bf16(p0[2], p0[3]), cvt_pk_bf16(p1[0], p1[1]), cvt_pk_bf16(p1[2], p1[3])};
    return __builtin_bit_cast(bf16x8, pw);
}
__device__ __forceinline__ void attn_phase(LAS unsigned char* lds, int G, int wave0, int odummy) {
    const Params P = load_params(lds);
    const int tid = opaque_tid(wave0), lane = tid & 63, wave = tid >> 6, fr = lane & 15, fq = lane >> 4;
    unsigned char* ws = P.ws;
    bf16_t* Q = (bf16_t*)(ws + WS_Z + 195 * MiB); bf16_t* Oout = odummy ? (bf16_t*)(ws + WS_Z + 130 * MiB) : Q; const bf16_t* KB = (const bf16_t*)(ws + WS_KB); const bf16_t* VB = (const bf16_t*)(ws + WS_VB);
    LAS bf16_t* Ks = (LAS bf16_t*)lds;
    LAS bf16_t* VTs = (LAS bf16_t*)(lds + 256 * 72 * 2);
    for (int i = blockIdx.x * 512 + tid; i < MT; i += G * 512) ((unsigned*)(ws + WS_SSB))[i] = 0u;
    for (int unit = blockIdx.x; unit < 768; unit += G) {
        const bool samp = unit >= 512;
        const int kvh = unit & 1;
        int b, qb;
        if (!samp) { b = unit >> 7; qb = (unit >> 1) & 63; } else { b = (unit - 512) >> 1; qb = 1; }
#pragma unroll
        for (int j = 0; j < 4; ++j) {
            const int idx = tid + 512 * j, r = idx >> 3, c8 = (idx & 7) * 8;
            u32x4 kv = (u32x4){0u, 0u, 0u, 0u}, vv = (u32x4){0u, 0u, 0u, 0u};
            if (!samp) { const int t = 128 * (qb - 1) + r; if (t >= 0) { const size_t go = (size_t)(b * SEQ + t) * KVD + kvh * 64 + c8; kv = *(const u32x4*)(KB + go); vv = *(const u32x4*)(VB + go); } }
            else if (r < 128) { const size_t go = ((size_t)(b * 128 + r) * 2 + kvh) * 64 + c8;
                const f32x4 k0 = *(const f32x4*)(P.cache_k + go), k1 = *(const f32x4*)(P.cache_k + go + 4), v0 = *(const f32x4*)(P.cache_v + go), v1 = *(const f32x4*)(P.cache_v + go + 4);
                kv = (u32x4){cvt_pk_bf16(k0[0], k0[1]), cvt_pk_bf16(k0[2], k0[3]), cvt_pk_bf16(k1[0], k1[1]), cvt_pk_bf16(k1[2], k1[3])};
                vv = (u32x4){cvt_pk_bf16(v0[0], v0[1]), cvt_pk_bf16(v0[2], v0[3]), cvt_pk_bf16(v1[0], v1[1]), cvt_pk_bf16(v1[2], v1[3])}; }
            else if (r < 132) { const size_t go = (size_t)(MP + 4 * b + (r - 128)) * KVD + kvh * 64 + c8; kv = *(const u32x4*)(KB + go); vv = *(const u32x4*)(VB + go); }
            *(LAS u32x4*)(Ks + r * 72 + c8) = kv;
            const int sp = r & 31, kk = (r & ~31) + 8 * ((sp & 15) >> 2) + 4 * (sp >> 4) + (sp & 3);
            LAS bf16_t* vt = VTs + c8 * 264 + kk;
            vt[0 * 264] = (bf16_t)(vv.x & 0xffffu); vt[1 * 264] = (bf16_t)(vv.x >> 16); vt[2 * 264] = (bf16_t)(vv.y & 0xffffu); vt[3 * 264] = (bf16_t)(vv.y >> 16);
            vt[4 * 264] = (bf16_t)(vv.z & 0xffffu); vt[5 * 264] = (bf16_t)(vv.z >> 16); vt[6 * 264] = (bf16_t)(vv.w & 0xffffu); vt[7 * 264] = (bf16_t)(vv.w >> 16);
        }
        __syncthreads();
        const int lane_ = lane; const int h = kvh * 8 + wave; const float sink = P.sinks[h] * LOG2E;
        const int nrt = samp ? 1 : 8;
        const bool fastp = !samp && qb > 0;
        const int dq = 4 * fq - fr;
#pragma unroll 1
        for (int rt2 = 0; rt2 < nrt; rt2 += 2) {
            const bool two = !samp;
            const int rowq0 = samp ? (MP + 4 * b + (fr & 3)) : (b * SEQ + qb * 128 + rt2 * 16 + fr), rowq1 = rowq0 + (two ? 16 : 0);
            const int qi0 = samp ? fr : 16 * rt2 + fr, qi1 = qi0 + 16;
            const int kt0 = samp ? 0 : rt2;
            bf16x8 qA[2], qB[2];
#pragma unroll
            for (int k = 0; k < 2; ++k) { qA[k] = *(const bf16x8*)(Q + (size_t)rowq0 * 1024 + h * 64 + 32 * k + 8 * fq); qB[k] = *(const bf16x8*)(Q + (size_t)rowq1 * 1024 + h * 64 + 32 * k + 8 * fq); }
            f32x4 SA[10], SB[10];
#pragma unroll
            for (int i = 0; i < 10; ++i) { f32x4 a = (f32x4){0.f, 0.f, 0.f, 0.f}, c2 = (f32x4){0.f, 0.f, 0.f, 0.f};
                const bool needA = !(fastp && i > 8), needB = two && !(fastp && i < 1);
#pragma unroll
                for (int k = 0; k < 2; ++k) { const bf16x8 kf = *(const LAS bf16x8*)(Ks + (16 * (kt0 + i) + fr) * 72 + 32 * k + 8 * fq);
                    if (needA) a = __builtin_amdgcn_mfma_f32_16x16x32_bf16(kf, qA[k], a, 0, 0, 0);
                    if (needB) c2 = __builtin_amdgcn_mfma_f32_16x16x32_bf16(kf, qB[k], c2, 0, 0, 0); }
                SA[i] = a; SB[i] = c2; }
            const float invA = attn_softmax<0>(SA, fastp, samp, qb, qi0, kt0, fq, dq, sink);
            float invB = 0.f;
            if (two) invB = attn_softmax<1>(SB, fastp, samp, qb, qi1, kt0, fq, dq, sink);
            f32x4 oA[4] = {(f32x4){0.f, 0.f, 0.f, 0.f}, (f32x4){0.f, 0.f, 0.f, 0.f}, (f32x4){0.f, 0.f, 0.f, 0.f}, (f32x4){0.f, 0.f, 0.f, 0.f}};
            f32x4 oB[4] = {(f32x4){0.f, 0.f, 0.f, 0.f}, (f32x4){0.f, 0.f, 0.f, 0.f}, (f32x4){0.f, 0.f, 0.f, 0.f}, (f32x4){0.f, 0.f, 0.f, 0.f}};
#pragma unroll
            for (int i = 0; i < 5; ++i) {
                const bf16x8 pA = attn_pfrag(SA[2 * i], SA[2 * i + 1], invA), pB = attn_pfrag(SB[2 * i], SB[2 * i + 1], invB);
#pragma unroll
                for (int dt = 0; dt < 4; ++dt) { const bf16x8 vfr = *(const LAS bf16x8*)(VTs + (32 * (dt >> 1) + 8 * (fr >> 2) + 4 * (dt & 1) + (fr & 3)) * 264 + 32 * ((kt0 >> 1) + i) + 8 * fq);
                    oA[dt] = __builtin_amdgcn_mfma_f32_16x16x32_bf16(vfr, pA, oA[dt], 0, 0, 0);
                    if (two) oB[dt] = __builtin_amdgcn_mfma_f32_16x16x32_bf16(vfr, pB, oB[dt], 0, 0, 0); }
            }
            if (!samp || fr < 4) {
#pragma unroll
                for (int dp = 0; dp < 2; ++dp) *(u32x4*)(Oout + (size_t)rowq0 * 1024 + h * 64 + 32 * dp + 8 * fq) = pack8(oA[2 * dp], oA[2 * dp + 1]);
            }
            if (two) {
#pragma unroll
                for (int dp = 0; dp < 2; ++dp) *(u32x4*)(Oout + (size_t)rowq1 * 1024 + h * 64 + 32 * dp + 8 * fq) = pack8(oB[2 * dp], oB[2 * dp + 1]);
            }
        }
        __syncthreads();
    }
}

__device__ __forceinline__ void final_phase(LAS unsigned char* lds, int G, int wave0) {
    const Params P = load_params(lds);
    const int tid = opaque_tid(wave0), lane = tid & 63, wave = tid >> 6;
    const float* SSB = (const float*)(P.ws + WS_SSB);
    const bf16_t* XB = (const bf16_t*)(P.ws + WS_Z + 130 * MiB);
    const int gw = blockIdx.x * 8 + wave, NGW = G * 8;
    f32x4 w[4];
#pragma unroll
    for (int j = 0; j < 2; ++j) { w[2 * j] = *((const f32x4*)P.final_norm + 128 * j + 2 * lane); w[2 * j + 1] = *((const f32x4*)P.final_norm + 128 * j + 2 * lane + 1); }
    for (int m = gw; m < MT; m += 2 * NGW) {
        const int m2 = m + NGW < MT ? m + NGW : m;
        const float rs = rstd16(SSB, m), rs2 = rstd16(SSB, m2);
        u32x4 a[2], b[2];
#pragma unroll
        for (int j = 0; j < 2; ++j) { a[j] = *((const u32x4*)(XB + (size_t)m * DM) + 64 * j + lane); b[j] = *((const u32x4*)(XB + (size_t)m2 * DM) + 64 * j + lane); }
        f32x4* yr = (f32x4*)(P.out + (size_t)m * DM); f32x4* yr2 = (f32x4*)(P.out + (size_t)m2 * DM);
#pragma unroll
        for (int j = 0; j < 2; ++j) {
            yr[128 * j + 2 * lane] = unpack4((u32x2){a[j].x, a[j].y}) * rs * w[2 * j]; yr[128 * j + 2 * lane + 1] = unpack4((u32x2){a[j].z, a[j].w}) * rs * w[2 * j + 1];
            if (m2 != m) { yr2[128 * j + 2 * lane] = unpack4((u32x2){b[j].x, b[j].y}) * rs2 * w[2 * j]; yr2[128 * j + 2 * lane + 1] = unpack4((u32x2){b[j].z, b[j].w}) * rs2 * w[2 * j + 1]; }
        }
    }
}

#define XB_TMO      128
#define XB_XCNT(j)  (256  + 64 * (j))
#define XB_XSUB(j)  (1280 + 64 * (j))
#define XB_XGEN(j)  (2304 + 64 * (j))
#define XB_TOP      3328
#define XB_TOPGEN   3392
#define XCD_BAR_WORDS 3456
#define XB_SPIN_CAP (1u << 18)
__device__ __forceinline__ unsigned xb_ld(unsigned* p)              { return __hip_atomic_load(p, __ATOMIC_RELAXED, __HIP_MEMORY_SCOPE_AGENT); }
__device__ __forceinline__ unsigned xb_add(unsigned* p, unsigned v) { return __hip_atomic_fetch_add(p, v, __ATOMIC_RELAXED, __HIP_MEMORY_SCOPE_AGENT); }
__device__ __forceinline__ unsigned xb_xcc_id() { return (unsigned)__builtin_amdgcn_s_getreg((3 << 11) | 20) & 0xFu; }
#define XB_SPIN(cond, bar) do { unsigned _sp = 0; while (cond) { __builtin_amdgcn_s_sleep(1); \
    if ((++_sp & 255u) == 0u) { if (xb_ld(&(bar)[XB_TMO])) break; if (_sp > XB_SPIN_CAP) { atomicAdd(&(bar)[XB_TMO], 1u); break; } } } } while (0)
struct XcdBarrier { unsigned* bar; unsigned x; volatile LAS unsigned* st; };
__device__ __forceinline__ XcdBarrier xcd_barrier_post(unsigned* bar, volatile LAS unsigned* st) {
    XcdBarrier b; b.bar = bar; b.x = xb_xcc_id(); b.st = st;
    if (threadIdx.x == 0) (void)xb_add(&bar[XB_XCNT(b.x)], 1u);
    return b;
}
__device__ __forceinline__ void xcd_barrier_complete(unsigned* bar, unsigned x, unsigned& nloc, unsigned& nx) {
    const unsigned G = gridDim.x * gridDim.y * gridDim.z;
    unsigned sum, cnt, mine, sp = 0u;
    for (;;) {
        sum = 0u; cnt = 0u; mine = 0u;
#pragma unroll
        for (unsigned j = 0; j < 16; ++j) { const unsigned c = xb_ld(&bar[XB_XCNT(j)]); sum += c; cnt += (c > 0u) ? 1u : 0u; mine = (j == x) ? c : mine; }
        if (sum == G) break;
        __builtin_amdgcn_s_sleep(1);
        if ((++sp & 255u) == 0u) { if (xb_ld(&bar[XB_TMO])) break; if (sp > XB_SPIN_CAP) { atomicAdd(&bar[XB_TMO], 1u); break; } }
    }
    nloc = mine > 0u ? mine : 1u; nx = cnt > 0u ? cnt : 1u;
}
__device__ __forceinline__ void xcd_barrier(const XcdBarrier& b) {
    asm volatile("s_waitcnt vmcnt(0)" ::: "memory");
    __syncthreads();
    if (threadIdx.x == 0) {
        unsigned* bar = b.bar;
        __builtin_amdgcn_s_waitcnt(0);
        unsigned nloc = b.st[0], nx = b.st[1];
        if (nloc == 0u) { xcd_barrier_complete(bar, b.x, nloc, nx); b.st[0] = nloc; b.st[1] = nx; }
        const unsigned old = xb_add(&bar[XB_XSUB(b.x)], 1u);
        const unsigned gen = old / nloc;
        if (old + 1u == (gen + 1u) * nloc) {
            __builtin_amdgcn_fence(__ATOMIC_RELEASE, "agent");
            asm volatile("s_waitcnt vmcnt(0)" ::: "memory");
            const unsigned og = xb_add(&bar[XB_TOP], 1u);
            const unsigned tg = og / nx;
            if (og + 1u == (tg + 1u) * nx) xb_add(&bar[XB_TOPGEN], 1u);
            else XB_SPIN(xb_ld(&bar[XB_TOPGEN]) == tg, bar);
            __builtin_amdgcn_fence(__ATOMIC_ACQUIRE, "agent");
            xb_add(&bar[XB_XGEN(b.x)], 1u);
            asm volatile("s_waitcnt vmcnt(0)" ::: "memory");
        } else {
            XB_SPIN(xb_ld(&bar[XB_XGEN(b.x)]) == gen, bar);
            __builtin_amdgcn_fence(__ATOMIC_ACQUIRE, "agent");
            asm volatile("s_waitcnt vmcnt(0)" ::: "memory");
        }
    }
    __syncthreads();
}

constexpr int LDS_BYTES = 147456;
__global__ void __launch_bounds__(512, 2) yoco_fwd(Params Pk) {
    extern __shared__ __attribute__((aligned(16))) unsigned char lds_raw[];
    LAS unsigned char* lds = (LAS unsigned char*)lds_raw;
    cg::grid_group grid = cg::this_grid();
#ifndef PROBE_MASK
#define PROBE_MASK 0u
#endif
#if PROBE == 1
#define GSYNC() do { xcd_barrier(xbar); xcd_barrier(xbar); } while (0)
#elif PROBE_MASK != 0u
    int ph_ = 1; unsigned long long tprev_ = __builtin_amdgcn_s_memrealtime();
#define GSYNC() do { xcd_barrier(xbar); unsigned long long tn_ = __builtin_amdgcn_s_memrealtime(); \
        if ((PROBE_MASK >> ph_) & 1u) { if (blockIdx.x == 0) { while (__builtin_amdgcn_s_memrealtime() - tn_ < tn_ - tprev_) __builtin_amdgcn_s_sleep(8); } xcd_barrier(xbar); tn_ = __builtin_amdgcn_s_memrealtime(); } \
        tprev_ = tn_; ++ph_; } while (0)
#else
#define GSYNC() do { XcdBarrier xb_; { unsigned po_ = PARAM_OFF; asm volatile("" : "+v"(po_)); xb_.bar = (unsigned*)(__attribute__((address_space(1))) unsigned*)ldq(lds + po_, 29) + 4096; } xb_.x = xb_xcc_id(); xb_.st = (volatile LAS unsigned*)(lds + 131072 + 512); xcd_barrier(xb_); } while (0)
#endif
#ifndef PHM
#define PHM 0xffff
#endif
#if PROBE >= 3
#define REP_BEGIN(id) { int nrep_ = (PROBE == (id)) ? 2 : 1; asm volatile("" : "+s"(nrep_)); _Pragma("unroll 1") for (int r_ = 0; r_ < nrep_; ++r_) {
#define REP_END() } }
#else
#define REP_BEGIN(id) {
#define REP_END() }
#endif
    constexpr int G = 256;
    const int wave0 = __builtin_amdgcn_readfirstlane((int)threadIdx.x >> 6);
    volatile LAS unsigned* xst = (volatile LAS unsigned*)(lds + 131072 + 512);
    if (threadIdx.x < 2) xst[threadIdx.x] = 0u;
    if (threadIdx.x < 30) ((LAS unsigned long long*)(lds + PARAM_OFF))[threadIdx.x] = ((const unsigned long long*)&Pk)[threadIdx.x];
    __syncthreads();
    XcdBarrier xbar = xcd_barrier_post((unsigned*)Pk.ws + 4096, xst);

    if (PHM & 1) conv_stage(lds, 0, 0, wave0);
    if (Pk.ws == nullptr) grid.sync();
    xcd_barrier(xbar);
#if PROBE_MASK != 0u
    { unsigned long long tn_ = __builtin_amdgcn_s_memrealtime();
      if (PROBE_MASK & 1u) { if (blockIdx.x == 0) { while (__builtin_amdgcn_s_memrealtime() - tn_ < tn_ - tprev_) __builtin_amdgcn_s_sleep(8); } xcd_barrier(xbar); tn_ = __builtin_amdgcn_s_memrealtime(); }
      tprev_ = tn_; }
#endif
#pragma unroll 1
    for (int L = 0; L < 2; ++L) {
        pg8::StaticOrder S;
        if (L == 0) {
            { const Params P = load_params(lds); unsigned char* ws = P.ws;
              pg8::Gemm g{(const bf16_t*)(ws + WS_XBA), (const bf16_t*)(ws + WS_WIN), MT, 4096, 1024, 1024}; S.init(MP, 4096, G, blockIdx.x);
              EpiGm E{(const float*)(ws + WS_SSA), (bf16_t*)(ws + WS_Z), (float*)(ws + WS_VSS)}; if (PHM & 2) pg8::gemm_phase<EpiGm>(lds, g, S, E, wave0); }
            conv_stage(lds, 1, 64, wave0);
            GSYNC();
            if (PHM & 4) gating_phase(lds, G, wave0);
            GSYNC();
        } else {
            { const Params P = load_params(lds); unsigned char* ws = P.ws;
              pg8::Gemm g{(const bf16_t*)(ws + WS_Z + 130 * MiB), (const bf16_t*)(ws + WS_WQKV), MT, 1280, 1024, 1024}; S.init(MP, 1280, G, blockIdx.x);
              EpiQKV E{(const float*)(ws + WS_SSB), (const float*)(ws + WS_ROPE), (bf16_t*)(ws + WS_Z + 195 * MiB), (bf16_t*)(ws + WS_KB), (bf16_t*)(ws + WS_VB), P.out};
              if (PHM & 8) pg8::gemm_phase<EpiQKV>(lds, g, S, E, wave0); }
            GSYNC();
#if PROBE == 2
            attn_phase(lds, G, wave0, 1);
#endif
            if (PHM & 16) attn_phase(lds, G, wave0, 0);
            GSYNC();
        }
        { const Params P = load_params(lds); unsigned char* ws = P.ws;
          pg8::Gemm g{(const bf16_t*)(ws + WS_Z + (L == 0 ? 0 : 195 * MiB)), (const bf16_t*)(ws + (L == 0 ? WS_WOUT : WS_WO)), MT, 1024, L == 0 ? 2048 : 1024, L == 0 ? 4096 : 1024}; S.init(MP, 1024, G, blockIdx.x);
          EpiRes E{(const bf16_t*)(ws + (L == 0 ? WS_XBA : WS_Z + 130 * MiB)), (bf16_t*)(ws + WS_XBA), (float*)(ws + WS_SSB)}; if (PHM & 32) pg8::gemm_phase<EpiRes>(lds, g, S, E, wave0); }
        if (L == 0) conv_stage(lds, 2, 16, wave0); else conv_stage(lds, 8, 16, wave0);
        GSYNC();
        { const Params P = load_params(lds); unsigned char* ws = P.ws;
          pg8::Gemm g{(const bf16_t*)(ws + WS_XBA), (const bf16_t*)(ws + WS_WGU0 + (size_t)L * 11 * MiB), MT, 2 * DFF, 1024, 1024}; S.init(MP, 2 * DFF, G, blockIdx.x);
          EpiGU E{(const float*)(ws + WS_SSB), (bf16_t*)(ws + WS_Z), P.conv_w + (size_t)L * 3 * DFF, P.conv_b + (size_t)L * DFF, (float*)(ws + WS_HG), (float*)(ws + WS_C0), (float*)(ws + WS_U0),
                  P.state + (size_t)L * 128 * 2 * DFF, P.out + O_NCS + (size_t)L * 128 * 2 * DFF};
          REP_BEGIN(3) if (PHM & 64) pg8::gemm_phase<EpiGU>(lds, g, S, E, wave0); REP_END()
        }
        if (L == 0) conv_stage(lds, 3, 88, wave0); else conv_stage(lds, 5, 88, wave0);
        GSYNC();
        if (PHM & 128) fixup_phase(lds, L, G, wave0);
        GSYNC();
        { const Params P = load_params(lds); unsigned char* ws = P.ws;
          pg8::Gemm g{(const bf16_t*)(ws + WS_Z), (const bf16_t*)(ws + WS_WD0 + (size_t)L * 5632 * 1024), MT, 1024, DFF, DFF}; S.init(MP, 1024, G, blockIdx.x);
          EpiRes E{(const bf16_t*)(ws + WS_XBA), (bf16_t*)(ws + WS_XBA), (float*)(ws + WS_SSA)}; if (PHM & 256) pg8::gemm_phase<EpiRes>(lds, g, S, E, wave0); }
        if (L == 0) conv_stage(lds, 4, 16, wave0); else conv_stage(lds, 6, 16, wave0);
        GSYNC();
        { const Params P = load_params(lds); unsigned char* ws = P.ws;
          pg8::Gemm g{(const bf16_t*)(ws + WS_PB) + (size_t)L * MT * PLE, (const bf16_t*)(ws + WS_WPP0 + (size_t)L * 512 * 1024), MT, 1024, 256, 256}; S.init(MP, 1024, G, blockIdx.x);
          EpiBf E{(bf16_t*)(ws + WS_Z)}; if (PHM & 512) pg8::gemm_phase<EpiBf>(lds, g, S, E, wave0); }
        { const Params P = load_params(lds); unsigned char* ws = P.ws;
          pg8::Gemm g{(const bf16_t*)(ws + WS_XBA), (const bf16_t*)(ws + WS_WPG0 + (size_t)L * 2 * MiB), MT, 1024, 1024, 1024}; S.init(MP, 1024, G, blockIdx.x);
          EpiPle E{(const float*)(ws + WS_SSA), (const bf16_t*)(ws + WS_Z), (const bf16_t*)(ws + WS_XBA), (bf16_t*)(ws + WS_Z + 130 * MiB), (float*)(ws + WS_SSB)}; if (PHM & 1024) pg8::gemm_phase<EpiPle>(lds, g, S, E, wave0); }
        if (L == 0) conv_stage(lds, 7, 16, wave0);
        GSYNC();
    }
    if (PHM & 2048) final_phase(lds, G, wave0);
#if PROBE_MASK != 0u
    if ((PROBE_MASK >> 15) & 1u) { asm volatile("s_waitcnt vmcnt(0)" ::: "memory"); const unsigned long long tn_ = __builtin_amdgcn_s_memrealtime(); if (blockIdx.x == 0) { while (__builtin_amdgcn_s_memrealtime() - tn_ < tn_ - tprev_) __builtin_amdgcn_s_sleep(8); } }
#endif
}

extern "C" void kernel_launch(void* const* d_in, const int* in_sizes, int n_in, void* d_out, int out_size, void* d_ws, size_t ws_size, hipStream_t stream) {
    static int grid = 0;
    if (grid == 0) {
        if (n_in != 28 || ws_size < WS_END) { fprintf(stderr, "kernel_launch: unexpected n_in %d / ws_size %zu\n", n_in, ws_size); grid = -1; return; }
        int dev = 0, cus = 0, per_cu = 0;
        hipGetDevice(&dev); hipDeviceGetAttribute(&cus, hipDeviceAttributeMultiprocessorCount, dev);
        hipFuncSetAttribute((const void*)yoco_fwd, hipFuncAttributeMaxDynamicSharedMemorySize, LDS_BYTES);
        hipOccupancyMaxActiveBlocksPerMultiprocessor(&per_cu, (const void*)yoco_fwd, 512, LDS_BYTES);
        if (per_cu < 1) { fprintf(stderr, "kernel_launch: occupancy query says %d blocks/CU\n", per_cu); per_cu = 1; }
        (void)hipGetLastError();
        if (cus < 256) { fprintf(stderr, "kernel_launch: needs 256 CUs, device has %d\n", cus); grid = -1; return; }
        grid = 256;
    }
    if (grid < 0) return;
    if (hipMemsetAsync(d_ws, 0, 65536, stream) != hipSuccess) { fprintf(stderr, "kernel_launch: memset failed\n"); return; }
    Params p{};
    const float** pp = (const float**)&p;
    for (int i = 0; i < 28; ++i) pp[i] = (const float*)d_in[i];
    p.out = (float*)d_out; p.ws = (unsigned char*)d_ws;
    void* args[] = {&p};
    hipError_t e = hipLaunchCooperativeKernel((const void*)yoco_fwd, dim3(grid), dim3(512), args, LDS_BYTES, stream);
    if (e != hipSuccess) fprintf(stderr, "cooperative launch failed: %s (grid %d)\n", hipGetErrorString(e), grid);
}
```

```cpp
#include <hip/hip_runtime.h>
#include <hip/hip_cooperative_groups.h>
#include <cstdio>
#include <cstdint>
namespace cg = cooperative_groups;
#ifndef PROBE
#define PROBE 0
#endif

#define LAS __attribute__((address_space(3)))
typedef unsigned short bf16_t;
typedef short bf16x8 __attribute__((ext_vector_type(8)));
typedef float f32x4 __attribute__((ext_vector_type(4)));
typedef float f32x2 __attribute__((ext_vector_type(2)));
typedef unsigned u32x4 __attribute__((ext_vector_type(4)));
typedef unsigned u32x2 __attribute__((ext_vector_type(2)));

constexpr int DM = 1024, SEQ = 8192, MP = 32768, MS = 512, MT = MP + MS;
constexpr int GH = 2048, DFF = 2816, PLE = 256, KVD = 128;
constexpr float EPS = 1e-6f;
constexpr float LOG2E = 1.4426950408889634f;

constexpr size_t MiB = 1u << 20;
constexpr size_t WS_ROPE = 1 * MiB;
constexpr size_t WS_WTRIL = 2 * MiB;
constexpr size_t WS_SSA = 3 * MiB;
constexpr size_t WS_SSB = 6 * MiB;
constexpr size_t WS_VSS = 9 * MiB;
constexpr size_t WS_HG = 14 * MiB;
constexpr size_t WS_C0 = 25 * MiB;
constexpr size_t WS_U0 = 36 * MiB;
constexpr size_t WS_KB = 47 * MiB;
constexpr size_t WS_VB = 56 * MiB;
constexpr size_t WS_WIN = 66 * MiB;
constexpr size_t WS_WOUT = 74 * MiB;
constexpr size_t WS_WGU0 = 78 * MiB;
constexpr size_t WS_WD0 = 100 * MiB;
constexpr size_t WS_WPG0 = 111 * MiB;
constexpr size_t WS_WPP0 = 115 * MiB;
constexpr size_t WS_WQKV = 116 * MiB;
constexpr size_t WS_WO = 119 * MiB;
constexpr size_t WS_XBA = 121 * MiB;
constexpr size_t WS_PB = 186 * MiB;
constexpr size_t WS_Z = 219 * MiB;
constexpr size_t WS_END = 479 * MiB;

constexpr size_t O_Y = 0, O_GMV = 34078720, O_NCP = 35127296, O_NCS = 35172352, O_NKP = 36614144, O_NVP = 36679680, O_KS = 36745216, O_VS = 36810752;

__device__ __forceinline__ unsigned cvt_pk_bf16(float lo, float hi) { unsigned r; asm volatile("v_cvt_pk_bf16_f32 %0, %1, %2" : "=v"(r) : "v"(lo), "v"(hi)); return r; }
__device__ __forceinline__ float bf2f(unsigned h) { return __uint_as_float(h << 16); }
__device__ __forceinline__ u32x2 pack4(f32x4 v) { u32x2 w; w.x = cvt_pk_bf16(v[0], v[1]); w.y = cvt_pk_bf16(v[2], v[3]); return w; }
__device__ __forceinline__ f32x4 unpack4(u32x2 w) { return (f32x4){bf2f(w.x & 0xffffu), bf2f(w.x >> 16), bf2f(w.y & 0xffffu), bf2f(w.y >> 16)}; }
__device__ __forceinline__ float gelu1(float x) {
    const float z = x * (0.7978845608f + 0.0356774081f * x * x);
    const float e = __builtin_amdgcn_exp2f(-2.0f * LOG2E * z);
    return x * __builtin_amdgcn_rcpf(1.0f + e);
}
__device__ __forceinline__ f32x2 gelu_pk2(f32x2 v) {
    const f32x2 t = (v * v) * (-0.10294325f) + (-2.3022082f);
    const f32x2 y = v * t;
    f32x2 e; e.x = __builtin_amdgcn_exp2f(y.x); e.y = __builtin_amdgcn_exp2f(y.y);
    const f32x2 d = e + 1.0f;
    f32x2 r; r.x = __builtin_amdgcn_rcpf(d.x); r.y = __builtin_amdgcn_rcpf(d.y);
    return v * r;
}
__device__ __forceinline__ f32x4 gelu4(f32x4 v) { const f32x2 a = gelu_pk2((f32x2){v[0], v[1]}), b = gelu_pk2((f32x2){v[2], v[3]}); return (f32x4){a.x, a.y, b.x, b.y}; }
__device__ __forceinline__ f32x4 sigmoid4(f32x4 v) {
    const f32x4 y = v * (-LOG2E);
    const f32x4 e = (f32x4){__builtin_amdgcn_exp2f(y[0]), __builtin_amdgcn_exp2f(y[1]), __builtin_amdgcn_exp2f(y[2]), __builtin_amdgcn_exp2f(y[3])} + 1.0f;
    return (f32x4){__builtin_amdgcn_rcpf(e[0]), __builtin_amdgcn_rcpf(e[1]), __builtin_amdgcn_rcpf(e[2]), __builtin_amdgcn_rcpf(e[3])};
}
__device__ __forceinline__ float sigmoid1(float x) { return __builtin_amdgcn_rcpf(1.0f + __builtin_amdgcn_exp2f(-LOG2E * x)); }
__device__ __forceinline__ u32x4 pack8(f32x4 a, f32x4 b) { u32x4 w; w.x = cvt_pk_bf16(a[0], a[1]); w.y = cvt_pk_bf16(a[2], a[3]); w.z = cvt_pk_bf16(b[0], b[1]); w.w = cvt_pk_bf16(b[2], b[3]); return w; }
__device__ __forceinline__ float dot4(f32x4 v) { return (v[0] * v[0] + v[1] * v[1]) + (v[2] * v[2] + v[3] * v[3]); }
constexpr float SS_SCALE = 512.0f, SS_INV = 1.0f / 512.0f;
__device__ __forceinline__ float ss_get(const float* ss, int row) { return (float)((const unsigned*)ss)[row] * SS_INV; }
__device__ __forceinline__ void ss_set(float* ss, int row, float v) { ((unsigned*)ss)[row] = (unsigned)__builtin_rintf(v * SS_SCALE); }
__device__ __forceinline__ void ss_add(float* ss, int row, float v) { (void)__hip_atomic_fetch_add((unsigned*)ss + row, (unsigned)__builtin_rintf(v * SS_SCALE), __ATOMIC_RELAXED, __HIP_MEMORY_SCOPE_AGENT); }
__device__ __forceinline__ float rstd16(const float* ss, int row) { return __builtin_amdgcn_rsqf(ss_get(ss, row) * (1.0f / 1024.0f) + EPS); }
#define EPI_FENCE() asm volatile("" ::: "memory")
__device__ __forceinline__ int opaque_tid(int wave0) { int l; asm volatile("v_mbcnt_lo_u32_b32 %0, -1, 0\n\tv_mbcnt_hi_u32_b32 %0, -1, %0" : "=v"(l)); return wave0 * 64 + l; }
__device__ __forceinline__ float bperm(float v, int src) { return __int_as_float(__builtin_amdgcn_ds_bpermute(src << 2, __float_as_int(v))); }
__device__ __forceinline__ float xsum16(float v) { const auto r = __builtin_amdgcn_permlane16_swap(__float_as_uint(v), __float_as_uint(v), false, false); return __uint_as_float(r[0]) + __uint_as_float(r[1]); }
__device__ __forceinline__ float xsum32(float v) { const auto r = __builtin_amdgcn_permlane32_swap(__float_as_uint(v), __float_as_uint(v), false, false); return __uint_as_float(r[0]) + __uint_as_float(r[1]); }
__device__ __forceinline__ float xmax16(float v) { const auto r = __builtin_amdgcn_permlane16_swap(__float_as_uint(v), __float_as_uint(v), false, false); return fmaxf(__uint_as_float(r[0]), __uint_as_float(r[1])); }
__device__ __forceinline__ float xmax32(float v) { const auto r = __builtin_amdgcn_permlane32_swap(__float_as_uint(v), __float_as_uint(v), false, false); return fmaxf(__uint_as_float(r[0]), __uint_as_float(r[1])); }
__device__ __forceinline__ float xpartner16(float v, int fq) { const auto r = __builtin_amdgcn_permlane16_swap(__float_as_uint(v), __float_as_uint(v), false, false); return __uint_as_float((fq & 1) ? r[0] : r[1]); }
__device__ __forceinline__ f32x4 shfl4(f32x4 v, int src) { return (f32x4){bperm(v[0], src), bperm(v[1], src), bperm(v[2], src), bperm(v[3], src)}; }
__device__ __forceinline__ float wave_sum(float v, int lane_) {
#pragma unroll
    for (int o = 1; o < 64; o <<= 1) v += bperm(v, lane_ ^ o);
    return v;
}

namespace pg8 {
constexpr int BM = 256, BK = 64, HALF = 128, HTB = HALF * BK * 2, STAGE_BYTES = 8 * HTB, NXCD = 8, WGM = 8;
__host__ __device__ __forceinline__ int lds_byte(int r, int c) { const int st = (r >> 4) * 2 + (c >> 5), rr = r & 15, cc = c & 31, ob = rr * 64 + cc * 2; return st * 1024 + (ob ^ (((ob >> 9) & 1) << 5)); }
__host__ __device__ __forceinline__ void stage_rc(int b, int& R, int& C) { const int st = b / 1024, sb = b % 1024, swz = sb ^ (((sb >> 9) & 1) << 5); R = (st >> 1) * 16 + swz / 64; C = (st & 1) * 32 + (swz % 64) / 2; }

__host__ __device__ __forceinline__ int perm32(int rho) { const int n = rho >> 4, i = rho & 15; return 8 * (i >> 2) + 4 * n + (i & 3); }
template <class E> constexpr auto epi_perm(int) -> decltype(E::PERM) { return E::PERM; }
template <class E> constexpr bool epi_perm(long) { return false; }
struct Unit { int row0, pn, half; };
struct Gemm { const bf16_t* A; const bf16_t* Bt; int M, N, K, lda; };

struct StaticOrder {
    int nM, nN, nwg, G, c;
    __device__ void init(int M, int N, int G_, int c_) { nM = M / BM; nN = N / BM; nwg = nM * nN; G = G_; c = c_; }
    __device__ bool next(int i, Unit& u) const {
        const long L = (long)i * G + c;
        if (L >= nwg) { const int q = (int)(L - nwg); if (q >= 4 * nN) return false; u.row0 = MP + (q & 3) * 128; u.pn = q >> 2; u.half = 1; return true; }
        int wgid = (int)L; { const int q = nwg / NXCD, r = nwg % NXCD, xcd = wgid % NXCD, off = wgid / NXCD; wgid = (xcd < r ? xcd * (q + 1) : r * (q + 1) + (xcd - r) * q) + off; }
        const int nig = WGM * nN, gid = wgid / nig, fm = gid * WGM, gsz = (nM - fm) < WGM ? (nM - fm) : WGM;
        u.row0 = (fm + ((wgid % nig) % gsz)) * BM; u.pn = (wgid % nig) / gsz; u.half = 0; return true;
    }
};

template <class Epi> __device__ __forceinline__ auto acc_init(const Epi& E, f32x4 (&acc)[2][2][4][2], const Unit& u, int wr, int wc, int fr, int fq, int) -> decltype(E.init(acc, u, wr, wc, fr, fq), void()) { E.init(acc, u, wr, wc, fr, fq); }
template <class Epi> __device__ __forceinline__ void acc_init(const Epi&, f32x4 (&acc)[2][2][4][2], const Unit&, int, int, int, int, long) {
#pragma unroll
    for (int a = 0; a < 2; ++a)
#pragma unroll
        for (int b = 0; b < 2; ++b)
#pragma unroll
            for (int m = 0; m < 4; ++m)
#pragma unroll
                for (int n = 0; n < 2; ++n) acc[a][b][m][n] = (f32x4){0.f, 0.f, 0.f, 0.f};
}
template <class Epi, bool ALIGN_EPI = true, bool SP2 = true>
__device__ __forceinline__ void gemm_phase(LAS unsigned char* lds, const Gemm g, const StaticOrder& S_in, const Epi& E, int wave0) {
    StaticOrder S = S_in; asm volatile("" : "+s"(S.c));
    const int tid = opaque_tid(wave0), wid = __builtin_amdgcn_readfirstlane(tid >> 6), lane = tid & 63, wr = wid >> 2, wc = wid & 3, fr = lane & 15, fq = lane >> 4;
    const int K = g.K, nt = K / BK;
    unsigned voffA[2], voffB[2];
#pragma unroll
    for (int i = 0; i < 2; ++i) { int R, C; stage_rc(tid * 16 + i * 8192, R, C);
        const int Rb = epi_perm<Epi>(0) ? ((R & ~31) + perm32(R & 31)) : R;
        voffA[i] = (unsigned)(R * g.lda + C) * 2u; voffB[i] = (unsigned)(Rb * K + C) * 2u; }
    const size_t kstep = (size_t)(BK * 2);
    const size_t hstepA = (size_t)HALF * g.lda * 2, hstepB = (size_t)HALF * K * 2;
    const size_t tstepA = 2 * hstepA, tstepB = 2 * hstepB;
    const unsigned ldsw = (unsigned)wid * 1024u;
    const int aoff = lds_byte(wr * 64 + fr, fq * 8), boff = lds_byte(wc * 32 + fr, fq * 8);
#define PG8_SA(b, h) (((b) * 2 + (h)) * HTB)
#define PG8_SB(b, h) ((4 + (b) * 2 + (h)) * HTB)
#define PG8_STAGE(bufoff, gbase, voff) do { _Pragma("unroll") for (int _i = 0; _i < 2; ++_i) \
        __builtin_amdgcn_global_load_lds((const unsigned*)((const char*)(gbase) + (voff)[_i]), (LAS unsigned*)(lds + (bufoff) + ldsw + _i * 8192), 16, 0, 0); } while (0)
#define PG8_LDA(dst, b, h) do { _Pragma("unroll") for (int m = 0; m < 4; ++m) _Pragma("unroll") for (int k = 0; k < 2; ++k) dst[m][k] = *(const LAS bf16x8*)(lds + PG8_SA(b, h) + aoff + m * 2048 + k * 1024); } while (0)
#define PG8_LDB(dst, b, h) do { _Pragma("unroll") for (int n = 0; n < 2; ++n) _Pragma("unroll") for (int k = 0; k < 2; ++k) dst[n][k] = *(const LAS bf16x8*)(lds + PG8_SB(b, h) + boff + n * 2048 + k * 1024); } while (0)
#define PG8_MMA(ai, bj, At, Bt) do { __builtin_amdgcn_s_setprio(1); _Pragma("unroll") for (int m = 0; m < 4; ++m) _Pragma("unroll") for (int n = 0; n < 2; ++n) _Pragma("unroll") for (int k = 0; k < 2; ++k) \
        acc[ai][bj][m][n] = __builtin_amdgcn_mfma_f32_16x16x32_bf16(Bt[n][k], At[m][k], acc[ai][bj][m][n], 0, 0, 0); __builtin_amdgcn_s_setprio(0); } while (0)
#define PG8_WAIT_V(n) asm volatile("s_waitcnt vmcnt(" #n ")" ::: "memory")
#define PG8_WAIT_L(n) asm volatile("s_waitcnt lgkmcnt(" #n ")" ::: "memory")
#define PG8_BAR __builtin_amdgcn_s_barrier()
#define PG8_SCHED __builtin_amdgcn_sched_barrier(0)
    Unit cur, nxt; int ui = 0;
    if (!S.next(0, cur)) return;
    f32x4 acc[2][2][4][2];
    acc_init(E, acc, cur, wr, wc, fr, fq, 0);
    bf16x8 At[4][2], B0[2][2], B1[2][2];
    const char* cA = (const char*)g.A + (size_t)cur.row0 * g.lda * 2; const char* cB = (const char*)g.Bt + (size_t)cur.pn * tstepB;
    if constexpr (SP2) {
        PG8_STAGE(PG8_SB(0, 0), cB, voffB); PG8_STAGE(PG8_SB(0, 1), cB + hstepB, voffB); PG8_STAGE(PG8_SA(0, 0), cA, voffA); PG8_STAGE(PG8_SA(0, 1), cA + hstepA, voffA);
        if (wr == 1) PG8_BAR;
        PG8_WAIT_V(2); PG8_BAR;
        PG8_STAGE(PG8_SB(1, 0), cB + kstep, voffB); PG8_STAGE(PG8_SA(1, 0), cA + kstep, voffA); PG8_STAGE(PG8_SB(1, 1), cB + hstepB + kstep, voffB);
        PG8_WAIT_V(6); PG8_BAR;
    } else {
        PG8_STAGE(PG8_SB(0, 0), cB, voffB); PG8_STAGE(PG8_SA(0, 0), cA, voffA); PG8_STAGE(PG8_SB(0, 1), cB + hstepB, voffB); PG8_STAGE(PG8_SA(0, 1), cA + hstepA, voffA);
        if (wr == 1) PG8_BAR;
        PG8_WAIT_V(4); PG8_BAR;
        PG8_STAGE(PG8_SB(1, 0), cB + kstep, voffB); PG8_STAGE(PG8_SA(1, 0), cA + kstep, voffA); PG8_STAGE(PG8_SB(1, 1), cB + hstepB + kstep, voffB);
        PG8_WAIT_V(6); PG8_BAR;
    }
    for (;;) {
        const bool has_next = S.next(ui + 1, nxt);
        const char* nA = has_next ? (const char*)g.A + (size_t)nxt.row0 * g.lda * 2 : cA; const char* nB = has_next ? (const char*)g.Bt + (size_t)nxt.pn * tstepB : cB;
        for (int t = 0; t < nt; t += 2) {
            const bool last = (t == nt - 2);
            const char* a1 = cA + (size_t)(t + 1) * kstep;
            const char* a2 = last ? nA : cA + (size_t)(t + 2) * kstep; const char* b2 = last ? nB : cB + (size_t)(t + 2) * kstep;
            const char* a3 = a2 + kstep; const char* b3 = b2 + kstep;
            if constexpr (SP2) {
            PG8_LDB(B0, 0, 0); PG8_LDB(B1, 0, 1); PG8_SCHED; PG8_LDA(At, 0, 0); PG8_STAGE(PG8_SA(1, 1), a1 + hstepA, voffA);
            PG8_WAIT_V(8); PG8_WAIT_L(0); PG8_BAR; PG8_MMA(0, 0, At, B0); PG8_MMA(0, 1, At, B1); PG8_BAR; PG8_SCHED;
            if (!cur.half) PG8_LDA(At, 0, 1); PG8_STAGE(PG8_SB(0, 0), b2, voffB); PG8_STAGE(PG8_SB(0, 1), b2 + hstepB, voffB); PG8_STAGE(PG8_SA(0, 0), a2, voffA);
            PG8_WAIT_V(8); PG8_WAIT_L(0); PG8_BAR; if (!cur.half) { PG8_MMA(1, 0, At, B0); PG8_MMA(1, 1, At, B1); } PG8_BAR; PG8_SCHED;
            PG8_LDB(B0, 1, 0); PG8_LDB(B1, 1, 1); PG8_SCHED; PG8_LDA(At, 1, 0); PG8_STAGE(PG8_SA(0, 1), a2 + hstepA, voffA);
            PG8_WAIT_V(8); PG8_WAIT_L(0); PG8_BAR; PG8_MMA(0, 0, At, B0); PG8_MMA(0, 1, At, B1); PG8_BAR; PG8_SCHED;
            if (!cur.half) PG8_LDA(At, 1, 1); PG8_STAGE(PG8_SB(1, 0), b3, voffB); PG8_STAGE(PG8_SB(1, 1), b3 + hstepB, voffB); PG8_STAGE(PG8_SA(1, 0), a3, voffA);
            PG8_WAIT_V(8); PG8_WAIT_L(0); PG8_BAR; if (!cur.half) { PG8_MMA(1, 0, At, B0); PG8_MMA(1, 1, At, B1); } PG8_BAR; PG8_SCHED;
            } else {
            PG8_LDB(B0, 0, 0); PG8_SCHED; PG8_LDA(At, 0, 0); PG8_STAGE(PG8_SA(1, 1), a1 + hstepA, voffA);
            PG8_WAIT_L(8); PG8_BAR; PG8_WAIT_L(0); PG8_MMA(0, 0, At, B0); PG8_BAR; PG8_SCHED;
            PG8_LDB(B1, 0, 1); PG8_STAGE(PG8_SB(0, 0), b2, voffB);
            PG8_BAR; PG8_WAIT_L(0); PG8_MMA(0, 1, At, B1); PG8_BAR;
            if (!cur.half) PG8_LDA(At, 0, 1); PG8_STAGE(PG8_SA(0, 0), a2, voffA);
            PG8_BAR; PG8_WAIT_L(0); if (!cur.half) { PG8_MMA(1, 0, At, B0); } PG8_BAR; PG8_SCHED;
            PG8_STAGE(PG8_SB(0, 1), b2 + hstepB, voffB);
            PG8_WAIT_V(6); PG8_BAR; if (!cur.half) { PG8_MMA(1, 1, At, B1); } PG8_BAR;
            PG8_LDB(B0, 1, 0); PG8_SCHED; PG8_LDA(At, 1, 0); PG8_STAGE(PG8_SA(0, 1), a2 + hstepA, voffA);
            PG8_WAIT_L(8); PG8_BAR; PG8_WAIT_L(0); PG8_MMA(0, 0, At, B0); PG8_BAR; PG8_SCHED;
            PG8_LDB(B1, 1, 1); PG8_STAGE(PG8_SB(1, 0), b3, voffB);
            PG8_BAR; PG8_WAIT_L(0); PG8_MMA(0, 1, At, B1); PG8_BAR;
            if (!cur.half) PG8_LDA(At, 1, 1); PG8_STAGE(PG8_SA(1, 0), a3, voffA);
            PG8_BAR; PG8_WAIT_L(0); if (!cur.half) { PG8_MMA(1, 0, At, B0); } PG8_BAR; PG8_SCHED;
            PG8_STAGE(PG8_SB(1, 1), b3 + hstepB, voffB);
            PG8_WAIT_V(6); PG8_BAR; if (!cur.half) { PG8_MMA(1, 1, At, B1); } PG8_BAR;
            }
        }
        if constexpr (ALIGN_EPI) { if (wr == 0) PG8_BAR; }
        E(acc, cur, wr, wc, fr, fq);
        if (!has_next) break;
        cur = nxt; cA = nA; cB = nB; ++ui;
        acc_init(E, acc, cur, wr, wc, fr, fq, 0);
        if constexpr (ALIGN_EPI) { if (wr == 1) PG8_BAR; }
    }
    PG8_WAIT_V(0);
    if constexpr (!ALIGN_EPI) { if (wr == 0) PG8_BAR; }
    PG8_BAR;
#undef PG8_SA
#undef PG8_SB
#undef PG8_STAGE
#undef PG8_LDA
#undef PG8_LDB
#undef PG8_MMA
#undef PG8_WAIT_V
#undef PG8_WAIT_L
#undef PG8_BAR
#undef PG8_SCHED
}
}
using pg8::Unit;
typedef f32x4 Acc[2][2][4][2];

struct EpiGm {
    static constexpr bool PERM = true;
    const float* ss; bf16_t* Z; float* vss;
    __device__ __forceinline__ void operator()(Acc& acc, const Unit& u, int wr, int wc, int fr, int fq) const {
        asm volatile("" : "+v"(fr), "+v"(fq));
        const int lane_ = fq * 16 + fr; (void)lane_;
        const int rowb = u.row0 + wr * 64 + fr, colb = u.pn * 256 + wc * 32 + 8 * fq;
        float rs[8];
#pragma unroll
        for (int g = 0; g < 8; ++g) rs[g] = ss_get(ss, rowb + (g >> 2) * 128 + (g & 3) * 16);
        EPI_FENCE();
#pragma unroll
        for (int g = 0; g < 8; ++g) {
            if (u.half && g >= 4) break;
            const int ai = g >> 2, m = g & 3, row = rowb + ai * 128 + m * 16;
            const float r = __builtin_amdgcn_rsqf(rs[g] * (1.0f / 1024.0f) + EPS); float s = 0.f;
#pragma unroll
            for (int bj = 0; bj < 2; ++bj) {
                const f32x4 v0 = gelu4(acc[ai][bj][m][0] * r), v1 = gelu4(acc[ai][bj][m][1] * r);
                *(u32x4*)(Z + (size_t)row * 4096 + colb + bj * 128) = pack8(v0, v1);
                s += dot4(v0) + dot4(v1);
            }
            if (u.pn >= 8) { s = xsum16(s); s = xsum32(s); if (fq == 0) ss_add(vss, row, s); }
        }
        EPI_FENCE();
    }
};
struct EpiRes {
    static constexpr bool PERM = true;
    const bf16_t* src; bf16_t* dst; float* sso;
    __device__ __forceinline__ void init(Acc& acc, const Unit& u, int wr, int wc, int fr, int fq) const {
        asm volatile("" : "+v"(fr), "+v"(fq));
        const int rowb = u.row0 + wr * 64 + fr, colb = u.pn * 256 + wc * 32 + 8 * fq;
#pragma unroll
        for (int g = 0; g < 8; ++g) { const int ai = g >> 2, m = g & 3;
#pragma unroll
            for (int bj = 0; bj < 2; ++bj) {
                if (u.half && ai == 1) { acc[ai][bj][m][0] = (f32x4){0.f, 0.f, 0.f, 0.f}; acc[ai][bj][m][1] = (f32x4){0.f, 0.f, 0.f, 0.f}; }
                else { const u32x4 w = *(const u32x4*)(src + (size_t)(rowb + ai * 128 + m * 16) * 1024 + colb + bj * 128);
                    acc[ai][bj][m][0] = unpack4((u32x2){w.x, w.y}); acc[ai][bj][m][1] = unpack4((u32x2){w.z, w.w}); } } }
    }
    __device__ __forceinline__ void operator()(Acc& acc, const Unit& u, int wr, int wc, int fr, int fq) const {
        asm volatile("" : "+v"(fr), "+v"(fq));
        const int lane_ = fq * 16 + fr; (void)lane_;
        const int rowb = u.row0 + wr * 64 + fr, colb = u.pn * 256 + wc * 32 + 8 * fq;
#pragma unroll
        for (int g = 0; g < 8; ++g) {
            if (u.half && g >= 4) break;
            const int ai = g >> 2, m = g & 3, row = rowb + ai * 128 + m * 16;
            float s = 0.f;
#pragma unroll
            for (int bj = 0; bj < 2; ++bj) { const f32x4 v0 = acc[ai][bj][m][0], v1 = acc[ai][bj][m][1];
                *(u32x4*)(dst + (size_t)row * 1024 + colb + bj * 128) = pack8(v0, v1); s += dot4(v0) + dot4(v1); }
            s = xsum16(s); s = xsum32(s); if (fq == 0) ss_add(sso, row, s);
        }
        EPI_FENCE();
    }
};
struct EpiBf {
    static constexpr bool PERM = true;
    bf16_t* C;
    __device__ __forceinline__ void operator()(Acc& acc, const Unit& u, int wr, int wc, int fr, int fq) const {
        asm volatile("" : "+v"(fr), "+v"(fq));
        const int rowb = u.row0 + wr * 64 + fr, colb = u.pn * 256 + wc * 32 + 8 * fq;
#pragma unroll
        for (int g = 0; g < 8; ++g) { if (u.half && g >= 4) break; const int ai = g >> 2, m = g & 3, row = rowb + ai * 128 + m * 16;
#pragma unroll
            for (int bj = 0; bj < 2; ++bj) *(u32x4*)(C + (size_t)row * 1024 + colb + bj * 128) = pack8(acc[ai][bj][m][0], acc[ai][bj][m][1]); }
        EPI_FENCE();
    }
};
struct EpiPle {
    static constexpr bool PERM = true;
    const float* ss; const bf16_t* PR; const bf16_t* src; bf16_t* dstb; float* sso;
    __device__ __forceinline__ void operator()(Acc& acc, const Unit& u, int wr, int wc, int fr, int fq) const {
        asm volatile("" : "+v"(fr), "+v"(fq));
        const int lane_ = fq * 16 + fr; (void)lane_;
        const int rowb = u.row0 + wr * 64 + fr, colb = u.pn * 256 + wc * 32 + 8 * fq;
        float rs[8];
#pragma unroll
        for (int g = 0; g < 8; ++g) rs[g] = ss_get(ss, rowb + (g >> 2) * 128 + (g & 3) * 16);
        u32x4 nx[2], np[2];
#pragma unroll
        for (int bj = 0; bj < 2; ++bj) { const size_t off = (size_t)rowb * 1024 + colb + bj * 128; nx[bj] = *(const u32x4*)(src + off); np[bj] = *(const u32x4*)(PR + off); }
        EPI_FENCE();
#pragma unroll
        for (int g = 0; g < 8; ++g) {
            if (u.half && g >= 4) break;
            const int ai = g >> 2, m = g & 3, row = rowb + ai * 128 + m * 16;
            u32x4 cx[2], cp[2];
#pragma unroll
            for (int bj = 0; bj < 2; ++bj) { cx[bj] = nx[bj]; cp[bj] = np[bj]; }
            if (g < 7) { const int row2 = rowb + ((g + 1) >> 2) * 128 + ((g + 1) & 3) * 16;
#pragma unroll
                for (int bj = 0; bj < 2; ++bj) { const size_t off = (size_t)row2 * 1024 + colb + bj * 128; nx[bj] = *(const u32x4*)(src + off); np[bj] = *(const u32x4*)(PR + off); } }
            EPI_FENCE();
            const float r = __builtin_amdgcn_rsqf(rs[g] * (1.0f / 1024.0f) + EPS); float s = 0.f;
#pragma unroll
            for (int bj = 0; bj < 2; ++bj) { const size_t off = (size_t)row * 1024 + colb + bj * 128;
                const f32x4 v0 = unpack4((u32x2){cx[bj].x, cx[bj].y}) + unpack4((u32x2){cp[bj].x, cp[bj].y}) * sigmoid4(acc[ai][bj][m][0] * r);
                const f32x4 v1 = unpack4((u32x2){cx[bj].z, cx[bj].w}) + unpack4((u32x2){cp[bj].z, cp[bj].w}) * sigmoid4(acc[ai][bj][m][1] * r);
                *(u32x4*)(dstb + off) = pack8(v0, v1);
                s += dot4(v0) + dot4(v1); }
            s = xsum16(s); s = xsum32(s); if (fq == 0) ss_add(sso, row, s);
            EPI_FENCE();
        }
    }
};
struct EpiGU {
    static constexpr bool PERM = true;
    const float* ss; bf16_t* act; const float* cw; const float* cb; float* hg; float* c0; float* u0; const float* state; float* ncs;
    __device__ __forceinline__ void operator()(Acc& acc, const Unit& u, int wr, int wc, int fr, int fq) const {
        asm volatile("" : "+v"(fr), "+v"(fq));
        const int lane_ = fq * 16 + fr; (void)lane_;
        const int src1 = (fq << 4) | ((fr + 15) & 15), src2 = (fq << 4) | ((fr + 14) & 15);
        const bool samp = u.row0 >= MP;
#pragma unroll
        for (int ai = 0; ai < 2; ++ai)
#pragma unroll
            for (int m = 0; m < 4; ++m) {
                const int row = u.row0 + ai * 128 + wr * 64 + m * 16 + fr; const float rs = rstd16(ss, row);
#pragma unroll
                for (int bj = 0; bj < 2; ++bj)
#pragma unroll
                    for (int n = 0; n < 2; ++n) acc[ai][bj][m][n] = acc[ai][bj][m][n] * rs;
            }
        const int colg = u.pn * 128 + wc * 32 + 8 * fq;
        f32x4 w0[2], w1[2], w2[2], bb[2];
#pragma unroll
        for (int n = 0; n < 2; ++n) { w0[n] = *(const f32x4*)(cw + colg + 4 * n); w1[n] = *(const f32x4*)(cw + DFF + colg + 4 * n); w2[n] = *(const f32x4*)(cw + 2 * DFF + colg + 4 * n); bb[n] = *(const f32x4*)(cb + colg + 4 * n); }
#pragma unroll
        for (int ai = 0; ai < 2; ++ai)
#pragma unroll
            for (int m = 0; m < 4; ++m) {
                if (u.half && ai == 1) break;
                const int row = u.row0 + ai * 128 + wr * 64 + m * 16 + fr;
                f32x4 a2[2];
#pragma unroll
                for (int n = 0; n < 2; ++n) {
                    const f32x4 g = acc[ai][0][m][n], gp = (m > 0) ? acc[ai][0][m > 0 ? m - 1 : 0][n] : g;
                    const f32x4 t1 = (fr == 15) ? gp : g, t2 = (fr >= 14) ? gp : g;
                    f32x4 g1 = shfl4(t1, src1), g2 = shfl4(t2, src2);
                    if (samp) {
                        const int t = fr & 3, b = (row - MP) >> 2;
                        if (t == 0) { g1 = *(const f32x4*)(state + (size_t)(b * 2 + 1) * DFF + colg + 4 * n); g2 = *(const f32x4*)(state + (size_t)(b * 2) * DFF + colg + 4 * n); }
                        else if (t == 1) { g2 = *(const f32x4*)(state + (size_t)(b * 2 + 1) * DFF + colg + 4 * n); }
                        else { *(f32x4*)(ncs + (size_t)(b * 2 + t - 2) * DFF + colg + 4 * n) = g; }
                    }
                    const f32x4 conv = bb[n] + w0[n] * g2 + w1[n] * g1 + w2[n] * g;
                    const f32x4 up = acc[ai][1][m][n];
                    a2[n] = gelu4(conv) * up;
                    if (!samp) {
                        if (m == 0 && fr < 2) { const int gj = (row >> 6) * 2 + fr; f32x4 c = bb[n] + w2[n] * g; if (fr == 1) c = c + w1[n] * g1;
                            *(f32x4*)(c0 + (size_t)gj * DFF + colg + 4 * n) = c; *(f32x4*)(u0 + (size_t)gj * DFF + colg + 4 * n) = up; }
                        if (m == 3 && fr >= 14) { const int gj = (row >> 6) * 2 + (fr - 14); *(f32x4*)(hg + (size_t)gj * DFF + colg + 4 * n) = g; }
                    }
                }
                *(u32x4*)(act + (size_t)row * DFF + colg) = pack8(a2[0], a2[1]);
                EPI_FENCE();
            }
    }
};
struct EpiQKV {
    static constexpr bool PERM = true;
    const float* ss; const float* rope; bf16_t* Q; bf16_t* KB; bf16_t* VB; float* out;
    __device__ __forceinline__ void operator()(Acc& acc, const Unit& u, int wr, int wc, int fr, int fq) const {
        asm volatile("" : "+v"(fr), "+v"(fq));
        const int lane_ = fq * 16 + fr; (void)lane_;
        float rsq[8];
#pragma unroll
        for (int g = 0; g < 8; ++g) rsq[g] = ss_get(ss, u.row0 + wr * 64 + fr + (g >> 2) * 128 + (g & 3) * 16);
        EPI_FENCE();
#pragma unroll
        for (int ai = 0; ai < 2; ++ai)
#pragma unroll
            for (int m = 0; m < 4; ++m) {
                if (u.half && ai == 1) break;
                const int row = u.row0 + ai * 128 + wr * 64 + m * 16 + fr; const float rs = __builtin_amdgcn_rsqf(rsq[ai * 4 + m] * (1.0f / 1024.0f) + EPS);
                const int posidx = row < MP ? (row & (SEQ - 1)) : SEQ + (row & 3);
                f32x4 cs[2], sn[2];
#pragma unroll
                for (int n = 0; n < 2; ++n) { cs[n] = *(const f32x4*)(rope + (size_t)posidx * 16 + 4 * n); sn[n] = *(const f32x4*)(rope + (size_t)posidx * 16 + 8 + 4 * n); }
#pragma unroll
                for (int bj = 0; bj < 2; ++bj) {
                    const bool isV = (u.pn == 4) && (bj == 1);
                    f32x4 v[2];
#pragma unroll
                    for (int n = 0; n < 2; ++n) {
                        v[n] = acc[ai][bj][m][n] * rs;
                        if ((wc & 1) == 0 && !isV) {
                            const f32x4 pt = (f32x4){xpartner16(v[n][0], fq), xpartner16(v[n][1], fq), xpartner16(v[n][2], fq), xpartner16(v[n][3], fq)};
                            if (fq == 0) v[n] = v[n] * cs[n] - pt * sn[n]; else if (fq == 1) v[n] = v[n] * cs[n] + pt * sn[n];
                        }
                    }
                    const int cu = bj * 128 + wc * 32 + 8 * fq;
                    if (u.pn < 4) { *(u32x4*)(Q + (size_t)row * 1024 + u.pn * 256 + cu) = pack8(v[0] * (0.125f * LOG2E), v[1] * (0.125f * LOG2E)); }
                    else {
                        const int c2 = cu & 127; bf16_t* dst = bj == 0 ? KB : VB;
                        *(u32x4*)(dst + (size_t)row * KVD + c2) = pack8(v[0], v[1]);
                        float* fo = nullptr;
                        if (row >= MP) fo = out + (bj == 0 ? O_KS : O_VS) + (size_t)(row - MP) * KVD + c2;
                        else if ((row & (SEQ - 1)) >= SEQ - 128) fo = out + (bj == 0 ? O_NKP : O_NVP) + (size_t)((row >> 13) * 128 + (row & (SEQ - 1)) - (SEQ - 128)) * KVD + c2;
                        if (fo) { *(f32x4*)fo = v[0]; *(f32x4*)(fo + 4) = v[1]; }
                    }
                }
                EPI_FENCE();
            }
    }
};

struct Params {
    const float *x_prompt, *x_sample, *state, *cache_k, *cache_v, *p_prompt, *p_sample, *norm_mix, *gm_w_in, *gm_v_norm, *gm_w_s, *gm_b_s, *gm_w_out, *kv_norm, *w_kv, *w_q, *sinks, *w_o,
        *norm_ffn, *w_gate, *w_up, *conv_w, *conv_b, *w_down, *ple_norm, *ple_w_gate, *ple_w_proj, *final_norm;
    float* out; unsigned char* ws;
};

constexpr int PARAM_OFF = 131072 + 1024;
__device__ __forceinline__ unsigned long long ldq(const LAS unsigned char* pbase, int i) {
    const unsigned long long v = ((const LAS unsigned long long*)pbase)[i];
    const unsigned lo = __builtin_amdgcn_readfirstlane((unsigned)v), hi = __builtin_amdgcn_readfirstlane((unsigned)(v >> 32));
    return ((unsigned long long)hi << 32) | lo;
}
__device__ __forceinline__ Params load_params(LAS unsigned char* lds) {
    Params p;
    unsigned poff = PARAM_OFF; asm volatile("" : "+v"(poff));
    const LAS unsigned char* pb = lds + poff;
    p.x_prompt = (decltype(p.x_prompt))(__attribute__((address_space(1))) float*)ldq(pb, 0);
    p.x_sample = (decltype(p.x_sample))(__attribute__((address_space(1))) float*)ldq(pb, 1);
    p.state = (decltype(p.state))(__attribute__((address_space(1))) float*)ldq(pb, 2);
    p.cache_k = (decltype(p.cache_k))(__attribute__((address_space(1))) float*)ldq(pb, 3);
    p.cache_v = (decltype(p.cache_v))(__attribute__((address_space(1))) float*)ldq(pb, 4);
    p.p_prompt = (decltype(p.p_prompt))(__attribute__((address_space(1))) float*)ldq(pb, 5);
    p.p_sample = (decltype(p.p_sample))(__attribute__((address_space(1))) float*)ldq(pb, 6);
    p.norm_mix = (decltype(p.norm_mix))(__attribute__((address_space(1))) float*)ldq(pb, 7);
    p.gm_w_in = (decltype(p.gm_w_in))(__attribute__((address_space(1))) float*)ldq(pb, 8);
    p.gm_v_norm = (decltype(p.gm_v_norm))(__attribute__((address_space(1))) float*)ldq(pb, 9);
    p.gm_w_s = (decltype(p.gm_w_s))(__attribute__((address_space(1))) float*)ldq(pb, 10);
    p.gm_b_s = (decltype(p.gm_b_s))(__attribute__((address_space(1))) float*)ldq(pb, 11);
    p.gm_w_out = (decltype(p.gm_w_out))(__attribute__((address_space(1))) float*)ldq(pb, 12);
    p.kv_norm = (decltype(p.kv_norm))(__attribute__((address_space(1))) float*)ldq(pb, 13);
    p.w_kv = (decltype(p.w_kv))(__attribute__((address_space(1))) float*)ldq(pb, 14);
    p.w_q = (decltype(p.w_q))(__attribute__((address_space(1))) float*)ldq(pb, 15);
    p.sinks = (decltype(p.sinks))(__attribute__((address_space(1))) float*)ldq(pb, 16);
    p.w_o = (decltype(p.w_o))(__attribute__((address_space(1))) float*)ldq(pb, 17);
    p.norm_ffn = (decltype(p.norm_ffn))(__attribute__((address_space(1))) float*)ldq(pb, 18);
    p.w_gate = (decltype(p.w_gate))(__attribute__((address_space(1))) float*)ldq(pb, 19);
    p.w_up = (decltype(p.w_up))(__attribute__((address_space(1))) float*)ldq(pb, 20);
    p.conv_w = (decltype(p.conv_w))(__attribute__((address_space(1))) float*)ldq(pb, 21);
    p.conv_b = (decltype(p.conv_b))(__attribute__((address_space(1))) float*)ldq(pb, 22);
    p.w_down = (decltype(p.w_down))(__attribute__((address_space(1))) float*)ldq(pb, 23);
    p.ple_norm = (decltype(p.ple_norm))(__attribute__((address_space(1))) float*)ldq(pb, 24);
    p.ple_w_gate = (decltype(p.ple_w_gate))(__attribute__((address_space(1))) float*)ldq(pb, 25);
    p.ple_w_proj = (decltype(p.ple_w_proj))(__attribute__((address_space(1))) float*)ldq(pb, 26);
    p.final_norm = (decltype(p.final_norm))(__attribute__((address_space(1))) float*)ldq(pb, 27);
    p.out = (decltype(p.out))(__attribute__((address_space(1))) float*)ldq(pb, 28);
    p.ws = (decltype(p.ws))(__attribute__((address_space(1))) unsigned char*)ldq(pb, 29);
    return p;
}
__device__ __forceinline__ void tr_item(const float* W, int K, int N, bf16_t* WT, const float* scale, int mode, int row_off, LAS float* scr, int item, int lane) {
    const int nblk = N / 32, kb = item / nblk, nb = item % nblk, k0 = 64 * kb, n0 = 32 * nb;
#pragma unroll 16
    for (int i = 0; i < 32; ++i) { const int kk = 2 * i + (lane >> 5); float w = W[(size_t)(k0 + kk) * N + n0 + (lane & 31)]; if (scale) w *= scale[k0 + kk]; scr[kk * 33 + (lane & 31)] = w; }
    asm volatile("s_waitcnt lgkmcnt(0)" ::: "memory");
    const int c = lane & 7;
    const int drow0 = mode == 0 ? row_off + n0 : ((n0 >> 7) * 256 + (mode == 2 ? 128 : 0) + (n0 & 127));
#pragma unroll
    for (int j = 0; j < 4; ++j) { const int n = (lane >> 3) + 8 * j; const LAS float* s = scr + (8 * c) * 33 + n;
        u32x4 o; o.x = cvt_pk_bf16(s[0 * 33], s[1 * 33]); o.y = cvt_pk_bf16(s[2 * 33], s[3 * 33]); o.z = cvt_pk_bf16(s[4 * 33], s[5 * 33]); o.w = cvt_pk_bf16(s[6 * 33], s[7 * 33]);
        *(u32x4*)(WT + (size_t)(drow0 + n) * K + k0 + 8 * c) = o; }
    asm volatile("s_waitcnt lgkmcnt(0)" ::: "memory");
}

__device__ __forceinline__ void conv_stage(LAS unsigned char* lds, int stage, int T, int wave0) {
    if ((int)blockIdx.x < T) return;
    const Params P = load_params(lds);
    const int tid = opaque_tid(wave0), lane = tid & 63, wave = tid >> 6;
    unsigned char* ws = P.ws;
    LAS float* scr = (LAS float*)(lds + wave * 16384);
    const int gw = ((int)blockIdx.x - T) * 8 + wave, NGW = (256 - T) * 8;
    const int nitems = stage == 0 ? 2048 : stage == 1 ? 1024 + 1408 : stage == 2 ? 1408 + 1408 + 512 + 128 : stage == 3 ? 512 + 128 + 512 : stage == 4 ? 512 + 128 : stage == 5 ? 1408 : stage == 7 ? 1408 : stage == 8 ? 1408 : 0;
    for (int it = gw; it < nitems; it += NGW) {
        int r = it; const float* W; int K, N; bf16_t* WT; const float* sc; int mode = 0, roff = 0;
        if (stage == 0) { W = P.gm_w_in; K = 1024; N = 4096; WT = (bf16_t*)(ws + WS_WIN); sc = P.norm_mix; }
        else if (stage == 1) {
            if (r < 1024) { W = P.gm_w_out; K = 2048; N = 1024; WT = (bf16_t*)(ws + WS_WOUT); sc = nullptr; }
            else { r -= 1024; W = P.w_gate; K = 1024; N = DFF; WT = (bf16_t*)(ws + WS_WGU0); sc = P.norm_ffn; mode = 1; }
        } else if (stage == 2) {
            if (r < 1408) { W = P.w_up; K = 1024; N = DFF; WT = (bf16_t*)(ws + WS_WGU0); sc = P.norm_ffn; mode = 2; }
            else if (r < 2816) { r -= 1408; W = P.w_down; K = DFF; N = 1024; WT = (bf16_t*)(ws + WS_WD0); sc = nullptr; }
            else if (r < 2816 + 512) { r -= 2816; W = P.ple_w_gate; K = 1024; N = 1024; WT = (bf16_t*)(ws + WS_WPG0); sc = P.ple_norm; }
            else { r -= 2816 + 512; W = P.ple_w_proj; K = 256; N = 1024; WT = (bf16_t*)(ws + WS_WPP0); sc = nullptr; }
        } else if (stage == 3) {
            if (r < 512) { W = P.w_q; K = 1024; N = 1024; WT = (bf16_t*)(ws + WS_WQKV); sc = P.norm_mix + 1024; }
            else if (r < 512 + 128) { r -= 512; W = P.w_kv; K = 1024; N = 256; WT = (bf16_t*)(ws + WS_WQKV); sc = P.kv_norm; roff = 1024; }
            else { r -= 512 + 128; W = P.w_o; K = 1024; N = 1024; WT = (bf16_t*)(ws + WS_WO); sc = nullptr; }
        } else if (stage == 4) {
            if (r < 512) { W = P.ple_w_gate + 1024 * 1024; K = 1024; N = 1024; WT = (bf16_t*)(ws + WS_WPG0 + 2 * MiB); sc = P.ple_norm + 1024; }
            else { r -= 512; W = P.ple_w_proj + 256 * 1024; K = 256; N = 1024; WT = (bf16_t*)(ws + WS_WPP0 + 512 * 1024); sc = nullptr; }
        } else if (stage == 7) { W = P.w_gate + (size_t)1024 * DFF; K = 1024; N = DFF; WT = (bf16_t*)(ws + WS_WGU0 + 11 * MiB); sc = P.norm_ffn + 1024; mode = 1; }
        else if (stage == 8) { W = P.w_up + (size_t)1024 * DFF; K = 1024; N = DFF; WT = (bf16_t*)(ws + WS_WGU0 + 11 * MiB); sc = P.norm_ffn + 1024; mode = 2; }
        else { W = P.w_down + (size_t)DFF * 1024; K = DFF; N = 1024; WT = (bf16_t*)(ws + WS_WD0 + 5632 * 1024); sc = nullptr; }
        tr_item(W, K, N, WT, sc, mode, roff, scr, r, lane);
    }
    if (stage == 0) {
        bf16_t* XBA = (bf16_t*)(ws + WS_XBA); float* SSA = (float*)(ws + WS_SSA);
        for (int m = gw; m < MT; m += 2 * NGW) {
            const int m2 = m + NGW; const bool has2 = m2 < MT; const int mb = has2 ? m2 : m;
            const float* src = m < MP ? P.x_prompt + (size_t)m * DM : P.x_sample + (size_t)(m - MP) * DM;
            const float* src2 = mb < MP ? P.x_prompt + (size_t)mb * DM : P.x_sample + (size_t)(mb - MP) * DM;
            f32x4 va[4], vb[4];
#pragma unroll
            for (int j = 0; j < 2; ++j) { va[2 * j] = *((const f32x4*)src + 128 * j + 2 * lane); va[2 * j + 1] = *((const f32x4*)src + 128 * j + 2 * lane + 1); vb[2 * j] = *((const f32x4*)src2 + 128 * j + 2 * lane); vb[2 * j + 1] = *((const f32x4*)src2 + 128 * j + 2 * lane + 1); }
            float s = 0.f, s2 = 0.f;
#pragma unroll
            for (int j = 0; j < 2; ++j) { s += dot4(va[2 * j]) + dot4(va[2 * j + 1]); s2 += dot4(vb[2 * j]) + dot4(vb[2 * j + 1]);
                *((u32x4*)(XBA + (size_t)m * DM) + 64 * j + lane) = pack8(va[2 * j], va[2 * j + 1]); if (has2) *((u32x4*)(XBA + (size_t)m2 * DM) + 64 * j + lane) = pack8(vb[2 * j], vb[2 * j + 1]); }
            s = wave_sum(s, lane); s2 = wave_sum(s2, lane);
            if (lane == 0) { ss_set(SSA, m, s); ss_set((float*)(ws + WS_SSB), m, 0.f); ss_set((float*)(ws + WS_VSS), m, 0.f); if (has2) { ss_set(SSA, m2, s2); ss_set((float*)(ws + WS_SSB), m2, 0.f); ss_set((float*)(ws + WS_VSS), m2, 0.f); } }
        }
        const int gt = blockIdx.x * 512 + tid, NGT = 256 * 512;
        bf16_t* WTT = (bf16_t*)(ws + WS_WTRIL);
        for (int i = gt; i < 8 * 128 * 128 / 2; i += NGT) { const int e = 2 * i, sx = e & 127, t = (e >> 7) & 127;
            const float a = sx <= t ? P.gm_w_s[e] : 0.f, b = (sx + 1) <= t ? P.gm_w_s[e + 1] : 0.f; ((unsigned*)WTT)[i] = cvt_pk_bf16(a, b); }
        float* rope = (float*)(ws + WS_ROPE);
        for (int i = gt; i < 8196 * 8; i += NGT) { const int pi = i >> 3, f = i & 7; const int pos = pi < SEQ ? pi : 16384 + (pi - SEQ);
            const float inv = __builtin_powf(500000.0f, -(float)f * 0.125f); const float ang = (float)pos * inv;
            double rev = (double)ang * 0.15915494309189535; rev -= __builtin_rint(rev); const float rf = (float)rev;
            rope[pi * 16 + f] = __builtin_amdgcn_cosf(rf); rope[pi * 16 + 8 + f] = __builtin_amdgcn_sinf(rf); }
    }
    if (stage == 4 || stage == 6) {
        const int L = stage == 6 ? 1 : 0;
        bf16_t* PB = (bf16_t*)(ws + WS_PB) + (size_t)L * MT * PLE;
        for (int m0 = gw; m0 < MT; m0 += 4 * NGW) {
            f32x4 v[4];
#pragma unroll
            for (int q = 0; q < 4; ++q) { const int m = m0 + q * NGW < MT ? m0 + q * NGW : m0;
                const float* src = m < MP ? P.p_prompt + ((size_t)L * MP + m) * PLE : P.p_sample + ((size_t)L * MS + (m - MP)) * PLE; v[q] = *((const f32x4*)src + lane); }
#pragma unroll
            for (int q = 0; q < 4; ++q) { const int m = m0 + q * NGW; if (m < MT) *((u32x2*)(PB + (size_t)m * PLE) + lane) = pack4(v[q]); }
        }
    }
}

__device__ __forceinline__ void gating_phase(LAS unsigned char* lds, int G, int wave0) {
    const Params P = load_params(lds);
    const int tid = opaque_tid(wave0), lane = tid & 63, wave = tid >> 6, fr = lane & 15, fq = lane >> 4;
    unsigned char* ws = P.ws;
    bf16_t* Z = (bf16_t*)(ws + WS_Z); const float* VSS = (const float*)(ws + WS_VSS); const bf16_t* WTR = (const bf16_t*)(ws + WS_WTRIL);
    LAS bf16_t* Vs = (LAS bf16_t*)lds;
    LAS float* rsb = (LAS float*)(lds + 128 * 264 * 2);
    LAS bf16_t* Wsl = (LAS bf16_t*)(lds + 69632);
    LAS float* vws = (LAS float*)(lds + 69632 + 128 * 136 * 2);
    LAS float* bsl = vws + 256;
    { const int g0 = (int)blockIdx.x & 7;
      for (int i = tid; i < 2048; i += 512) { const int row = i >> 4, c8 = (i & 15) * 8; *(LAS u32x4*)(Wsl + row * 136 + c8) = *(const u32x4*)(WTR + (size_t)(g0 * 128 + row) * 128 + c8); }
      if (tid < 64) *(LAS f32x4*)(vws + 4 * tid) = *(const f32x4*)(P.gm_v_norm + 256 * g0 + 4 * tid);
      else if (tid < 96) *(LAS f32x4*)(bsl + 4 * (tid - 64)) = *(const f32x4*)(P.gm_b_s + 128 * g0 + 4 * (tid - 64)); }
    u32x4 raw[8]; float rsn[8];
#define GATE_FETCH(un) do { const int ch_ = (un) >> 3, g_ = (un) & 7; _Pragma("unroll") for (int j = 0; j < 8; ++j) { const int idx = tid + 512 * j, r = idx >> 5, c8 = (idx & 31) * 8; \
        raw[j] = *(const u32x4*)(Z + (size_t)(ch_ * 128 + r) * 4096 + 2048 + 256 * g_ + c8); rsn[j] = ss_get(VSS, ch_ * 128 + r); } } while (0)
    if ((int)blockIdx.x < 2048) GATE_FETCH(blockIdx.x);
    __syncthreads();
    for (int unit = blockIdx.x; unit < 2048; unit += G) {
        const int ch = unit >> 3, g = unit & 7, row0 = ch * 128;
#pragma unroll
        for (int j = 0; j < 8; ++j) { const int idx = tid + 512 * j, r = idx >> 5, c8 = (idx & 31) * 8;
            const f32x4 wa = *(const LAS f32x4*)(vws + c8), wb = *(const LAS f32x4*)(vws + c8 + 4);
            const float rs = __builtin_amdgcn_rsqf(rsn[j] * (1.0f / 2048.0f) + EPS);
            const u32x4 rw = raw[j]; u32x4 o;
            o.x = cvt_pk_bf16(bf2f(rw.x & 0xffffu) * rs * wa[0], bf2f(rw.x >> 16) * rs * wa[1]);
            o.y = cvt_pk_bf16(bf2f(rw.y & 0xffffu) * rs * wa[2], bf2f(rw.y >> 16) * rs * wa[3]);
            o.z = cvt_pk_bf16(bf2f(rw.z & 0xffffu) * rs * wb[0], bf2f(rw.z >> 16) * rs * wb[1]);
            o.w = cvt_pk_bf16(bf2f(rw.w & 0xffffu) * rs * wb[2], bf2f(rw.w >> 16) * rs * wb[3]);
            *(LAS u32x4*)(Vs + r * 264 + c8) = o; }
        __syncthreads();
        if (unit + G < 2048) GATE_FETCH(unit + G);
        bf16x8 vf[4][2];
#pragma unroll
        for (int ks = 0; ks < 4; ++ks)
#pragma unroll
            for (int nt = 0; nt < 2; ++nt)
#pragma unroll
                for (int j = 0; j < 8; ++j) vf[ks][nt][j] = (short)Vs[(32 * ks + 8 * fq + j) * 264 + 32 * wave + 8 * (fr >> 2) + 4 * nt + (fr & 3)];
        u32x4 uu[8];
#pragma unroll
        for (int mt = 0; mt < 8; ++mt) uu[mt] = *(const u32x4*)(Z + (size_t)(row0 + 16 * mt + fr) * 4096 + 256 * g + 32 * wave + 8 * fq);
#pragma unroll
        for (int mt = 0; mt < 8; ++mt) {
            f32x4 a2[2] = {(f32x4){0.f, 0.f, 0.f, 0.f}, (f32x4){0.f, 0.f, 0.f, 0.f}};
#pragma unroll
            for (int ks = 0; ks < 4; ++ks) if (32 * ks <= 16 * mt + 15) {
                const bf16x8 wf = *(const LAS bf16x8*)(Wsl + (16 * mt + fr) * 136 + 32 * ks + 8 * fq);
#pragma unroll
                for (int nt = 0; nt < 2; ++nt) a2[nt] = __builtin_amdgcn_mfma_f32_16x16x32_bf16(vf[ks][nt], wf, a2[nt], 0, 0, 0);
            }
            const int t = 16 * mt + fr; const float bias = bsl[t];
            *(u32x4*)(Z + (size_t)(row0 + t) * 4096 + 256 * g + 32 * wave + 8 * fq) = pack8(unpack4((u32x2){uu[mt].x, uu[mt].y}) * (a2[0] + bias), unpack4((u32x2){uu[mt].z, uu[mt].w}) * (a2[1] + bias));
        }
        __syncthreads();
    }
#undef GATE_FETCH
    float* gmv = P.out + O_GMV;
    for (int b = blockIdx.x; b < 128; b += G) {
        const int row0 = MP + 4 * b;
        if (tid < 4) rsb[tid] = __builtin_amdgcn_rsqf(ss_get(VSS, row0 + tid) * (1.0f / 2048.0f) + EPS);
        __syncthreads();
        const int c = 4 * tid, g = c >> 8;
        const f32x4 vw = *(const f32x4*)(P.gm_v_norm + c);
        f32x4 v[4];
#pragma unroll
        for (int s = 0; s < 4; ++s) { v[s] = unpack4(*(const u32x2*)(Z + (size_t)(row0 + s) * 4096 + 2048 + c)) * rsb[s] * vw; *(f32x4*)(gmv + (size_t)(4 * b + s) * GH + c) = v[s]; }
#pragma unroll
        for (int t = 0; t < 4; ++t) { const float bias = P.gm_b_s[g * 128 + t]; f32x4 mx = (f32x4){bias, bias, bias, bias};
#pragma unroll
            for (int s = 0; s <= t; ++s) mx = mx + v[s] * P.gm_w_s[(g * 128 + t) * 128 + s];
            bf16_t* zp = Z + (size_t)(row0 + t) * 4096 + c; *(u32x2*)zp = pack4(unpack4(*(const u32x2*)zp) * mx); }
        __syncthreads();
    }
}

__device__ __forceinline__ void fixup_phase(LAS unsigned char* lds, int L, int G, int wave0) {
    const Params P = load_params(lds);
    unsigned char* ws = P.ws;
    const f32x4* HG = (const f32x4*)(ws + WS_HG); const f32x4* C0 = (const f32x4*)(ws + WS_C0); const f32x4* U0 = (const f32x4*)(ws + WS_U0);
    bf16_t* ACT = (bf16_t*)(ws + WS_Z);
    const f32x4* cw = (const f32x4*)(P.conv_w + (size_t)L * 3 * DFF);
    const int gt = blockIdx.x * 512 + opaque_tid(wave0), NGT = G * 512;
    for (int idx = gt; idx < 1024 * 704; idx += NGT) {
        const int gj = idx / 704, c4 = idx % 704, grp = gj >> 1, j = gj & 1, r = 64 * grp + j;
        f32x4 conv = C0[idx]; const f32x4 up = U0[idx];
        if ((grp & 127) != 0) { const f32x4 h0 = HG[(size_t)((grp - 1) * 2) * 704 + c4], h1 = HG[(size_t)((grp - 1) * 2 + 1) * 704 + c4]; const f32x4 w0 = cw[c4], w1 = cw[704 + c4];
            conv = conv + (j == 0 ? (w0 * h0 + w1 * h1) : (w0 * h1)); }
        *(u32x2*)(ACT + (size_t)r * DFF + 4 * c4) = pack4(gelu4(conv) * up);
    }
    for (int i = gt; i < MT; i += NGT) { ((unsigned*)(ws + WS_SSA))[i] = 0u; ((unsigned*)(ws + WS_SSB))[i] = 0u; }
    f32x4* ncp = (f32x4*)(P.out + O_NCP + (size_t)L * 4 * 2 * DFF);
    for (int idx = gt; idx < 8 * 704; idx += NGT) { const int bj = idx / 704, c4 = idx % 704, b = bj >> 1, j = bj & 1; ncp[idx] = HG[(size_t)((128 * b + 127) * 2 + j) * 704 + c4]; }
}

template <int PAR> __device__ __forceinline__ float attn_softmax(f32x4 (&S)[10], bool fastp, bool samp, int qb, int qi, int kt0, int fq, int dq, float sink) {
    float mx = sink;
    if (fastp) {
#pragma unroll
        for (int i = 0; i < 10; ++i) { const int c = i - PAR;
            if (c < 0 || c > 8) continue;
#pragma unroll
            for (int j = 0; j < 4; ++j) {
                if (c == 0) { if (!(dq + j > 0)) S[i][j] = -1e30f; }
                else if (c == 8) { if (!(dq + j <= 0)) S[i][j] = -1e30f; }
                mx = fmaxf(mx, S[i][j]); } }
    } else {
#pragma unroll
        for (int i = 0; i < 10; ++i)
#pragma unroll
            for (int j = 0; j < 4; ++j) { const int kw = 16 * (kt0 + i) + 4 * fq + j;
                const bool vis = (kw > qi) && (kw <= qi + 128) && (samp ? (kw < 132) : (qb > 0 || kw >= 128));
                const float sv = vis ? S[i][j] : -1e30f; S[i][j] = sv; mx = fmaxf(mx, sv); }
    }
    mx = xmax16(mx); mx = xmax32(mx);
    float sum = 0.f;
#pragma unroll
    for (int i = 0; i < 10; ++i) { const int c = i - PAR;
        if (fastp && (c < 0 || c > 8)) { S[i] = (f32x4){0.f, 0.f, 0.f, 0.f}; continue; }
#pragma unroll
        for (int j = 0; j < 4; ++j) { const float e = __builtin_amdgcn_exp2f(S[i][j] - mx); S[i][j] = e; sum += e; } }
    sum = xsum16(sum); sum = xsum32(sum);
    return 1.0f / (sum + __builtin_amdgcn_exp2f(sink - mx));
}
__device__ __forceinline__ bf16x8 attn_pfrag(const f32x4& a, const f32x4& b, float inv) {
    const f32x4 p0 = a * inv, p1 = b * inv;
    const u32x4 pw = (u32x4){cvt_pk_bf16(p0[0], p0[1]), cvt_pk_bf16(p0[2], p0[3]), cvt_pk_bf16(p1[0], p1[1]), cvt_pk_bf16(p1[2], p1[3])};
    return __builtin_bit_cast(bf16x8, pw);
}
__device__ __forceinline__ void attn_phase(LAS unsigned char* lds, int G, int wave0, int odummy) {
    const Params P = load_params(lds);
    const int tid = opaque_tid(wave0), lane = tid & 63, wave = tid >> 6, fr = lane & 15, fq = lane >> 4;
    unsigned char* ws = P.ws;
    bf16_t* Q = (bf16_t*)(ws + WS_Z + 195 * MiB); bf16_t* Oout = odummy ? (bf16_t*)(ws + WS_Z + 130 * MiB) : Q; const bf16_t* KB = (const bf16_t*)(ws + WS_KB); const bf16_t* VB = (const bf16_t*)(ws + WS_VB);
    LAS bf16_t* Ks = (LAS bf16_t*)lds;
    LAS bf16_t* VTs = (LAS bf16_t*)(lds + 256 * 72 * 2);
    for (int i = blockIdx.x * 512 + tid; i < MT; i += G * 512) ((unsigned*)(ws + WS_SSB))[i] = 0u;
    for (int unit = blockIdx.x; unit < 768; unit += G) {
        const bool samp = unit >= 512;
        const int kvh = unit & 1;
        int b, qb;
        if (!samp) { b = unit >> 7; qb = (unit >> 1) & 63; } else { b = (unit - 512) >> 1; qb = 1; }
#pragma unroll
        for (int j = 0; j < 4; ++j) {
            const int idx = tid + 512 * j, r = idx >> 3, c8 = (idx & 7) * 8;
            u32x4 kv = (u32x4){0u, 0u, 0u, 0u}, vv = (u32x4){0u, 0u, 0u, 0u};
            if (!samp) { const int t = 128 * (qb - 1) + r; if (t >= 0) { const size_t go = (size_t)(b * SEQ + t) * KVD + kvh * 64 + c8; kv = *(const u32x4*)(KB + go); vv = *(const u32x4*)(VB + go); } }
            else if (r < 128) { const size_t go = ((size_t)(b * 128 + r) * 2 + kvh) * 64 + c8;
                const f32x4 k0 = *(const f32x4*)(P.cache_k + go), k1 = *(const f32x4*)(P.cache_k + go + 4), v0 = *(const f32x4*)(P.cache_v + go), v1 = *(const f32x4*)(P.cache_v + go + 4);
                kv = (u32x4){cvt_pk_bf16(k0[0], k0[1]), cvt_pk_bf16(k0[2], k0[3]), cvt_pk_bf16(k1[0], k1[1]), cvt_pk_bf16(k1[2], k1[3])};
                vv = (u32x4){cvt_pk_bf16(v0[0], v0[1]), cvt_pk_bf16(v0[2], v0[3]), cvt_pk_bf16(v1[0], v1[1]), cvt_pk_bf16(v1[2], v1[3])}; }
            else if (r < 132) { const size_t go = (size_t)(MP + 4 * b + (r - 128)) * KVD + kvh * 64 + c8; kv = *(const u32x4*)(KB + go); vv = *(const u32x4*)(VB + go); }
            *(LAS u32x4*)(Ks + r * 72 + c8) = kv;
            const int sp = r & 31, kk = (r & ~31) + 8 * ((sp & 15) >> 2) + 4 * (sp >> 4) + (sp & 3);
            LAS bf16_t* vt = VTs + c8 * 264 + kk;
            vt[0 * 264] = (bf16_t)(vv.x & 0xffffu); vt[1 * 264] = (bf16_t)(vv.x >> 16); vt[2 * 264] = (bf16_t)(vv.y & 0xffffu); vt[3 * 264] = (bf16_t)(vv.y >> 16);
            vt[4 * 264] = (bf16_t)(vv.z & 0xffffu); vt[5 * 264] = (bf16_t)(vv.z >> 16); vt[6 * 264] = (bf16_t)(vv.w & 0xffffu); vt[7 * 264] = (bf16_t)(vv.w >> 16);
        }
        __syncthreads();
        const int lane_ = lane; const int h = kvh * 8 + wave; const float sink = P.sinks[h] * LOG2E;
        const int nrt = samp ? 1 : 8;
        const bool fastp = !samp && qb > 0;
        const int dq = 4 * fq - fr;
#pragma unroll 1
        for (int rt2 = 0; rt2 < nrt; rt2 += 2) {
            const bool two = !samp;
            const int rowq0 = samp ? (MP + 4 * b + (fr & 3)) : (b * SEQ + qb * 128 + rt2 * 16 + fr), rowq1 = rowq0 + (two ? 16 : 0);
            const int qi0 = samp ? fr : 16 * rt2 + fr, qi1 = qi0 + 16;
            const int kt0 = samp ? 0 : rt2;
            bf16x8 qA[2], qB[2];
#pragma unroll
            for (int k = 0; k < 2; ++k) { qA[k] = *(const bf16x8*)(Q + (size_t)rowq0 * 1024 + h * 64 + 32 * k + 8 * fq); qB[k] = *(const bf16x8*)(Q + (size_t)rowq1 * 1024 + h * 64 + 32 * k + 8 * fq); }
            f32x4 SA[10], SB[10];
#pragma unroll
            for (int i = 0; i < 10; ++i) { f32x4 a = (f32x4){0.f, 0.f, 0.f, 0.f}, c2 = (f32x4){0.f, 0.f, 0.f, 0.f};
                const bool needA = !(fastp && i > 8), needB = two && !(fastp && i < 1);
#pragma unroll
                for (int k = 0; k < 2; ++k) { const bf16x8 kf = *(const LAS bf16x8*)(Ks + (16 * (kt0 + i) + fr) * 72 + 32 * k + 8 * fq);
                    if (needA) a = __builtin_amdgcn_mfma_f32_16x16x32_bf16(kf, qA[k], a, 0, 0, 0);
                    if (needB) c2 = __builtin_amdgcn_mfma_f32_16x16x32_bf16(kf, qB[k], c2, 0, 0, 0); }
                SA[i] = a; SB[i] = c2; }
            const float invA = attn_softmax<0>(SA, fastp, samp, qb, qi0, kt0, fq, dq, sink);
            float invB = 0.f;
            if (two) invB = attn_softmax<1>(SB, fastp, samp, qb, qi1, kt0, fq, dq, sink);
            f32x4 oA[4] = {(f32x4){0.f, 0.f, 0.f, 0.f}, (f32x4){0.f, 0.f, 0.f, 0.f}, (f32x4){0.f, 0.f, 0.f, 0.f}, (f32x4){0.f, 0.f, 0.f, 0.f}};
            f32x4 oB[4] = {(f32x4){0.f, 0.f, 0.f, 0.f}, (f32x4){0.f, 0.f, 0.f, 0.f}, (f32x4){0.f, 0.f, 0.f, 0.f}, (f32x4){0.f, 0.f, 0.f, 0.f}};
#pragma unroll
            for (int i = 0; i < 5; ++i) {
                const bf16x8 pA = attn_pfrag(SA[2 * i], SA[2 * i + 1], invA), pB = attn_pfrag(SB[2 * i], SB[2 * i + 1], invB);
#pragma unroll
                for (int dt = 0; dt < 4; ++dt) { const bf16x8 vfr = *(const LAS bf16x8*)(VTs + (32 * (dt >> 1) + 8 * (fr >> 2) + 4 * (dt & 1) + (fr & 3)) * 264 + 32 * ((kt0 >> 1) + i) + 8 * fq);
                    oA[dt] = __builtin_amdgcn_mfma_f32_16x16x32_bf16(vfr, pA, oA[dt], 0, 0, 0);
                    if (two) oB[dt] = __builtin_amdgcn_mfma_f32_16x16x32_bf16(vfr, pB, oB[dt], 0, 0, 0); }
            }
            if (!samp || fr < 4) {
#pragma unroll
                for (int dp = 0; dp < 2; ++dp) *(u32x4*)(Oout + (size_t)rowq0 * 1024 + h * 64 + 32 * dp + 8 * fq) = pack8(oA[2 * dp], oA[2 * dp + 1]);
            }
            if (two) {
#pragma unroll
                for (int dp = 0; dp < 2; ++dp) *(u32x4*)(Oout + (size_t)rowq1 * 1024 + h * 64 + 32 * dp + 8 * fq) = pack8(oB[2 * dp], oB[2 * dp + 1]);
            }
        }
        __syncthreads();
    }
}

__device__ __forceinline__ void final_phase(LAS unsigned char* lds, int G, int wave0) {
    const Params P = load_params(lds);
    const int tid = opaque_tid(wave0), lane = tid & 63, wave = tid >> 6;
    const float* SSB = (const float*)(P.ws + WS_SSB);
    const bf16_t* XB = (const bf16_t*)(P.ws + WS_Z + 130 * MiB);
    const int gw = blockIdx.x * 8 + wave, NGW = G * 8;
    f32x4 w[4];
#pragma unroll
    for (int j = 0; j < 2; ++j) { w[2 * j] = *((const f32x4*)P.final_norm + 128 * j + 2 * lane); w[2 * j + 1] = *((const f32x4*)P.final_norm + 128 * j + 2 * lane + 1); }
    for (int m = gw; m < MT; m += 2 * NGW) {
        const int m2 = m + NGW < MT ? m + NGW : m;
        const float rs = rstd16(SSB, m), rs2 = rstd16(SSB, m2);
        u32x4 a[2], b[2];
#pragma unroll
        for (int j = 0; j < 2; ++j) { a[j] = *((const u32x4*)(XB + (size_t)m * DM) + 64 * j + lane); b[j] = *((const u32x4*)(XB + (size_t)m2 * DM) + 64 * j + lane); }
        f32x4* yr = (f32x4*)(P.out + (size_t)m * DM); f32x4* yr2 = (f32x4*)(P.out + (size_t)m2 * DM);
#pragma unroll
        for (int j = 0; j < 2; ++j) {
            yr[128 * j + 2 * lane] = unpack4((u32x2){a[j].x, a[j].y}) * rs * w[2 * j]; yr[128 * j + 2 * lane + 1] = unpack4((u32x2){a[j].z, a[j].w}) * rs * w[2 * j + 1];
            if (m2 != m) { yr2[128 * j + 2 * lane] = unpack4((u32x2){b[j].x, b[j].y}) * rs2 * w[2 * j]; yr2[128 * j + 2 * lane + 1] = unpack4((u32x2){b[j].z, b[j].w}) * rs2 * w[2 * j + 1]; }
        }
    }
}

#define XB_TMO      128
#define XB_XCNT(j)  (256  + 64 * (j))
#define XB_XSUB(j)  (1280 + 64 * (j))
#define XB_XGEN(j)  (2304 + 64 * (j))
#define XB_TOP      3328
#define XB_TOPGEN   3392
#define XCD_BAR_WORDS 3456
#define XB_SPIN_CAP (1u << 18)
__device__ __forceinline__ unsigned xb_ld(unsigned* p)              { return __hip_atomic_load(p, __ATOMIC_RELAXED, __HIP_MEMORY_SCOPE_AGENT); }
__device__ __forceinline__ unsigned xb_add(unsigned* p, unsigned v) { return __hip_atomic_fetch_add(p, v, __ATOMIC_RELAXED, __HIP_MEMORY_SCOPE_AGENT); }
__device__ __forceinline__ unsigned xb_xcc_id() { return (unsigned)__builtin_amdgcn_s_getreg((3 << 11) | 20) & 0xFu; }
#define XB_SPIN(cond, bar) do { unsigned _sp = 0; while (cond) { __builtin_amdgcn_s_sleep(1); \
    if ((++_sp & 255u) == 0u) { if (xb_ld(&(bar)[XB_TMO])) break; if (_sp > XB_SPIN_CAP) { atomicAdd(&(bar)[XB_TMO], 1u); break; } } } } while (0)
struct XcdBarrier { unsigned* bar; unsigned x; volatile LAS unsigned* st; };
__device__ __forceinline__ XcdBarrier xcd_barrier_post(unsigned* bar, volatile LAS unsigned* st) {
    XcdBarrier b; b.bar = bar; b.x = xb_xcc_id(); b.st = st;
    if (threadIdx.x == 0) (void)xb_add(&bar[XB_XCNT(b.x)], 1u);
    return b;
}
__device__ __forceinline__ void xcd_barrier_complete(unsigned* bar, unsigned x, unsigned& nloc, unsigned& nx) {
    const unsigned G = gridDim.x * gridDim.y * gridDim.z;
    unsigned sum, cnt, mine, sp = 0u;
    for (;;) {
        sum = 0u; cnt = 0u; mine = 0u;
#pragma unroll
        for (unsigned j = 0; j < 16; ++j) { const unsigned c = xb_ld(&bar[XB_XCNT(j)]); sum += c; cnt += (c > 0u) ? 1u : 0u; mine = (j == x) ? c : mine; }
        if (sum == G) break;
        __builtin_amdgcn_s_sleep(1);
        if ((++sp & 255u) == 0u) { if (xb_ld(&bar[XB_TMO])) break; if (sp > XB_SPIN_CAP) { atomicAdd(&bar[XB_TMO], 1u); break; } }
    }
    nloc = mine > 0u ? mine : 1u; nx = cnt > 0u ? cnt : 1u;
}
__device__ __forceinline__ void xcd_barrier(const XcdBarrier& b) {
    asm volatile("s_waitcnt vmcnt(0)" ::: "memory");
    __syncthreads();
    if (threadIdx.x == 0) {
        unsigned* bar = b.bar;
        __builtin_amdgcn_s_waitcnt(0);
        unsigned nloc = b.st[0], nx = b.st[1];
        if (nloc == 0u) { xcd_barrier_complete(bar, b.x, nloc, nx); b.st[0] = nloc; b.st[1] = nx; }
        const unsigned old = xb_add(&bar[XB_XSUB(b.x)], 1u);
        const unsigned gen = old / nloc;
        if (old + 1u == (gen + 1u) * nloc) {
            __builtin_amdgcn_fence(__ATOMIC_RELEASE, "agent");
            asm volatile("s_waitcnt vmcnt(0)" ::: "memory");
            const unsigned og = xb_add(&bar[XB_TOP], 1u);
            const unsigned tg = og / nx;
            if (og + 1u == (tg + 1u) * nx) xb_add(&bar[XB_TOPGEN], 1u);
            else XB_SPIN(xb_ld(&bar[XB_TOPGEN]) == tg, bar);
            __builtin_amdgcn_fence(__ATOMIC_ACQUIRE, "agent");
            xb_add(&bar[XB_XGEN(b.x)], 1u);
            asm volatile("s_waitcnt vmcnt(0)" ::: "memory");
        } else {
            XB_SPIN(xb_ld(&bar[XB_XGEN(b.x)]) == gen, bar);
            __builtin_amdgcn_fence(__ATOMIC_ACQUIRE, "agent");
            asm volatile("s_waitcnt vmcnt(0)" ::: "memory");
        }
    }
    __syncthreads();
}

constexpr int LDS_BYTES = 147456;
__global__ void __launch_bounds__(512, 2) yoco_fwd(Params Pk) {
    extern __shared__ __attribute__((aligned(16))) unsigned char lds_raw[];
    LAS unsigned char* lds = (LAS unsigned char*)lds_raw;
    cg::grid_group grid = cg::this_grid();
#ifndef PROBE_MASK
#define PROBE_MASK 0u
#endif
#if PROBE == 1
#define GSYNC() do { xcd_barrier(xbar); xcd_barrier(xbar); } while (0)
#elif PROBE_MASK != 0u
    int ph_ = 1; unsigned long long tprev_ = __builtin_amdgcn_s_memrealtime();
#define GSYNC() do { xcd_barrier(xbar); unsigned long long tn_ = __builtin_amdgcn_s_memrealtime(); \
        if ((PROBE_MASK >> ph_) & 1u) { if (blockIdx.x == 0) { while (__builtin_amdgcn_s_memrealtime() - tn_ < tn_ - tprev_) __builtin_amdgcn_s_sleep(8); } xcd_barrier(xbar); tn_ = __builtin_amdgcn_s_memrealtime(); } \
        tprev_ = tn_; ++ph_; } while (0)
#else
#define GSYNC() do { XcdBarrier xb_; { unsigned po_ = PARAM_OFF; asm volatile("" : "+v"(po_)); xb_.bar = (unsigned*)(__attribute__((address_space(1))) unsigned*)ldq(lds + po_, 29) + 4096; } xb_.x = xb_xcc_id(); xb_.st = (volatile LAS unsigned*)(lds + 131072 + 512); xcd_barrier(xb_); } while (0)
#endif
#ifndef PHM
#define PHM 0xffff
#endif
#if PROBE >= 3
#define REP_BEGIN(id) { int nrep_ = (PROBE == (id)) ? 2 : 1; asm volatile("" : "+s"(nrep_)); _Pragma("unroll 1") for (int r_ = 0; r_ < nrep_; ++r_) {
#define REP_END() } }
#else
#define REP_BEGIN(id) {
#define REP_END() }
#endif
    constexpr int G = 256;
    const int wave0 = __builtin_amdgcn_readfirstlane((int)threadIdx.x >> 6);
    volatile LAS unsigned* xst = (volatile LAS unsigned*)(lds + 131072 + 512);
    if (threadIdx.x < 2) xst[threadIdx.x] = 0u;
    if (threadIdx.x < 30) ((LAS unsigned long long*)(lds + PARAM_OFF))[threadIdx.x] = ((const unsigned long long*)&Pk)[threadIdx.x];
    __syncthreads();
    XcdBarrier xbar = xcd_barrier_post((unsigned*)Pk.ws + 4096, xst);

    if (PHM & 1) conv_stage(lds, 0, 0, wave0);
    if (Pk.ws == nullptr) grid.sync();
    xcd_barrier(xbar);
#if PROBE_MASK != 0u
    { unsigned long long tn_ = __builtin_amdgcn_s_memrealtime();
      if (PROBE_MASK & 1u) { if (blockIdx.x == 0) { while (__builtin_amdgcn_s_memrealtime() - tn_ < tn_ - tprev_) __builtin_amdgcn_s_sleep(8); } xcd_barrier(xbar); tn_ = __builtin_amdgcn_s_memrealtime(); }
      tprev_ = tn_; }
#endif
#pragma unroll 1
    for (int L = 0; L < 2; ++L) {
        pg8::StaticOrder S;
        if (L == 0) {
            { const Params P = load_params(lds); unsigned char* ws = P.ws;
              pg8::Gemm g{(const bf16_t*)(ws + WS_XBA), (const bf16_t*)(ws + WS_WIN), MT, 4096, 1024, 1024}; S.init(MP, 4096, G, blockIdx.x);
              EpiGm E{(const float*)(ws + WS_SSA), (bf16_t*)(ws + WS_Z), (float*)(ws + WS_VSS)}; if (PHM & 2) pg8::gemm_phase<EpiGm>(lds, g, S, E, wave0); }
            conv_stage(lds, 1, 64, wave0);
            GSYNC();
            if (PHM & 4) gating_phase(lds, G, wave0);
            GSYNC();
        } else {
            { const Params P = load_params(lds); unsigned char* ws = P.ws;
              pg8::Gemm g{(const bf16_t*)(ws + WS_Z + 130 * MiB), (const bf16_t*)(ws + WS_WQKV), MT, 1280, 1024, 1024}; S.init(MP, 1280, G, blockIdx.x);
              EpiQKV E{(const float*)(ws + WS_SSB), (const float*)(ws + WS_ROPE), (bf16_t*)(ws + WS_Z + 195 * MiB), (bf16_t*)(ws + WS_KB), (bf16_t*)(ws + WS_VB), P.out};
              if (PHM & 8) pg8::gemm_phase<EpiQKV>(lds, g, S, E, wave0); }
            GSYNC();
#if PROBE == 2
            attn_phase(lds, G, wave0, 1);
#endif
            if (PHM & 16) attn_phase(lds, G, wave0, 0);
            GSYNC();
        }
        { const Params P = load_params(lds); unsigned char* ws = P.ws;
          pg8::Gemm g{(const bf16_t*)(ws + WS_Z + (L == 0 ? 0 : 195 * MiB)), (const bf16_t*)(ws + (L == 0 ? WS_WOUT : WS_WO)), MT, 1024, L == 0 ? 2048 : 1024, L == 0 ? 4096 : 1024}; S.init(MP, 1024, G, blockIdx.x);
          EpiRes E{(const bf16_t*)(ws + (L == 0 ? WS_XBA : WS_Z + 130 * MiB)), (bf16_t*)(ws + WS_XBA), (float*)(ws + WS_SSB)}; if (PHM & 32) pg8::gemm_phase<EpiRes>(lds, g, S, E, wave0); }
        if (L == 0) conv_stage(lds, 2, 16, wave0); else conv_stage(lds, 8, 16, wave0);
        GSYNC();
        { const Params P = load_params(lds); unsigned char* ws = P.ws;
          pg8::Gemm g{(const bf16_t*)(ws + WS_XBA), (const bf16_t*)(ws + WS_WGU0 + (size_t)L * 11 * MiB), MT, 2 * DFF, 1024, 1024}; S.init(MP, 2 * DFF, G, blockIdx.x);
          EpiGU E{(const float*)(ws + WS_SSB), (bf16_t*)(ws + WS_Z), P.conv_w + (size_t)L * 3 * DFF, P.conv_b + (size_t)L * DFF, (float*)(ws + WS_HG), (float*)(ws + WS_C0), (float*)(ws + WS_U0),
                  P.state + (size_t)L * 128 * 2 * DFF, P.out + O_NCS + (size_t)L * 128 * 2 * DFF};
          REP_BEGIN(3) if (PHM & 64) pg8::gemm_phase<EpiGU>(lds, g, S, E, wave0); REP_END()
        }
        if (L == 0) conv_stage(lds, 3, 88, wave0); else conv_stage(lds, 5, 88, wave0);
        GSYNC();
        if (PHM & 128) fixup_phase(lds, L, G, wave0);
        GSYNC();
        { const Params P = load_params(lds); unsigned char* ws = P.ws;
          pg8::Gemm g{(const bf16_t*)(ws + WS_Z), (const bf16_t*)(ws + WS_WD0 + (size_t)L * 5632 * 1024), MT, 1024, DFF, DFF}; S.init(MP, 1024, G, blockIdx.x);
          EpiRes E{(const bf16_t*)(ws + WS_XBA), (bf16_t*)(ws + WS_XBA), (float*)(ws + WS_SSA)}; if (PHM & 256) pg8::gemm_phase<EpiRes>(lds, g, S, E, wave0); }
        if (L == 0) conv_stage(lds, 4, 16, wave0); else conv_stage(lds, 6, 16, wave0);
        GSYNC();
        { const Params P = load_params(lds); unsigned char* ws = P.ws;
          pg8::Gemm g{(const bf16_t*)(ws + WS_PB) + (size_t)L * MT * PLE, (const bf16_t*)(ws + WS_WPP0 + (size_t)L * 512 * 1024), MT, 1024, 256, 256}; S.init(MP, 1024, G, blockIdx.x);
          EpiBf E{(bf16_t*)(ws + WS_Z)}; if (PHM & 512) pg8::gemm_phase<EpiBf>(lds, g, S, E, wave0); }
        { const Params P = load_params(lds); unsigned char* ws = P.ws;
          pg8::Gemm g{(const bf16_t*)(ws + WS_XBA), (const bf16_t*)(ws + WS_WPG0 + (size_t)L * 2 * MiB), MT, 1024, 1024, 1024}; S.init(MP, 1024, G, blockIdx.x);
          EpiPle E{(const float*)(ws + WS_SSA), (const bf16_t*)(ws + WS_Z), (const bf16_t*)(ws + WS_XBA), (bf16_t*)(ws + WS_Z + 130 * MiB), (float*)(ws + WS_SSB)}; if (PHM & 1024) pg8::gemm_phase<EpiPle>(lds, g, S, E, wave0); }
        if (L == 0) conv_stage(lds, 7, 16, wave0);
        GSYNC();
    }
    if (PHM & 2048) final_phase(lds, G, wave0);
#if PROBE_MASK != 0u
    if ((PROBE_MASK >> 15) & 1u) { asm volatile("s_waitcnt vmcnt(0)" ::: "memory"); const unsigned long long tn_ = __builtin_amdgcn_s_memrealtime(); if (blockIdx.x == 0) { while (__builtin_amdgcn_s_memrealtime() - tn_ < tn_ - tprev_) __builtin_amdgcn_s_sleep(8); } }
#endif
}

extern "C" void kernel_launch(void* const* d_in, const int* in_sizes, int n_in, void* d_out, int out_size, void* d_ws, size_t ws_size, hipStream_t stream) {
    static int grid = 0;
    if (grid == 0) {
        if (n_in != 28 || ws_size < WS_END) { fprintf(stderr, "kernel_launch: unexpected n_in %d / ws_size %zu\n", n_in, ws_size); grid = -1; return; }
        int dev = 0, cus = 0, per_cu = 0;
        hipGetDevice(&dev); hipDeviceGetAttribute(&cus, hipDeviceAttributeMultiprocessorCount, dev);
        hipFuncSetAttribute((const void*)yoco_fwd, hipFuncAttributeMaxDynamicSharedMemorySize, LDS_BYTES);
        hipOccupancyMaxActiveBlocksPerMultiprocessor(&per_cu, (const void*)yoco_fwd, 512, LDS_BYTES);
        if (per_cu < 1) { fprintf(stderr, "kernel_launch: occupancy query says %d blocks/CU\n", per_cu); per_cu = 1; }
        (void)hipGetLastError();
        if (cus < 256) { fprintf(stderr, "kernel_launch: needs 256 CUs, device has %d\n", cus); grid = -1; return; }
        grid = 256;
    }
    if (grid < 0) return;
    if (hipMemsetAsync(d_ws, 0, 65536, stream) != hipSuccess) { fprintf(stderr, "kernel_launch: memset failed\n"); return; }
    Params p{};
    const float** pp = (const float**)&p;
    for (int i = 0; i < 28; ++i) pp[i] = (const float*)d_in[i];
    p.out = (float*)d_out; p.ws = (unsigned char*)d_ws;
    void* args[] = {&p};
    hipError_t e = hipLaunchCooperativeKernel((const void*)yoco_fwd, dim3(grid), dim3(512), args, LDS_BYTES, stream);
    if (e != hipSuccess) fprintf(stderr, "cooperative launch failed: %s (grid %d)\n", hipGetErrorString(e), grid);
}
```

```cpp
#include <hip/hip_runtime.h>
#include <hip/hip_cooperative_groups.h>
#include <cstdio>
#include <cstdint>
namespace cg = cooperative_groups;
#ifndef PROBE
#define PROBE 0
#endif

#define LAS __attribute__((address_space(3)))
typedef unsigned short bf16_t;
typedef short bf16x8 __attribute__((ext_vector_type(8)));
typedef float f32x4 __attribute__((ext_vector_type(4)));
typedef float f32x2 __attribute__((ext_vector_type(2)));
typedef unsigned u32x4 __attribute__((ext_vector_type(4)));
typedef unsigned u32x2 __attribute__((ext_vector_type(2)));

constexpr int DM = 1024, SEQ = 8192, MP = 32768, MS = 512, MT = MP + MS;
constexpr int GH = 2048, DFF = 2816, PLE = 256, KVD = 128;
constexpr float EPS = 1e-6f;
constexpr float LOG2E = 1.4426950408889634f;

constexpr size_t MiB = 1u << 20;
constexpr size_t WS_ROPE = 1 * MiB;
constexpr size_t WS_WTRIL = 2 * MiB;
constexpr size_t WS_SSA = 3 * MiB;
constexpr size_t WS_SSB = 6 * MiB;
constexpr size_t WS_VSS = 9 * MiB;
constexpr size_t WS_HG = 14 * MiB;
constexpr size_t WS_C0 = 25 * MiB;
constexpr size_t WS_U0 = 36 * MiB;
constexpr size_t WS_KB = 47 * MiB;
constexpr size_t WS_VB = 56 * MiB;
constexpr size_t WS_WIN = 66 * MiB;
constexpr size_t WS_WOUT = 74 * MiB;
constexpr size_t WS_WGU0 = 78 * MiB;
constexpr size_t WS_WD0 = 100 * MiB;
constexpr size_t WS_WPG0 = 111 * MiB;
constexpr size_t WS_WPP0 = 115 * MiB;
constexpr size_t WS_WQKV = 116 * MiB;
constexpr size_t WS_WO = 119 * MiB;
constexpr size_t WS_XBA = 121 * MiB;
constexpr size_t WS_PB = 186 * MiB;
constexpr size_t WS_Z = 219 * MiB;
constexpr size_t WS_END = 479 * MiB;

constexpr size_t O_Y = 0, O_GMV = 34078720, O_NCP = 35127296, O_NCS = 35172352, O_NKP = 36614144, O_NVP = 36679680, O_KS = 36745216, O_VS = 36810752;

__device__ __forceinline__ unsigned cvt_pk_bf16(float lo, float hi) { unsigned r; asm volatile("v_cvt_pk_bf16_f32 %0, %1, %2" : "=v"(r) : "v"(lo), "v"(hi)); return r; }
__device__ __forceinline__ float bf2f(unsigned h) { return __uint_as_float(h << 16); }
__device__ __forceinline__ u32x2 pack4(f32x4 v) { u32x2 w; w.x = cvt_pk_bf16(v[0], v[1]); w.y = cvt_pk_bf16(v[2], v[3]); return w; }
__device__ __forceinline__ f32x4 unpack4(u32x2 w) { return (f32x4){bf2f(w.x & 0xffffu), bf2f(w.x >> 16), bf2f(w.y & 0xffffu), bf2f(w.y >> 16)}; }
__device__ __forceinline__ float gelu1(float x) {
    const float z = x * (0.7978845608f + 0.0356774081f * x * x);
    const float e = __builtin_amdgcn_exp2f(-2.0f * LOG2E * z);
    return x * __builtin_amdgcn_rcpf(1.0f + e);
}
__device__ __forceinline__ f32x2 gelu_pk2(f32x2 v) {
    const f32x2 t = (v * v) * (-0.10294325f) + (-2.3022082f);
    const f32x2 y = v * t;
    f32x2 e; e.x = __builtin_amdgcn_exp2f(y.x); e.y = __builtin_amdgcn_exp2f(y.y);
    const f32x2 d = e + 1.0f;
    f32x2 r; r.x = __builtin_amdgcn_rcpf(d.x); r.y = __builtin_amdgcn_rcpf(d.y);
    return v * r;
}
__device__ __forceinline__ f32x4 gelu4(f32x4 v) { const f32x2 a = gelu_pk2((f32x2){v[0], v[1]}), b = gelu_pk2((f32x2){v[2], v[3]}); return (f32x4){a.x, a.y, b.x, b.y}; }
__device__ __forceinline__ f32x4 sigmoid4(f32x4 v) {
    const f32x4 y = v * (-LOG2E);
    const f32x4 e = (f32x4){__builtin_amdgcn_exp2f(y[0]), __builtin_amdgcn_exp2f(y[1]), __builtin_amdgcn_exp2f(y[2]), __builtin_amdgcn_exp2f(y[3])} + 1.0f;
    return (f32x4){__builtin_amdgcn_rcpf(e[0]), __builtin_amdgcn_rcpf(e[1]), __builtin_amdgcn_rcpf(e[2]), __builtin_amdgcn_rcpf(e[3])};
}
__device__ __forceinline__ float sigmoid1(float x) { return __builtin_amdgcn_rcpf(1.0f + __builtin_amdgcn_exp2f(-LOG2E * x)); }
__device__ __forceinline__ u32x4 pack8(f32x4 a, f32x4 b) { u32x4 w; w.x = cvt_pk_bf16(a[0], a[1]); w.y = cvt_pk_bf16(a[2], a[3]); w.z = cvt_pk_bf16(b[0], b[1]); w.w = cvt_pk_bf16(b[2], b[3]); return w; }
__device__ __forceinline__ float dot4(f32x4 v) { return (v[0] * v[0] + v[1] * v[1]) + (v[2] * v[2] + v[3] * v[3]); }
constexpr float SS_SCALE = 512.0f, SS_INV = 1.0f / 512.0f;
__device__ __forceinline__ float ss_get(const float* ss, int row) { return (float)((const unsigned*)ss)[row] * SS_INV; }
__device__ __forceinline__ void ss_set(float* ss, int row, float v) { ((unsigned*)ss)[row] = (unsigned)__builtin_rintf(v * SS_SCALE); }
__device__ __forceinline__ void ss_add(float* ss, int row, float v) { (void)__hip_atomic_fetch_add((unsigned*)ss + row, (unsigned)__builtin_rintf(v * SS_SCALE), __ATOMIC_RELAXED, __HIP_MEMORY_SCOPE_AGENT); }
__device__ __forceinline__ float rstd16(const float* ss, int row) { return __builtin_amdgcn_rsqf(ss_get(ss, row) * (1.0f / 1024.0f) + EPS); }
#define EPI_FENCE() asm volatile("" ::: "memory")
__device__ __forceinline__ int opaque_tid(int wave0) { int l; asm volatile("v_mbcnt_lo_u32_b32 %0, -1, 0\n\tv_mbcnt_hi_u32_b32 %0, -1, %0" : "=v"(l)); return wave0 * 64 + l; }
__device__ __forceinline__ float bperm(float v, int src) { return __int_as_float(__builtin_amdgcn_ds_bpermute(src << 2, __float_as_int(v))); }
__device__ __forceinline__ float xsum16(float v) { const auto r = __builtin_amdgcn_permlane16_swap(__float_as_uint(v), __float_as_uint(v), false, false); return __uint_as_float(r[0]) + __uint_as_float(r[1]); }
__device__ __forceinline__ float xsum32(float v) { const auto r = __builtin_amdgcn_permlane32_swap(__float_as_uint(v), __float_as_uint(v), false, false); return __uint_as_float(r[0]) + __uint_as_float(r[1]); }
__device__ __forceinline__ float xmax16(float v) { const auto r = __builtin_amdgcn_permlane16_swap(__float_as_uint(v), __float_as_uint(v), false, false); return fmaxf(__uint_as_float(r[0]), __uint_as_float(r[1])); }
__device__ __forceinline__ float xmax32(float v) { const auto r = __builtin_amdgcn_permlane32_swap(__float_as_uint(v), __float_as_uint(v), false, false); return fmaxf(__uint_as_float(r[0]), __uint_as_float(r[1])); }
__device__ __forceinline__ float xpartner16(float v, int fq) { const auto r = __builtin_amdgcn_permlane16_swap(__float_as_uint(v), __float_as_uint(v), false, false); return __uint_as_float((fq & 1) ? r[0] : r[1]); }
__device__ __forceinline__ f32x4 shfl4(f32x4 v, int src) { return (f32x4){bperm(v[0], src), bperm(v[1], src), bperm(v[2], src), bperm(v[3], src)}; }
__device__ __forceinline__ float wave_sum(float v, int lane_) {
#pragma unroll
    for (int o = 1; o < 64; o <<= 1) v += bperm(v, lane_ ^ o);
    return v;
}

namespace pg8 {
constexpr int BM = 256, BK = 64, HALF = 128, HTB = HALF * BK * 2, STAGE_BYTES = 8 * HTB, NXCD = 8, WGM = 8;
__host__ __device__ __forceinline__ int lds_byte(int r, int c) { const int st = (r >> 4) * 2 + (c >> 5), rr = r & 15, cc = c & 31, ob = rr * 64 + cc * 2; return st * 1024 + (ob ^ (((ob >> 9) & 1) << 5)); }
__host__ __device__ __forceinline__ void stage_rc(int b, int& R, int& C) { const int st = b / 1024, sb = b % 1024, swz = sb ^ (((sb >> 9) & 1) << 5); R = (st >> 1) * 16 + swz / 64; C = (st & 1) * 32 + (swz % 64) / 2; }

__host__ __device__ __forceinline__ int perm32(int rho) { const int n = rho >> 4, i = rho & 15; return 8 * (i >> 2) + 4 * n + (i & 3); }
template <class E> constexpr auto epi_perm(int) -> decltype(E::PERM) { return E::PERM; }
template <class E> constexpr bool epi_perm(long) { return false; }
struct Unit { int row0, pn, half; };
struct Gemm { const bf16_t* A; const bf16_t* Bt; int M, N, K, lda; };

struct StaticOrder {
    int nM, nN, nwg, G, c;
    __device__ void init(int M, int N, int G_, int c_) { nM = M / BM; nN = N / BM; nwg = nM * nN; G = G_; c = c_; }
    __device__ bool next(int i, Unit& u) const {
        const long L = (long)i * G + c;
        if (L >= nwg) { const int q = (int)(L - nwg); if (q >= 4 * nN) return false; u.row0 = MP + (q & 3) * 128; u.pn = q >> 2; u.half = 1; return true; }
        int wgid = (int)L; { const int q = nwg / NXCD, r = nwg % NXCD, xcd = wgid % NXCD, off = wgid / NXCD; wgid = (xcd < r ? xcd * (q + 1) : r * (q + 1) + (xcd - r) * q) + off; }
        const int nig = WGM * nN, gid = wgid / nig, fm = gid * WGM, gsz = (nM - fm) < WGM ? (nM - fm) : WGM;
        u.row0 = (fm + ((wgid % nig) % gsz)) * BM; u.pn = (wgid % nig) / gsz; u.half = 0; return true;
    }
};

template <class Epi> __device__ __forceinline__ auto acc_init(const Epi& E, f32x4 (&acc)[2][2][4][2], const Unit& u, int wr, int wc, int fr, int fq, int) -> decltype(E.init(acc, u, wr, wc, fr, fq), void()) { E.init(acc, u, wr, wc, fr, fq); }
template <class Epi> __device__ __forceinline__ void acc_init(const Epi&, f32x4 (&acc)[2][2][4][2], const Unit&, int, int, int, int, long) {
#pragma unroll
    for (int a = 0; a < 2; ++a)
#pragma unroll
        for (int b = 0; b < 2; ++b)
#pragma unroll
            for (int m = 0; m < 4; ++m)
#pragma unroll
                for (int n = 0; n < 2; ++n) acc[a][b][m][n] = (f32x4){0.f, 0.f, 0.f, 0.f};
}
template <class Epi, bool ALIGN_EPI = true, bool SP2 = true>
__device__ __forceinline__ void gemm_phase(LAS unsigned char* lds, const Gemm g, const StaticOrder& S_in, const Epi& E, int wave0) {
    StaticOrder S = S_in; asm volatile("" : "+s"(S.c));
    const int tid = opaque_tid(wave0), wid = __builtin_amdgcn_readfirstlane(tid >> 6), lane = tid & 63, wr = wid >> 2, wc = wid & 3, fr = lane & 15, fq = lane >> 4;
    const int K = g.K, nt = K / BK;
    unsigned voffA[2], voffB[2];
#pragma unroll
    for (int i = 0; i < 2; ++i) { int R, C; stage_rc(tid * 16 + i * 8192, R, C);
        const int Rb = epi_perm<Epi>(0) ? ((R & ~31) + perm32(R & 31)) : R;
        voffA[i] = (unsigned)(R * g.lda + C) * 2u; voffB[i] = (unsigned)(Rb * K + C) * 2u; }
    const size_t kstep = (size_t)(BK * 2);
    const size_t hstepA = (size_t)HALF * g.lda * 2, hstepB = (size_t)HALF * K * 2;
    const size_t tstepA = 2 * hstepA, tstepB = 2 * hstepB;
    const unsigned ldsw = (unsigned)wid * 1024u;
    const int aoff = lds_byte(wr * 64 + fr, fq * 8), boff = lds_byte(wc * 32 + fr, fq * 8);
#define PG8_SA(b, h) (((b) * 2 + (h)) * HTB)
#define PG8_SB(b, h) ((4 + (b) * 2 + (h)) * HTB)
#define PG8_STAGE(bufoff, gbase, voff) do { _Pragma("unroll") for (int _i = 0; _i < 2; ++_i) \
        __builtin_amdgcn_global_load_lds((const unsigned*)((const char*)(gbase) + (voff)[_i]), (LAS unsigned*)(lds + (bufoff) + ldsw + _i * 8192), 16, 0, 0); } while (0)
#define PG8_LDA(dst, b, h) do { _Pragma("unroll") for (int m = 0; m < 4; ++m) _Pragma("unroll") for (int k = 0; k < 2; ++k) dst[m][k] = *(const LAS bf16x8*)(lds + PG8_SA(b, h) + aoff + m * 2048 + k * 1024); } while (0)
#define PG8_LDB(dst, b, h) do { _Pragma("unroll") for (int n = 0; n < 2; ++n) _Pragma("unroll") for (int k = 0; k < 2; ++k) dst[n][k] = *(const LAS bf16x8*)(lds + PG8_SB(b, h) + boff + n * 2048 + k * 1024); } while (0)
#define PG8_MMA(ai, bj, At, Bt) do { __builtin_amdgcn_s_setprio(1); _Pragma("unroll") for (int m = 0; m < 4; ++m) _Pragma("unroll") for (int n = 0; n < 2; ++n) _Pragma("unroll") for (int k = 0; k < 2; ++k) \
        acc[ai][bj][m][n] = __builtin_amdgcn_mfma_f32_16x16x32_bf16(Bt[n][k], At[m][k], acc[ai][bj][m][n], 0, 0, 0); __builtin_amdgcn_s_setprio(0); } while (0)
#define PG8_WAIT_V(n) asm volatile("s_waitcnt vmcnt(" #n ")" ::: "memory")
#define PG8_WAIT_L(n) asm volatile("s_waitcnt lgkmcnt(" #n ")" ::: "memory")
#define PG8_BAR __builtin_amdgcn_s_barrier()
#define PG8_SCHED __builtin_amdgcn_sched_barrier(0)
    Unit cur, nxt; int ui = 0;
    if (!S.next(0, cur)) return;
    f32x4 acc[2][2][4][2];
    acc_init(E, acc, cur, wr, wc, fr, fq, 0);
    bf16x8 At[4][2], B0[2][2], B1[2][2];
    const char* cA = (const char*)g.A + (size_t)cur.row0 * g.lda * 2; const char* cB = (const char*)g.Bt + (size_t)cur.pn * tstepB;
    if constexpr (SP2) {
        PG8_STAGE(PG8_SB(0, 0), cB, voffB); PG8_STAGE(PG8_SB(0, 1), cB + hstepB, voffB); PG8_STAGE(PG8_SA(0, 0), cA, voffA); PG8_STAGE(PG8_SA(0, 1), cA + hstepA, voffA);
        if (wr == 1) PG8_BAR;
        PG8_WAIT_V(2); PG8_BAR;
        PG8_STAGE(PG8_SB(1, 0), cB + kstep, voffB); PG8_STAGE(PG8_SA(1, 0), cA + kstep, voffA); PG8_STAGE(PG8_SB(1, 1), cB + hstepB + kstep, voffB);
        PG8_WAIT_V(6); PG8_BAR;
    } else {
        PG8_STAGE(PG8_SB(0, 0), cB, voffB); PG8_STAGE(PG8_SA(0, 0), cA, voffA); PG8_STAGE(PG8_SB(0, 1), cB + hstepB, voffB); PG8_STAGE(PG8_SA(0, 1), cA + hstepA, voffA);
        if (wr == 1) PG8_BAR;
        PG8_WAIT_V(4); PG8_BAR;
        PG8_STAGE(PG8_SB(1, 0), cB + kstep, voffB); PG8_STAGE(PG8_SA(1, 0), cA + kstep, voffA); PG8_STAGE(PG8_SB(1, 1), cB + hstepB + kstep, voffB);
        PG8_WAIT_V(6); PG8_BAR;
    }
    for (;;) {
        const bool has_next = S.next(ui + 1, nxt);
        const char* nA = has_next ? (const char*)g.A + (size_t)nxt.row0 * g.lda * 2 : cA; const char* nB = has_next ? (const char*)g.Bt + (size_t)nxt.pn * tstepB : cB;
        for (int t = 0; t < nt; t += 2) {
            const bool last = (t == nt - 2);
            const char* a1 = cA + (size_t)(t + 1) * kstep;
            const char* a2 = last ? nA : cA + (size_t)(t + 2) * kstep; const char* b2 = last ? nB : cB + (size_t)(t + 2) * kstep;
            const char* a3 = a2 + kstep; const char* b3 = b2 + kstep;
            if constexpr (SP2) {
            PG8_LDB(B0, 0, 0); PG8_LDB(B1, 0, 1); PG8_SCHED; PG8_LDA(At, 0, 0); PG8_STAGE(PG8_SA(1, 1), a1 + hstepA, voffA);
            PG8_WAIT_V(8); PG8_WAIT_L(0); PG8_BAR; PG8_MMA(0, 0, At, B0); PG8_MMA(0, 1, At, B1); PG8_BAR; PG8_SCHED;
            if (!cur.half) PG8_LDA(At, 0, 1); PG8_STAGE(PG8_SB(0, 0), b2, voffB); PG8_STAGE(PG8_SB(0, 1), b2 + hstepB, voffB); PG8_STAGE(PG8_SA(0, 0), a2, voffA);
            PG8_WAIT_V(8); PG8_WAIT_L(0); PG8_BAR; if (!cur.half) { PG8_MMA(1, 0, At, B0); PG8_MMA(1, 1, At, B1); } PG8_BAR; PG8_SCHED;
            PG8_LDB(B0, 1, 0); PG8_LDB(B1, 1, 1); PG8_SCHED; PG8_LDA(At, 1, 0); PG8_STAGE(PG8_SA(0, 1), a2 + hstepA, voffA);
            PG8_WAIT_V(8); PG8_WAIT_L(0); PG8_BAR; PG8_MMA(0, 0, At, B0); PG8_MMA(0, 1, At, B1); PG8_BAR; PG8_SCHED;
            if (!cur.half) PG8_LDA(At, 1, 1); PG8_STAGE(PG8_SB(1, 0), b3, voffB); PG8_STAGE(PG8_SB(1, 1), b3 + hstepB, voffB); PG8_STAGE(PG8_SA(1, 0), a3, voffA);
            PG8_WAIT_V(8); PG8_WAIT_L(0); PG8_BAR; if (!cur.half) { PG8_MMA(1, 0, At, B0); PG8_MMA(1, 1, At, B1); } PG8_BAR; PG8_SCHED;
            } else {
            PG8_LDB(B0, 0, 0); PG8_SCHED; PG8_LDA(At, 0, 0); PG8_STAGE(PG8_SA(1, 1), a1 + hstepA, voffA);
            PG8_WAIT_L(8); PG8_BAR; PG8_WAIT_L(0); PG8_MMA(0, 0, At, B0); PG8_BAR; PG8_SCHED;
            PG8_LDB(B1, 0, 1); PG8_STAGE(PG8_SB(0, 0), b2, voffB);
            PG8_BAR; PG8_WAIT_L(0); PG8_MMA(0, 1, At, B1); PG8_BAR;
            if (!cur.half) PG8_LDA(At, 0, 1); PG8_STAGE(PG8_SA(0, 0), a2, voffA);
            PG8_BAR; PG8_WAIT_L(0); if (!cur.half) { PG8_MMA(1, 0, At, B0); } PG8_BAR; PG8_SCHED;
            PG8_STAGE(PG8_SB(0, 1), b2 + hstepB, voffB);
            PG8_WAIT_V(6); PG8_BAR; if (!cur.half) { PG8_MMA(1, 1, At, B1); } PG8_BAR;
            PG8_LDB(B0, 1, 0); PG8_SCHED; PG8_LDA(At, 1, 0); PG8_STAGE(PG8_SA(0, 1), a2 + hstepA, voffA);
            PG8_WAIT_L(8); PG8_BAR; PG8_WAIT_L(0); PG8_MMA(0, 0, At, B0); PG8_BAR; PG8_SCHED;
            PG8_LDB(B1, 1, 1); PG8_STAGE(PG8_SB(1, 0), b3, voffB);
            PG8_BAR; PG8_WAIT_L(0); PG8_MMA(0, 1, At, B1); PG8_BAR;
            if (!cur.half) PG8_LDA(At, 1, 1); PG8_STAGE(PG8_SA(1, 0), a3, voffA);
            PG8_BAR; PG8_WAIT_L(0); if (!cur.half) { PG8_MMA(1, 0, At, B0); } PG8_BAR; PG8_SCHED;
            PG8_STAGE(PG8_SB(1, 1), b3 + hstepB, voffB);
            PG8_WAIT_V(6); PG8_BAR; if (!cur.half) { PG8_MMA(1, 1, At, B1); } PG8_BAR;
            }
        }
        if constexpr (ALIGN_EPI) { if (wr == 0) PG8_BAR; }
        E(acc, cur, wr, wc, fr, fq);
        if (!has_next) break;
        cur = nxt; cA = nA; cB = nB; ++ui;
        acc_init(E, acc, cur, wr, wc, fr, fq, 0);
        if constexpr (ALIGN_EPI) { if (wr == 1) PG8_BAR; }
    }
    PG8_WAIT_V(0);
    if constexpr (!ALIGN_EPI) { if (wr == 0) PG8_BAR; }
    PG8_BAR;
#undef PG8_SA
#undef PG8_SB
#undef PG8_STAGE
#undef PG8_LDA
#undef PG8_LDB
#undef PG8_MMA
#undef PG8_WAIT_V
#undef PG8_WAIT_L
#undef PG8_BAR
#undef PG8_SCHED
}
}
using pg8::Unit;
typedef f32x4 Acc[2][2][4][2];

struct EpiGm {
    static constexpr bool PERM = true;
    const float* ss; bf16_t* Z; float* vss;
    __device__ __forceinline__ void operator()(Acc& acc, const Unit& u, int wr, int wc, int fr, int fq) const {
        asm volatile("" : "+v"(fr), "+v"(fq));
        const int lane_ = fq * 16 + fr; (void)lane_;
        const int rowb = u.row0 + wr * 64 + fr, colb = u.pn * 256 + wc * 32 + 8 * fq;
        float rs[8];
#pragma unroll
        for (int g = 0; g < 8; ++g) rs[g] = ss_get(ss, rowb + (g >> 2) * 128 + (g & 3) * 16);
        EPI_FENCE();
#pragma unroll
        for (int g = 0; g < 8; ++g) {
            if (u.half && g >= 4) break;
            const int ai = g >> 2, m = g & 3, row = rowb + ai * 128 + m * 16;
            const float r = __builtin_amdgcn_rsqf(rs[g] * (1.0f / 1024.0f) + EPS); float s = 0.f;
#pragma unroll
            for (int bj = 0; bj < 2; ++bj) {
                const f32x4 v0 = gelu4(acc[ai][bj][m][0] * r), v1 = gelu4(acc[ai][bj][m][1] * r);
                *(u32x4*)(Z + (size_t)row * 4096 + colb + bj * 128) = pack8(v0, v1);
                s += dot4(v0) + dot4(v1);
            }
            if (u.pn >= 8) { s = xsum16(s); s = xsum32(s); if (fq == 0) ss_add(vss, row, s); }
        }
        EPI_FENCE();
    }
};
struct EpiRes {
    static constexpr bool PERM = true;
    const bf16_t* src; bf16_t* dst; float* sso;
    __device__ __forceinline__ void init(Acc& acc, const Unit& u, int wr, int wc, int fr, int fq) const {
        asm volatile("" : "+v"(fr), "+v"(fq));
        const int rowb = u.row0 + wr * 64 + fr, colb = u.pn * 256 + wc * 32 + 8 * fq;
#pragma unroll
        for (int g = 0; g < 8; ++g) { const int ai = g >> 2, m = g & 3;
#pragma unroll
            for (int bj = 0; bj < 2; ++bj) {
                if (u.half && ai == 1) { acc[ai][bj][m][0] = (f32x4){0.f, 0.f, 0.f, 0.f}; acc[ai][bj][m][1] = (f32x4){0.f, 0.f, 0.f, 0.f}; }
                else { const u32x4 w = *(const u32x4*)(src + (size_t)(rowb + ai * 128 + m * 16) * 1024 + colb + bj * 128);
                    acc[ai][bj][m][0] = unpack4((u32x2){w.x, w.y}); acc[ai][bj][m][1] = unpack4((u32x2){w.z, w.w}); } } }
    }
    __device__ __forceinline__ void operator()(Acc& acc, const Unit& u, int wr, int wc, int fr, int fq) const {
        asm volatile("" : "+v"(fr), "+v"(fq));
        const int lane_ = fq * 16 + fr; (void)lane_;
        const int rowb = u.row0 + wr * 64 + fr, colb = u.pn * 256 + wc * 32 + 8 * fq;
#pragma unroll
        for (int g = 0; g < 8; ++g) {
            if (u.half && g >= 4) break;
            const int ai = g >> 2, m = g & 3, row = rowb + ai * 128 + m * 16;
            float s = 0.f;
#pragma unroll
            for (int bj = 0; bj < 2; ++bj) { const f32x4 v0 = acc[ai][bj][m][0], v1 = acc[ai][bj][m][1];
                *(u32x4*)(dst + (size_t)row * 1024 + colb + bj * 128) = pack8(v0, v1); s += dot4(v0) + dot4(v1); }
            s = xsum16(s); s = xsum32(s); if (fq == 0) ss_add(sso, row, s);
        }
        EPI_FENCE();
    }
};
struct EpiBf {
    static constexpr bool PERM = true;
    bf16_t* C;
    __device__ __forceinline__ void operator()(Acc& acc, const Unit& u, int wr, int wc, int fr, int fq) const {
        asm volatile("" : "+v"(fr), "+v"(fq));
        const int rowb = u.row0 + wr * 64 + fr, colb = u.pn * 256 + wc * 32 + 8 * fq;
#pragma unroll
        for (int g = 0; g < 8; ++g) { if (u.half && g >= 4) break; const int ai = g >> 2, m = g & 3, row = rowb + ai * 128 + m * 16;
#pragma unroll
            for (int bj = 0; bj < 2; ++bj) *(u32x4*)(C + (size_t)row * 1024 + colb + bj * 128) = pack8(acc[ai][bj][m][0], acc[ai][bj][m][1]); }
        EPI_FENCE();
    }
};
struct EpiPle {
    static constexpr bool PERM = true;
    const float* ss; const bf16_t* PR; const bf16_t* src; bf16_t* dstb; float* sso;
    __device__ __forceinline__ void operator()(Acc& acc, const Unit& u, int wr, int wc, int fr, int fq) const {
        asm volatile("" : "+v"(fr), "+v"(fq));
        const int lane_ = fq * 16 + fr; (void)lane_;
        const int rowb = u.row0 + wr * 64 + fr, colb = u.pn * 256 + wc * 32 + 8 * fq;
        float rs[8];
#pragma unroll
        for (int g = 0; g < 8; ++g) rs[g] = ss_get(ss, rowb + (g >> 2) * 128 + (g & 3) * 16);
        u32x4 nx[2], np[2];
#pragma unroll
        for (int bj = 0; bj < 2; ++bj) { const size_t off = (size_t)rowb * 1024 + colb + bj * 128; nx[bj] = *(const u32x4*)(src + off); np[bj] = *(const u32x4*)(PR + off); }
        EPI_FENCE();
#pragma unroll
        for (int g = 0; g < 8; ++g) {
            if (u.half && g >= 4) break;
            const int ai = g >> 2, m = g & 3, row = rowb + ai * 128 + m * 16;
            u32x4 cx[2], cp[2];
#pragma unroll
            for (int bj = 0; bj < 2; ++bj) { cx[bj] = nx[bj]; cp[bj] = np[bj]; }
            if (g < 7) { const int row2 = rowb + ((g + 1) >> 2) * 128 + ((g + 1) & 3) * 16;
#pragma unroll
                for (int bj = 0; bj < 2; ++bj) { const size_t off = (size_t)row2 * 1024 + colb + bj * 128; nx[bj] = *(const u32x4*)(src + off); np[bj] = *(const u32x4*)(PR + off); } }
            EPI_FENCE();
            const float r = __builtin_amdgcn_rsqf(rs[g] * (1.0f / 1024.0f) + EPS); float s = 0.f;
#pragma unroll
            for (int bj = 0; bj < 2; ++bj) { const size_t off = (size_t)row * 1024 + colb + bj * 128;
                const f32x4 v0 = unpack4((u32x2){cx[bj].x, cx[bj].y}) + unpack4((u32x2){cp[bj].x, cp[bj].y}) * sigmoid4(acc[ai][bj][m][0] * r);
                const f32x4 v1 = unpack4((u32x2){cx[bj].z, cx[bj].w}) + unpack4((u32x2){cp[bj].z, cp[bj].w}) * sigmoid4(acc[ai][bj][m][1] * r);
                *(u32x4*)(dstb + off) = pack8(v0, v1);
                s += dot4(v0) + dot4(v1); }
            s = xsum16(s); s = xsum32(s); if (fq == 0) ss_add(sso, row, s);
            EPI_FENCE();
        }
    }
};
struct EpiGU {
    static constexpr bool PERM = true;
    const float* ss; bf16_t* act; const float* cw; const float* cb; float* hg; float* c0; float* u0; const float* state; float* ncs;
    __device__ __forceinline__ void operator()(Acc& acc, const Unit& u, int wr, int wc, int fr, int fq) const {
        asm volatile("" : "+v"(fr), "+v"(fq));
        const int lane_ = fq * 16 + fr; (void)lane_;
        const int src1 = (fq << 4) | ((fr + 15) & 15), src2 = (fq << 4) | ((fr + 14) & 15);
        const bool samp = u.row0 >= MP;
#pragma unroll
        for (int ai = 0; ai < 2; ++ai)
#pragma unroll
            for (int m = 0; m < 4; ++m) {
                const int row = u.row0 + ai * 128 + wr * 64 + m * 16 + fr; const float rs = rstd16(ss, row);
#pragma unroll
                for (int bj = 0; bj < 2; ++bj)
#pragma unroll
                    for (int n = 0; n < 2; ++n) acc[ai][bj][m][n] = acc[ai][bj][m][n] * rs;
            }
        const int colg = u.pn * 128 + wc * 32 + 8 * fq;
        f32x4 w0[2], w1[2], w2[2], bb[2];
#pragma unroll
        for (int n = 0; n < 2; ++n) { w0[n] = *(const f32x4*)(cw + colg + 4 * n); w1[n] = *(const f32x4*)(cw + DFF + colg + 4 * n); w2[n] = *(const f32x4*)(cw + 2 * DFF + colg + 4 * n); bb[n] = *(const f32x4*)(cb + colg + 4 * n); }
#pragma unroll
        for (int ai = 0; ai < 2; ++ai)
#pragma unroll
            for (int m = 0; m < 4; ++m) {
                if (u.half && ai == 1) break;
                const int row = u.row0 + ai * 128 + wr * 64 + m * 16 + fr;
                f32x4 a2[2];
#pragma unroll
                for (int n = 0; n < 2; ++n) {
                    const f32x4 g = acc[ai][0][m][n], gp = (m > 0) ? acc[ai][0][m > 0 ? m - 1 : 0][n] : g;
                    const f32x4 t1 = (fr == 15) ? gp : g, t2 = (fr >= 14) ? gp : g;
                    f32x4 g1 = shfl4(t1, src1), g2 = shfl4(t2, src2);
                    if (samp) {
                        const int t = fr & 3, b = (row - MP) >> 2;
                        if (t == 0) { g1 = *(const f32x4*)(state + (size_t)(b * 2 + 1) * DFF + colg + 4 * n); g2 = *(const f32x4*)(state + (size_t)(b * 2) * DFF + colg + 4 * n); }
                        else if (t == 1) { g2 = *(const f32x4*)(state + (size_t)(b * 2 + 1) * DFF + colg + 4 * n); }
                        else { *(f32x4*)(ncs + (size_t)(b * 2 + t - 2) * DFF + colg + 4 * n) = g; }
                    }
                    const f32x4 conv = bb[n] + w0[n] * g2 + w1[n] * g1 + w2[n] * g;
                    const f32x4 up = acc[ai][1][m][n];
                    a2[n] = gelu4(conv) * up;
                    if (!samp) {
                        if (m == 0 && fr < 2) { const int gj = (row >> 6) * 2 + fr; f32x4 c = bb[n] + w2[n] * g; if (fr == 1) c = c + w1[n] * g1;
                            *(f32x4*)(c0 + (size_t)gj * DFF + colg + 4 * n) = c; *(f32x4*)(u0 + (size_t)gj * DFF + colg + 4 * n) = up; }
                        if (m == 3 && fr >= 14) { const int gj = (row >> 6) * 2 + (fr - 14); *(f32x4*)(hg + (size_t)gj * DFF + colg + 4 * n) = g; }
                    }
                }
                *(u32x4*)(act + (size_t)row * DFF + colg) = pack8(a2[0], a2[1]);
                EPI_FENCE();
            }
    }
};
struct EpiQKV {
    static constexpr bool PERM = true;
    const float* ss; const float* rope; bf16_t* Q; bf16_t* KB; bf16_t* VB; float* out;
    __device__ __forceinline__ void operator()(Acc& acc, const Unit& u, int wr, int wc, int fr, int fq) const {
        asm volatile("" : "+v"(fr), "+v"(fq));
        const int lane_ = fq * 16 + fr; (void)lane_;
        float rsq[8];
#pragma unroll
        for (int g = 0; g < 8; ++g) rsq[g] = ss_get(ss, u.row0 + wr * 64 + fr + (g >> 2) * 128 + (g & 3) * 16);
        EPI_FENCE();
#pragma unroll
        for (int ai = 0; ai < 2; ++ai)
#pragma unroll
            for (int m = 0; m < 4; ++m) {
                if (u.half && ai == 1) break;
                const int row = u.row0 + ai * 128 + wr * 64 + m * 16 + fr; const float rs = __builtin_amdgcn_rsqf(rsq[ai * 4 + m] * (1.0f / 1024.0f) + EPS);
                const int posidx = row < MP ? (row & (SEQ - 1)) : SEQ + (row & 3);
                f32x4 cs[2], sn[2];
#pragma unroll
                for (int n = 0; n < 2; ++n) { cs[n] = *(const f32x4*)(rope + (size_t)posidx * 16 + 4 * n); sn[n] = *(const f32x4*)(rope + (size_t)posidx * 16 + 8 + 4 * n); }
#pragma unroll
                for (int bj = 0; bj < 2; ++bj) {
                    const bool isV = (u.pn == 4) && (bj == 1);
                    f32x4 v[2];
#pragma unroll
                    for (int n = 0; n < 2; ++n) {
                        v[n] = acc[ai][bj][m][n] * rs;
                        if ((wc & 1) == 0 && !isV) {
                            const f32x4 pt = (f32x4){xpartner16(v[n][0], fq), xpartner16(v[n][1], fq), xpartner16(v[n][2], fq), xpartner16(v[n][3], fq)};
                            if (fq == 0) v[n] = v[n] * cs[n] - pt * sn[n]; else if (fq == 1) v[n] = v[n] * cs[n] + pt * sn[n];
                        }
                    }
                    const int cu = bj * 128 + wc * 32 + 8 * fq;
                    if (u.pn < 4) { *(u32x4*)(Q + (size_t)row * 1024 + u.pn * 256 + cu) = pack8(v[0] * (0.125f * LOG2E), v[1] * (0.125f * LOG2E)); }
                    else {
                        const int c2 = cu & 127; bf16_t* dst = bj == 0 ? KB : VB;
                        *(u32x4*)(dst + (size_t)row * KVD + c2) = pack8(v[0], v[1]);
                        float* fo = nullptr;
                        if (row >= MP) fo = out + (bj == 0 ? O_KS : O_VS) + (size_t)(row - MP) * KVD + c2;
                        else if ((row & (SEQ - 1)) >= SEQ - 128) fo = out + (bj == 0 ? O_NKP : O_NVP) + (size_t)((row >> 13) * 128 + (row & (SEQ - 1)) - (SEQ - 128)) * KVD + c2;
                        if (fo) { *(f32x4*)fo = v[0]; *(f32x4*)(fo + 4) = v[1]; }
                    }
                }
                EPI_FENCE();
            }
    }
};

struct Params {
    const float *x_prompt, *x_sample, *state, *cache_k, *cache_v, *p_prompt, *p_sample, *norm_mix, *gm_w_in, *gm_v_norm, *gm_w_s, *gm_b_s, *gm_w_out, *kv_norm, *w_kv, *w_q, *sinks, *w_o,
        *norm_ffn, *w_gate, *w_up, *conv_w, *conv_b, *w_down, *ple_norm, *ple_w_gate, *ple_w_proj, *final_norm;
    float* out; unsigned char* ws;
};

constexpr int PARAM_OFF = 131072 + 1024;
__device__ __forceinline__ unsigned long long ldq(const LAS unsigned char* pbase, int i) {
    const unsigned long long v = ((const LAS unsigned long long*)pbase)[i];
    const unsigned lo = __builtin_amdgcn_readfirstlane((unsigned)v), hi = __builtin_amdgcn_readfirstlane((unsigned)(v >> 32));
    return ((unsigned long long)hi << 32) | lo;
}
__device__ __forceinline__ Params load_params(LAS unsigned char* lds) {
    Params p;
    unsigned poff = PARAM_OFF; asm volatile("" : "+v"(poff));
    const LAS unsigned char* pb = lds + poff;
    p.x_prompt = (decltype(p.x_prompt))(__attribute__((address_space(1))) float*)ldq(pb, 0);
    p.x_sample = (decltype(p.x_sample))(__attribute__((address_space(1))) float*)ldq(pb, 1);
    p.state = (decltype(p.state))(__attribute__((address_space(1))) float*)ldq(pb, 2);
    p.cache_k = (decltype(p.cache_k))(__attribute__((address_space(1))) float*)ldq(pb, 3);
    p.cache_v = (decltype(p.cache_v))(__attribute__((address_space(1))) float*)ldq(pb, 4);
    p.p_prompt = (decltype(p.p_prompt))(__attribute__((address_space(1))) float*)ldq(pb, 5);
    p.p_sample = (decltype(p.p_sample))(__attribute__((address_space(1))) float*)ldq(pb, 6);
    p.norm_mix = (decltype(p.norm_mix))(__attribute__((address_space(1))) float*)ldq(pb, 7);
    p.gm_w_in = (decltype(p.gm_w_in))(__attribute__((address_space(1))) float*)ldq(pb, 8);
    p.gm_v_norm = (decltype(p.gm_v_norm))(__attribute__((address_space(1))) float*)ldq(pb, 9);
    p.gm_w_s = (decltype(p.gm_w_s))(__attribute__((address_space(1))) float*)ldq(pb, 10);
    p.gm_b_s = (decltype(p.gm_b_s))(__attribute__((address_space(1))) float*)ldq(pb, 11);
    p.gm_w_out = (decltype(p.gm_w_out))(__attribute__((address_space(1))) float*)ldq(pb, 12);
    p.kv_norm = (decltype(p.kv_norm))(__attribute__((address_space(1))) float*)ldq(pb, 13);
    p.w_kv = (decltype(p.w_kv))(__attribute__((address_space(1))) float*)ldq(pb, 14);
    p.w_q = (decltype(p.w_q))(__attribute__((address_space(1))) float*)ldq(pb, 15);
    p.sinks = (decltype(p.sinks))(__attribute__((address_space(1))) float*)ldq(pb, 16);
    p.w_o = (decltype(p.w_o))(__attribute__((address_space(1))) float*)ldq(pb, 17);
    p.norm_ffn = (decltype(p.norm_ffn))(__attribute__((address_space(1))) float*)ldq(pb, 18);
    p.w_gate = (decltype(p.w_gate))(__attribute__((address_space(1))) float*)ldq(pb, 19);
    p.w_up = (decltype(p.w_up))(__attribute__((address_space(1))) float*)ldq(pb, 20);
    p.conv_w = (decltype(p.conv_w))(__attribute__((address_space(1))) float*)ldq(pb, 21);
    p.conv_b = (decltype(p.conv_b))(__attribute__((address_space(1))) float*)ldq(pb, 22);
    p.w_down = (decltype(p.w_down))(__attribute__((address_space(1))) float*)ldq(pb, 23);
    p.ple_norm = (decltype(p.ple_norm))(__attribute__((address_space(1))) float*)ldq(pb, 24);
    p.ple_w_gate = (decltype(p.ple_w_gate))(__attribute__((address_space(1))) float*)ldq(pb, 25);
    p.ple_w_proj = (decltype(p.ple_w_proj))(__attribute__((address_space(1))) float*)ldq(pb, 26);
    p.final_norm = (decltype(p.final_norm))(__attribute__((address_space(1))) float*)ldq(pb, 27);
    p.out = (decltype(p.out))(__attribute__((address_space(1))) float*)ldq(pb, 28);
    p.ws = (decltype(p.ws))(__attribute__((address_space(1))) unsigned char*)ldq(pb, 29);
    return p;
}
__device__ __forceinline__ void tr_item(const float* W, int K, int N, bf16_t* WT, const float* scale, int mode, int row_off, LAS float* scr, int item, int lane) {
    const int nblk = N / 32, kb = item / nblk, nb = item % nblk, k0 = 64 * kb, n0 = 32 * nb;
#pragma unroll 16
    for (int i = 0; i < 32; ++i) { const int kk = 2 * i + (lane >> 5); float w = W[(size_t)(k0 + kk) * N + n0 + (lane & 31)]; if (scale) w *= scale[k0 + kk]; scr[kk * 33 + (lane & 31)] = w; }
    asm volatile("s_waitcnt lgkmcnt(0)" ::: "memory");
    const int c = lane & 7;
    const int drow0 = mode == 0 ? row_off + n0 : ((n0 >> 7) * 256 + (mode == 2 ? 128 : 0) + (n0 & 127));
#pragma unroll
    for (int j = 0; j < 4; ++j) { const int n = (lane >> 3) + 8 * j; const LAS float* s = scr + (8 * c) * 33 + n;
        u32x4 o; o.x = cvt_pk_bf16(s[0 * 33], s[1 * 33]); o.y = cvt_pk_bf16(s[2 * 33], s[3 * 33]); o.z = cvt_pk_bf16(s[4 * 33], s[5 * 33]); o.w = cvt_pk_bf16(s[6 * 33], s[7 * 33]);
        *(u32x4*)(WT + (size_t)(drow0 + n) * K + k0 + 8 * c) = o; }
    asm volatile("s_waitcnt lgkmcnt(0)" ::: "memory");
}

__device__ __forceinline__ void conv_stage(LAS unsigned char* lds, int stage, int T, int wave0) {
    if ((int)blockIdx.x < T) return;
    const Params P = load_params(lds);
    const int tid = opaque_tid(wave0), lane = tid & 63, wave = tid >> 6;
    unsigned char* ws = P.ws;
    LAS float* scr = (LAS float*)(lds + wave * 16384);
    const int gw = ((int)blockIdx.x - T) * 8 + wave, NGW = (256 - T) * 8;
    const int nitems = stage == 0 ? 2048 : stage == 1 ? 1024 + 1408 : stage == 2 ? 1408 + 1408 + 512 + 128 : stage == 3 ? 512 + 128 + 512 : stage == 4 ? 512 + 128 : stage == 5 ? 1408 : stage == 7 ? 1408 : stage == 8 ? 1408 : 0;
    for (int it = gw; it < nitems; it += NGW) {
        int r = it; const float* W; int K, N; bf16_t* WT; const float* sc; int mode = 0, roff = 0;
        if (stage == 0) { W = P.gm_w_in; K = 1024; N = 4096; WT = (bf16_t*)(ws + WS_WIN); sc = P.norm_mix; }
        else if (stage == 1) {
            if (r < 1024) { W = P.gm_w_out; K = 2048; N = 1024; WT = (bf16_t*)(ws + WS_WOUT); sc = nullptr; }
            else { r -= 1024; W = P.w_gate; K = 1024; N = DFF; WT = (bf16_t*)(ws + WS_WGU0); sc = P.norm_ffn; mode = 1; }
        } else if (stage == 2) {
            if (r < 1408) { W = P.w_up; K = 1024; N = DFF; WT = (bf16_t*)(ws + WS_WGU0); sc = P.norm_ffn; mode = 2; }
            else if (r < 2816) { r -= 1408; W = P.w_down; K = DFF; N = 1024; WT = (bf16_t*)(ws + WS_WD0); sc = nullptr; }
            else if (r < 2816 + 512) { r -= 2816; W = P.ple_w_gate; K = 1024; N = 1024; WT = (bf16_t*)(ws + WS_WPG0); sc = P.ple_norm; }
            else { r -= 2816 + 512; W = P.ple_w_proj; K = 256; N = 1024; WT = (bf16_t*)(ws + WS_WPP0); sc = nullptr; }
        } else if (stage == 3) {
            if (r < 512) { W = P.w_q; K = 1024; N = 1024; WT = (bf16_t*)(ws + WS_WQKV); sc = P.norm_mix + 1024; }
            else if (r < 512 + 128) { r -= 512; W = P.w_kv; K = 1024; N = 256; WT = (bf16_t*)(ws + WS_WQKV); sc = P.kv_norm; roff = 1024; }
            else { r -= 512 + 128; W = P.w_o; K = 1024; N = 1024; WT = (bf16_t*)(ws + WS_WO); sc = nullptr; }
        } else if (stage == 4) {
            if (r < 512) { W = P.ple_w_gate + 1024 * 1024; K = 1024; N = 1024; WT = (bf16_t*)(ws + WS_WPG0 + 2 * MiB); sc = P.ple_norm + 1024; }
            else { r -= 512; W = P.ple_w_proj + 256 * 1024; K = 256; N = 1024; WT = (bf16_t*)(ws + WS_WPP0 + 512 * 1024); sc = nullptr; }
        } else if (stage == 7) { W = P.w_gate + (size_t)1024 * DFF; K = 1024; N = DFF; WT = (bf16_t*)(ws + WS_WGU0 + 11 * MiB); sc = P.norm_ffn + 1024; mode = 1; }
        else if (stage == 8) { W = P.w_up + (size_t)1024 * DFF; K = 1024; N = DFF; WT = (bf16_t*)(ws + WS_WGU0 + 11 * MiB); sc = P.norm_ffn + 1024; mode = 2; }
        else { W = P.w_down + (size_t)DFF * 1024; K = DFF; N = 1024; WT = (bf16_t*)(ws + WS_WD0 + 5632 * 1024); sc = nullptr; }
        tr_item(W, K, N, WT, sc, mode, roff, scr, r, lane);
    }
    if (stage == 0) {
        bf16_t* XBA = (bf16_t*)(ws + WS_XBA); float* SSA = (float*)(ws + WS_SSA);
        for (int m = gw; m < MT; m += 2 * NGW) {
            const int m2 = m + NGW; const bool has2 = m2 < MT; const int mb = has2 ? m2 : m;
            const float* src = m < MP ? P.x_prompt + (size_t)m * DM : P.x_sample + (size_t)(m - MP) * DM;
            const float* src2 = mb < MP ? P.x_prompt + (size_t)mb * DM : P.x_sample + (size_t)(mb - MP) * DM;
            f32x4 va[4], vb[4];
#pragma unroll
            for (int j = 0; j < 2; ++j) { va[2 * j] = *((const f32x4*)src + 128 * j + 2 * lane); va[2 * j + 1] = *((const f32x4*)src + 128 * j + 2 * lane + 1); vb[2 * j] = *((const f32x4*)src2 + 128 * j + 2 * lane); vb[2 * j + 1] = *((const f32x4*)src2 + 128 * j + 2 * lane + 1); }
            float s = 0.f, s2 = 0.f;
#pragma unroll
            for (int j = 0; j < 2; ++j) { s += dot4(va[2 * j]) + dot4(va[2 * j + 1]); s2 += dot4(vb[2 * j]) + dot4(vb[2 * j + 1]);
                *((u32x4*)(XBA + (size_t)m * DM) + 64 * j + lane) = pack8(va[2 * j], va[2 * j + 1]); if (has2) *((u32x4*)(XBA + (size_t)m2 * DM) + 64 * j + lane) = pack8(vb[2 * j], vb[2 * j + 1]); }
            s = wave_sum(s, lane); s2 = wave_sum(s2, lane);
            if (lane == 0) { ss_set(SSA, m, s); ss_set((float*)(ws + WS_SSB), m, 0.f); ss_set((float*)(ws + WS_VSS), m, 0.f); if (has2) { ss_set(SSA, m2, s2); ss_set((float*)(ws + WS_SSB), m2, 0.f); ss_set((float*)(ws + WS_VSS), m2, 0.f); } }
        }
        const int gt = blockIdx.x * 512 + tid, NGT = 256 * 512;
        bf16_t* WTT = (bf16_t*)(ws + WS_WTRIL);
        for (int i = gt; i < 8 * 128 * 128 / 2; i += NGT) { const int e = 2 * i, sx = e & 127, t = (e >> 7) & 127;
            const float a = sx <= t ? P.gm_w_s[e] : 0.f, b = (sx + 1) <= t ? P.gm_w_s[e + 1] : 0.f; ((unsigned*)WTT)[i] = cvt_pk_bf16(a, b); }
        float* rope = (float*)(ws + WS_ROPE);
        for (int i = gt; i < 8196 * 8; i += NGT) { const int pi = i >> 3, f = i & 7; const int pos = pi < SEQ ? pi : 16384 + (pi - SEQ);
            const float inv = __builtin_powf(500000.0f, -(float)f * 0.125f); const float ang = (float)pos * inv;
            double rev = (double)ang * 0.15915494309189535; rev -= __builtin_rint(rev); const float rf = (float)rev;
            rope[pi * 16 + f] = __builtin_amdgcn_cosf(rf); rope[pi * 16 + 8 + f] = __builtin_amdgcn_sinf(rf); }
    }
    if (stage == 4 || stage == 6) {
        const int L = stage == 6 ? 1 : 0;
        bf16_t* PB = (bf16_t*)(ws + WS_PB) + (size_t)L * MT * PLE;
        for (int m0 = gw; m0 < MT; m0 += 4 * NGW) {
            f32x4 v[4];
#pragma unroll
            for (int q = 0; q < 4; ++q) { const int m = m0 + q * NGW < MT ? m0 + q * NGW : m0;
                const float* src = m < MP ? P.p_prompt + ((size_t)L * MP + m) * PLE : P.p_sample + ((size_t)L * MS + (m - MP)) * PLE; v[q] = *((const f32x4*)src + lane); }
#pragma unroll
            for (int q = 0; q < 4; ++q) { const int m = m0 + q * NGW; if (m < MT) *((u32x2*)(PB + (size_t)m * PLE) + lane) = pack4(v[q]); }
        }
    }
}

__device__ __forceinline__ void gating_phase(LAS unsigned char* lds, int G, int wave0) {
    const Params P = load_params(lds);
    const int tid = opaque_tid(wave0), lane = tid & 63, wave = tid >> 6, fr = lane & 15, fq = lane >> 4;
    unsigned char* ws = P.ws;
    bf16_t* Z = (bf16_t*)(ws + WS_Z); const float* VSS = (const float*)(ws + WS_VSS); const bf16_t* WTR = (const bf16_t*)(ws + WS_WTRIL);
    LAS bf16_t* Vs = (LAS bf16_t*)lds;
    LAS float* rsb = (LAS float*)(lds + 128 * 264 * 2);
    LAS bf16_t* Wsl = (LAS bf16_t*)(lds + 69632);
    LAS float* vws = (LAS float*)(lds + 69632 + 128 * 136 * 2);
    LAS float* bsl = vws + 256;
    { const int g0 = (int)blockIdx.x & 7;
      for (int i = tid; i < 2048; i += 512) { const int row = i >> 4, c8 = (i & 15) * 8; *(LAS u32x4*)(Wsl + row * 136 + c8) = *(const u32x4*)(WTR + (size_t)(g0 * 128 + row) * 128 + c8); }
      if (tid < 64) *(LAS f32x4*)(vws + 4 * tid) = *(const f32x4*)(P.gm_v_norm + 256 * g0 + 4 * tid);
      else if (tid < 96) *(LAS f32x4*)(bsl + 4 * (tid - 64)) = *(const f32x4*)(P.gm_b_s + 128 * g0 + 4 * (tid - 64)); }
    u32x4 raw[8]; float rsn[8];
#define GATE_FETCH(un) do { const int ch_ = (un) >> 3, g_ = (un) & 7; _Pragma("unroll") for (int j = 0; j < 8; ++j) { const int idx = tid + 512 * j, r = idx >> 5, c8 = (idx & 31) * 8; \
        raw[j] = *(const u32x4*)(Z + (size_t)(ch_ * 128 + r) * 4096 + 2048 + 256 * g_ + c8); rsn[j] = ss_get(VSS, ch_ * 128 + r); } } while (0)
    if ((int)blockIdx.x < 2048) GATE_FETCH(blockIdx.x);
    __syncthreads();
    for (int unit = blockIdx.x; unit < 2048; unit += G) {
        const int ch = unit >> 3, g = unit & 7, row0 = ch * 128;
#pragma unroll
        for (int j = 0; j < 8; ++j) { const int idx = tid + 512 * j, r = idx >> 5, c8 = (idx & 31) * 8;
            const f32x4 wa = *(const LAS f32x4*)(vws + c8), wb = *(const LAS f32x4*)(vws + c8 + 4);
            const float rs = __builtin_amdgcn_rsqf(rsn[j] * (1.0f / 2048.0f) + EPS);
            const u32x4 rw = raw[j]; u32x4 o;
            o.x = cvt_pk_bf16(bf2f(rw.x & 0xffffu) * rs * wa[0], bf2f(rw.x >> 16) * rs * wa[1]);
            o.y = cvt_pk_bf16(bf2f(rw.y & 0xffffu) * rs * wa[2], bf2f(rw.y >> 16) * rs * wa[3]);
            o.z = cvt_pk_bf16(bf2f(rw.z & 0xffffu) * rs * wb[0], bf2f(rw.z >> 16) * rs * wb[1]);
            o.w = cvt_pk_bf16(bf2f(rw.w & 0xffffu) * rs * wb[2], bf2f(rw.w >> 16) * rs * wb[3]);
            *(LAS u32x4*)(Vs + r * 264 + c8) = o; }
        __syncthreads();
        if (unit + G < 2048) GATE_FETCH(unit + G);
        bf16x8 vf[4][2];
#pragma unroll
        for (int ks = 0; ks < 4; ++ks)
#pragma unroll
            for (int nt = 0; nt < 2; ++nt)
#pragma unroll
                for (int j = 0; j < 8; ++j) vf[ks][nt][j] = (short)Vs[(32 * ks + 8 * fq + j) * 264 + 32 * wave + 8 * (fr >> 2) + 4 * nt + (fr & 3)];
        u32x4 uu[8];
#pragma unroll
        for (int mt = 0; mt < 8; ++mt) uu[mt] = *(const u32x4*)(Z + (size_t)(row0 + 16 * mt + fr) * 4096 + 256 * g + 32 * wave + 8 * fq);
#pragma unroll
        for (int mt = 0; mt < 8; ++mt) {
            f32x4 a2[2] = {(f32x4){0.f, 0.f, 0.f, 0.f}, (f32x4){0.f, 0.f, 0.f, 0.f}};
#pragma unroll
            for (int ks = 0; ks < 4; ++ks) if (32 * ks <= 16 * mt + 15) {
                const bf16x8 wf = *(const LAS bf16x8*)(Wsl + (16 * mt + fr) * 136 + 32 * ks + 8 * fq);
#pragma unroll
                for (int nt = 0; nt < 2; ++nt) a2[nt] = __builtin_amdgcn_mfma_f32_16x16x32_bf16(vf[ks][nt], wf, a2[nt], 0, 0, 0);
            }
            const int t = 16 * mt + fr; const float bias = bsl[t];
            *(u32x4*)(Z + (size_t)(row0 + t) * 4096 + 256 * g + 32 * wave + 8 * fq) = pack8(unpack4((u32x2){uu[mt].x, uu[mt].y}) * (a2[0] + bias), unpack4((u32x2){uu[mt].z, uu[mt].w}) * (a2[1] + bias));
        }
        __syncthreads();
    }
#undef GATE_FETCH
    float* gmv = P.out + O_GMV;
    for (int b = blockIdx.x; b < 128; b += G) {
        const int row0 = MP + 4 * b;
        if (tid < 4) rsb[tid] = __builtin_amdgcn_rsqf(ss_get(VSS, row0 + tid) * (1.0f / 2048.0f) + EPS);
        __syncthreads();
        const int c = 4 * tid, g = c >> 8;
        const f32x4 vw = *(const f32x4*)(P.gm_v_norm + c);
        f32x4 v[4];
#pragma unroll
        for (int s = 0; s < 4; ++s) { v[s] = unpack4(*(const u32x2*)(Z + (size_t)(row0 + s) * 4096 + 2048 + c)) * rsb[s] * vw; *(f32x4*)(gmv + (size_t)(4 * b + s) * GH + c) = v[s]; }
#pragma unroll
        for (int t = 0; t < 4; ++t) { const float bias = P.gm_b_s[g * 128 + t]; f32x4 mx = (f32x4){bias, bias, bias, bias};
#pragma unroll
            for (int s = 0; s <= t; ++s) mx = mx + v[s] * P.gm_w_s[(g * 128 + t) * 128 + s];
            bf16_t* zp = Z + (size_t)(row0 + t) * 4096 + c; *(u32x2*)zp = pack4(unpack4(*(const u32x2*)zp) * mx); }
        __syncthreads();
    }
}

__device__ __forceinline__ void fixup_phase(LAS unsigned char* lds, int L, int G, int wave0) {
    const Params P = load_params(lds);
    unsigned char* ws = P.ws;
    const f32x4* HG = (const f32x4*)(ws + WS_HG); const f32x4* C0 = (const f32x4*)(ws + WS_C0); const f32x4* U0 = (const f32x4*)(ws + WS_U0);
    bf16_t* ACT = (bf16_t*)(ws + WS_Z);
    const f32x4* cw = (const f32x4*)(P.conv_w + (size_t)L * 3 * DFF);
    const int gt = blockIdx.x * 512 + opaque_tid(wave0), NGT = G * 512;
    constexpr int NIT = 1024 * 704;
    for (int idx0 = gt; idx0 < NIT; idx0 += 3 * NGT) {
        f32x4 cv[3], up[3], h0[3], h1[3], w0[3], w1[3]; int rr[3], cc[3], jj[3]; bool hz[3], ok[3];
#pragma unroll
        for (int q = 0; q < 3; ++q) { const int idx = idx0 + q * NGT; ok[q] = idx < NIT; const int ic = ok[q] ? idx : idx0;
            const int gj = ic / 704, c4 = ic % 704, grp = gj >> 1, j = gj & 1, gp = grp > 0 ? grp - 1 : 0;
            rr[q] = 64 * grp + j; cc[q] = c4; jj[q] = j; hz[q] = (grp & 127) != 0;
            cv[q] = C0[ic]; up[q] = U0[ic]; h0[q] = HG[(size_t)(gp * 2) * 704 + c4]; h1[q] = HG[(size_t)(gp * 2 + 1) * 704 + c4]; w0[q] = cw[c4]; w1[q] = cw[704 + c4]; }
#pragma unroll
        for (int q = 0; q < 3; ++q) if (ok[q]) {
            f32x4 conv = cv[q];
            if (hz[q]) conv = conv + (jj[q] == 0 ? (w0[q] * h0[q] + w1[q] * h1[q]) : (w0[q] * h1[q]));
            *(u32x2*)(ACT + (size_t)rr[q] * DFF + 4 * cc[q]) = pack4(gelu4(conv) * up[q]); }
    }
    for (int i = gt; i < MT; i += NGT) { ((unsigned*)(ws + WS_SSA))[i] = 0u; ((unsigned*)(ws + WS_SSB))[i] = 0u; }
    f32x4* ncp = (f32x4*)(P.out + O_NCP + (size_t)L * 4 * 2 * DFF);
    for (int idx = gt; idx < 8 * 704; idx += NGT) { const int bj = idx / 704, c4 = idx % 704, b = bj >> 1, j = bj & 1; ncp[idx] = HG[(size_t)((128 * b + 127) * 2 + j) * 704 + c4]; }
}

template <int PAR> __device__ __forceinline__ float attn_softmax(f32x4 (&S)[10], bool fastp, bool samp, int qb, int qi, int kt0, int fq, int dq, float sink) {
    float mx = sink;
    if (fastp) {
#pragma unroll
        for (int i = 0; i < 10; ++i) { const int c = i - PAR;
            if (c < 0 || c > 8) continue;
#pragma unroll
            for (int j = 0; j < 4; ++j) {
                if (c == 0) { if (!(dq + j > 0)) S[i][j] = -1e30f; }
                else if (c == 8) { if (!(dq + j <= 0)) S[i][j] = -1e30f; }
                mx = fmaxf(mx, S[i][j]); } }
    } else {
#pragma unroll
        for (int i = 0; i < 10; ++i)
#pragma unroll
            for (int j = 0; j < 4; ++j) { const int kw = 16 * (kt0 + i) + 4 * fq + j;
                const bool vis = (kw > qi) && (kw <= qi + 128) && (samp ? (kw < 132) : (qb > 0 || kw >= 128));
                const float sv = vis ? S[i][j] : -1e30f; S[i][j] = sv; mx = fmaxf(mx, sv); }
    }
    mx = xmax16(mx); mx = xmax32(mx);
    float sum = 0.f;
#pragma unroll
    for (int i = 0; i < 10; ++i) { const int c = i - PAR;
        if (fastp && (c < 0 || c > 8)) { S[i] = (f32x4){0.f, 0.f, 0.f, 0.f}; continue; }
#pragma unroll
        for (int j = 0; j < 4; ++j) { const float e = __builtin_amdgcn_exp2f(S[i][j] - mx); S[i][j] = e; sum += e; } }
    sum = xsum16(sum); sum = xsum32(sum);
    return 1.0f / (sum + __builtin_amdgcn_exp2f(sink - mx));
}
__device__ __forceinline__ bf16x8 attn_pfrag(const f32x4& a, const f32x4& b, float inv) {
    const f32x4 p0 = a * inv, p1 = b * inv;
    const u32x4 pw = (u32x4){cvt_pk_bf16(p0[0], p0[1]), cvt_pk_bf16(p0[2], p0[3]), cvt_pk_bf16(p1[0], p1[1]), cvt_pk_bf16(p1[2], p1[3])};
    return __builtin_bit_cast(bf16x8, pw);
}
__device__ __forceinline__ void attn_phase(LAS unsigned char* lds, int G, int wave0, int odummy) {
    const Params P = load_params(lds);
    const int tid = opaque_tid(wave0), lane = tid & 63, wave = tid >> 6, fr = lane & 15, fq = lane >> 4;
    unsigned char* ws = P.ws;
    bf16_t* Q = (bf16_t*)(ws + WS_Z + 195 * MiB); bf16_t* Oout = odummy ? (bf16_t*)(ws + WS_Z + 130 * MiB) : Q; const bf16_t* KB = (const bf16_t*)(ws + WS_KB); const bf16_t* VB = (const bf16_t*)(ws + WS_VB);
    LAS bf16_t* Ks = (LAS bf16_t*)lds;
    LAS bf16_t* VTs = (LAS bf16_t*)(lds + 256 * 72 * 2);
    for (int i = blockIdx.x * 512 + tid; i < MT; i += G * 512) ((unsigned*)(ws + WS_SSB))[i] = 0u;
    for (int unit = blockIdx.x; unit < 768; unit += G) {
        const bool samp = unit >= 512;
        const int kvh = unit & 1;
        int b, qb;
        if (!samp) { b = unit >> 7; qb = (unit >> 1) & 63; } else { b = (unit - 512) >> 1; qb = 1; }
#pragma unroll
        for (int j = 0; j < 4; ++j) {
            const int idx = tid + 512 * j, r = idx >> 3, c8 = (idx & 7) * 8;
            u32x4 kv = (u32x4){0u, 0u, 0u, 0u}, vv = (u32x4){0u, 0u, 0u, 0u};
            if (!samp) { const int t = 128 * (qb - 1) + r; if (t >= 0) { const size_t go = (size_t)(b * SEQ + t) * KVD + kvh * 64 + c8; kv = *(const u32x4*)(KB + go); vv = *(const u32x4*)(VB + go); } }
            else if (r < 128) { const size_t go = ((size_t)(b * 128 + r) * 2 + kvh) * 64 + c8;
                const f32x4 k0 = *(const f32x4*)(P.cache_k + go), k1 = *(const f32x4*)(P.cache_k + go + 4), v0 = *(const f32x4*)(P.cache_v + go), v1 = *(const f32x4*)(P.cache_v + go + 4);
                kv = (u32x4){cvt_pk_bf16(k0[0], k0[1]), cvt_pk_bf16(k0[2], k0[3]), cvt_pk_bf16(k1[0], k1[1]), cvt_pk_bf16(k1[2], k1[3])};
                vv = (u32x4){cvt_pk_bf16(v0[0], v0[1]), cvt_pk_bf16(v0[2], v0[3]), cvt_pk_bf16(v1[0], v1[1]), cvt_pk_bf16(v1[2], v1[3])}; }
            else if (r < 132) { const size_t go = (size_t)(MP + 4 * b + (r - 128)) * KVD + kvh * 64 + c8; kv = *(const u32x4*)(KB + go); vv = *(const u32x4*)(VB + go); }
            *(LAS u32x4*)(Ks + r * 72 + c8) = kv;
            const int sp = r & 31, kk = (r & ~31) + 8 * ((sp & 15) >> 2) + 4 * (sp >> 4) + (sp & 3);
            LAS bf16_t* vt = VTs + c8 * 264 + kk;
            vt[0 * 264] = (bf16_t)(vv.x & 0xffffu); vt[1 * 264] = (bf16_t)(vv.x >> 16); vt[2 * 264] = (bf16_t)(vv.y & 0xffffu); vt[3 * 264] = (bf16_t)(vv.y >> 16);
            vt[4 * 264] = (bf16_t)(vv.z & 0xffffu); vt[5 * 264] = (bf16_t)(vv.z >> 16); vt[6 * 264] = (bf16_t)(vv.w & 0xffffu); vt[7 * 264] = (bf16_t)(vv.w >> 16);
        }
        __syncthreads();
        const int lane_ = lane; const int h = kvh * 8 + wave; const float sink = P.sinks[h] * LOG2E;
        const int nrt = samp ? 1 : 8;
        const bool fastp = !samp && qb > 0;
        const int dq = 4 * fq - fr;
#pragma unroll 1
        for (int rt2 = 0; rt2 < nrt; rt2 += 2) {
            const bool two = !samp;
            const int rowq0 = samp ? (MP + 4 * b + (fr & 3)) : (b * SEQ + qb * 128 + rt2 * 16 + fr), rowq1 = rowq0 + (two ? 16 : 0);
            const int qi0 = samp ? fr : 16 * rt2 + fr, qi1 = qi0 + 16;
            const int kt0 = samp ? 0 : rt2;
            bf16x8 qA[2], qB[2];
#pragma unroll
            for (int k = 0; k < 2; ++k) { qA[k] = *(const bf16x8*)(Q + (size_t)rowq0 * 1024 + h * 64 + 32 * k + 8 * fq); qB[k] = *(const bf16x8*)(Q + (size_t)rowq1 * 1024 + h * 64 + 32 * k + 8 * fq); }
            f32x4 SA[10], SB[10];
#pragma unroll
            for (int i = 0; i < 10; ++i) { f32x4 a = (f32x4){0.f, 0.f, 0.f, 0.f}, c2 = (f32x4){0.f, 0.f, 0.f, 0.f};
                const bool needA = !(fastp && i > 8), needB = two && !(fastp && i < 1);
#pragma unroll
                for (int k = 0; k < 2; ++k) { const bf16x8 kf = *(const LAS bf16x8*)(Ks + (16 * (kt0 + i) + fr) * 72 + 32 * k + 8 * fq);
                    if (needA) a = __builtin_amdgcn_mfma_f32_16x16x32_bf16(kf, qA[k], a, 0, 0, 0);
                    if (needB) c2 = __builtin_amdgcn_mfma_f32_16x16x32_bf16(kf, qB[k], c2, 0, 0, 0); }
                SA[i] = a; SB[i] = c2; }
            const float invA = attn_softmax<0>(SA, fastp, samp, qb, qi0, kt0, fq, dq, sink);
            float invB = 0.f;
            if (two) invB = attn_softmax<1>(SB, fastp, samp, qb, qi1, kt0, fq, dq, sink);
            f32x4 oA[4] = {(f32x4){0.f, 0.f, 0.f, 0.f}, (f32x4){0.f, 0.f, 0.f, 0.f}, (f32x4){0.f, 0.f, 0.f, 0.f}, (f32x4){0.f, 0.f, 0.f, 0.f}};
            f32x4 oB[4] = {(f32x4){0.f, 0.f, 0.f, 0.f}, (f32x4){0.f, 0.f, 0.f, 0.f}, (f32x4){0.f, 0.f, 0.f, 0.f}, (f32x4){0.f, 0.f, 0.f, 0.f}};
#pragma unroll
            for (int i = 0; i < 5; ++i) {
                const bf16x8 pA = attn_pfrag(SA[2 * i], SA[2 * i + 1], invA), pB = attn_pfrag(SB[2 * i], SB[2 * i + 1], invB);
#pragma unroll
                for (int dt = 0; dt < 4; ++dt) { const bf16x8 vfr = *(const LAS bf16x8*)(VTs + (32 * (dt >> 1) + 8 * (fr >> 2) + 4 * (dt & 1) + (fr & 3)) * 264 + 32 * ((kt0 >> 1) + i) + 8 * fq);
                    oA[dt] = __builtin_amdgcn_mfma_f32_16x16x32_bf16(vfr, pA, oA[dt], 0, 0, 0);
                    if (two) oB[dt] = __builtin_amdgcn_mfma_f32_16x16x32_bf16(vfr, pB, oB[dt], 0, 0, 0); }
            }
            if (!samp || fr < 4) {
#pragma unroll
                for (int dp = 0; dp < 2; ++dp) *(u32x4*)(Oout + (size_t)rowq0 * 1024 + h * 64 + 32 * dp + 8 * fq) = pack8(oA[2 * dp], oA[2 * dp + 1]);
            }
            if (two) {
#pragma unroll
                for (int dp = 0; dp < 2; ++dp) *(u32x4*)(Oout + (size_t)rowq1 * 1024 + h * 64 + 32 * dp + 8 * fq) = pack8(oB[2 * dp], oB[2 * dp + 1]);
            }
        }
        __syncthreads();
    }
}

__device__ __forceinline__ void final_phase(LAS unsigned char* lds, int G, int wave0) {
    const Params P = load_params(lds);
    const int tid = opaque_tid(wave0), lane = tid & 63, wave = tid >> 6;
    const float* SSB = (const float*)(P.ws + WS_SSB);
    const bf16_t* XB = (const bf16_t*)(P.ws + WS_Z + 130 * MiB);
    const int gw = blockIdx.x * 8 + wave, NGW = G * 8;
    f32x4 w[4];
#pragma unroll
    for (int j = 0; j < 2; ++j) { w[2 * j] = *((const f32x4*)P.final_norm + 128 * j + 2 * lane); w[2 * j + 1] = *((const f32x4*)P.final_norm + 128 * j + 2 * lane + 1); }
    for (int m = gw; m < MT; m += 2 * NGW) {
        const int m2 = m + NGW < MT ? m + NGW : m;
        const float rs = rstd16(SSB, m), rs2 = rstd16(SSB, m2);
        u32x4 a[2], b[2];
#pragma unroll
        for (int j = 0; j < 2; ++j) { a[j] = *((const u32x4*)(XB + (size_t)m * DM) + 64 * j + lane); b[j] = *((const u32x4*)(XB + (size_t)m2 * DM) + 64 * j + lane); }
        f32x4* yr = (f32x4*)(P.out + (size_t)m * DM); f32x4* yr2 = (f32x4*)(P.out + (size_t)m2 * DM);
#pragma unroll
        for (int j = 0; j < 2; ++j) {
            yr[128 * j + 2 * lane] = unpack4((u32x2){a[j].x, a[j].y}) * rs * w[2 * j]; yr[128 * j + 2 * lane + 1] = unpack4((u32x2){a[j].z, a[j].w}) * rs * w[2 * j + 1];
            if (m2 != m) { yr2[128 * j + 2 * lane] = unpack4((u32x2){b[j].x, b[j].y}) * rs2 * w[2 * j]; yr2[128 * j + 2 * lane + 1] = unpack4((u32x2){b[j].z, b[j].w}) * rs2 * w[2 * j + 1]; }
        }
    }
}

#define XB_TMO      128
#define XB_XCNT(j)  (256  + 64 * (j))
#define XB_XSUB(j)  (1280 + 64 * (j))
#define XB_XGEN(j)  (2304 + 64 * (j))
#define XB_TOP      3328
#define XB_TOPGEN   3392
#define XCD_BAR_WORDS 3456
#define XB_SPIN_CAP (1u << 18)
__device__ __forceinline__ unsigned xb_ld(unsigned* p)              { return __hip_atomic_load(p, __ATOMIC_RELAXED, __HIP_MEMORY_SCOPE_AGENT); }
__device__ __forceinline__ unsigned xb_add(unsigned* p, unsigned v) { return __hip_atomic_fetch_add(p, v, __ATOMIC_RELAXED, __HIP_MEMORY_SCOPE_AGENT); }
__device__ __forceinline__ unsigned xb_xcc_id() { return (unsigned)__builtin_amdgcn_s_getreg((3 << 11) | 20) & 0xFu; }
#define XB_SPIN(cond, bar) do { unsigned _sp = 0; while (cond) { __builtin_amdgcn_s_sleep(1); \
    if ((++_sp & 255u) == 0u) { if (xb_ld(&(bar)[XB_TMO])) break; if (_sp > XB_SPIN_CAP) { atomicAdd(&(bar)[XB_TMO], 1u); break; } } } } while (0)
struct XcdBarrier { unsigned* bar; unsigned x; volatile LAS unsigned* st; };
__device__ __forceinline__ XcdBarrier xcd_barrier_post(unsigned* bar, volatile LAS unsigned* st) {
    XcdBarrier b; b.bar = bar; b.x = xb_xcc_id(); b.st = st;
    if (threadIdx.x == 0) (void)xb_add(&bar[XB_XCNT(b.x)], 1u);
    return b;
}
__device__ __forceinline__ void xcd_barrier_complete(unsigned* bar, unsigned x, unsigned& nloc, unsigned& nx) {
    const unsigned G = gridDim.x * gridDim.y * gridDim.z;
    unsigned sum, cnt, mine, sp = 0u;
    for (;;) {
        sum = 0u; cnt = 0u; mine = 0u;
#pragma unroll
        for (unsigned j = 0; j < 16; ++j) { const unsigned c = xb_ld(&bar[XB_XCNT(j)]); sum += c; cnt += (c > 0u) ? 1u : 0u; mine = (j == x) ? c : mine; }
        if (sum == G) break;
        __builtin_amdgcn_s_sleep(1);
        if ((++sp & 255u) == 0u) { if (xb_ld(&bar[XB_TMO])) break; if (sp > XB_SPIN_CAP) { atomicAdd(&bar[XB_TMO], 1u); break; } }
    }
    nloc = mine > 0u ? mine : 1u; nx = cnt > 0u ? cnt : 1u;
}
__device__ __forceinline__ void xcd_barrier(const XcdBarrier& b) {
    asm volatile("s_waitcnt vmcnt(0)" ::: "memory");
    __syncthreads();
    if (threadIdx.x == 0) {
        unsigned* bar = b.bar;
        __builtin_amdgcn_s_waitcnt(0);
        unsigned nloc = b.st[0], nx = b.st[1];
        if (nloc == 0u) { xcd_barrier_complete(bar, b.x, nloc, nx); b.st[0] = nloc; b.st[1] = nx; }
        const unsigned old = xb_add(&bar[XB_XSUB(b.x)], 1u);
        const unsigned gen = old / nloc;
        if (old + 1u == (gen + 1u) * nloc) {
            __builtin_amdgcn_fence(__ATOMIC_RELEASE, "agent");
            asm volatile("s_waitcnt vmcnt(0)" ::: "memory");
            const unsigned og = xb_add(&bar[XB_TOP], 1u);
            const unsigned tg = og / nx;
            if (og + 1u == (tg + 1u) * nx) xb_add(&bar[XB_TOPGEN], 1u);
            else XB_SPIN(xb_ld(&bar[XB_TOPGEN]) == tg, bar);
            __builtin_amdgcn_fence(__ATOMIC_ACQUIRE, "agent");
            xb_add(&bar[XB_XGEN(b.x)], 1u);
            asm volatile("s_waitcnt vmcnt(0)" ::: "memory");
        } else {
            XB_SPIN(xb_ld(&bar[XB_XGEN(b.x)]) == gen, bar);
            __builtin_amdgcn_fence(__ATOMIC_ACQUIRE, "agent");
            asm volatile("s_waitcnt vmcnt(0)" ::: "memory");
        }
    }
    __syncthreads();
}

constexpr int LDS_BYTES = 147456;
__global__ void __launch_bounds__(512, 2) yoco_fwd(Params Pk) {
    extern __shared__ __attribute__((aligned(16))) unsigned char lds_raw[];
    LAS unsigned char* lds = (LAS unsigned char*)lds_raw;
    cg::grid_group grid = cg::this_grid();
#ifndef PROBE_MASK
#define PROBE_MASK 0u
#endif
#if PROBE == 1
#define GSYNC() do { xcd_barrier(xbar); xcd_barrier(xbar); } while (0)
#elif PROBE_MASK != 0u
    int ph_ = 1; unsigned long long tprev_ = __builtin_amdgcn_s_memrealtime();
#define GSYNC() do { xcd_barrier(xbar); unsigned long long tn_ = __builtin_amdgcn_s_memrealtime(); \
        if ((PROBE_MASK >> ph_) & 1u) { if (blockIdx.x == 0) { while (__builtin_amdgcn_s_memrealtime() - tn_ < tn_ - tprev_) __builtin_amdgcn_s_sleep(8); } xcd_barrier(xbar); tn_ = __builtin_amdgcn_s_memrealtime(); } \
        tprev_ = tn_; ++ph_; } while (0)
#else
#define GSYNC() do { XcdBarrier xb_; { unsigned po_ = PARAM_OFF; asm volatile("" : "+v"(po_)); xb_.bar = (unsigned*)(__attribute__((address_space(1))) unsigned*)ldq(lds + po_, 29) + 4096; } xb_.x = xb_xcc_id(); xb_.st = (volatile LAS unsigned*)(lds + 131072 + 512); xcd_barrier(xb_); } while (0)
#endif
#ifndef PHM
#define PHM 0xffff
#endif
#if PROBE >= 3
#define REP_BEGIN(id) { int nrep_ = (PROBE == (id)) ? 2 : 1; asm volatile("" : "+s"(nrep_)); _Pragma("unroll 1") for (int r_ = 0; r_ < nrep_; ++r_) {
#define REP_END() } }
#else
#define REP_BEGIN(id) {
#define REP_END() }
#endif
    constexpr int G = 256;
    const int wave0 = __builtin_amdgcn_readfirstlane((int)threadIdx.x >> 6);
    volatile LAS unsigned* xst = (volatile LAS unsigned*)(lds + 131072 + 512);
    if (threadIdx.x < 2) xst[threadIdx.x] = 0u;
    if (threadIdx.x < 30) ((LAS unsigned long long*)(lds + PARAM_OFF))[threadIdx.x] = ((const unsigned long long*)&Pk)[threadIdx.x];
    __syncthreads();
    XcdBarrier xbar = xcd_barrier_post((unsigned*)Pk.ws + 4096, xst);

    if (PHM & 1) conv_stage(lds, 0, 0, wave0);
    if (Pk.ws == nullptr) grid.sync();
    xcd_barrier(xbar);
#if PROBE_MASK != 0u
    { unsigned long long tn_ = __builtin_amdgcn_s_memrealtime();
      if (PROBE_MASK & 1u) { if (blockIdx.x == 0) { while (__builtin_amdgcn_s_memrealtime() - tn_ < tn_ - tprev_) __builtin_amdgcn_s_sleep(8); } xcd_barrier(xbar); tn_ = __builtin_amdgcn_s_memrealtime(); }
      tprev_ = tn_; }
#endif
#pragma unroll 1
    for (int L = 0; L < 2; ++L) {
        pg8::StaticOrder S;
        if (L == 0) {
            { const Params P = load_params(lds); unsigned char* ws = P.ws;
              pg8::Gemm g{(const bf16_t*)(ws + WS_XBA), (const bf16_t*)(ws + WS_WIN), MT, 4096, 1024, 1024}; S.init(MP, 4096, G, blockIdx.x);
              EpiGm E{(const float*)(ws + WS_SSA), (bf16_t*)(ws + WS_Z), (float*)(ws + WS_VSS)}; if (PHM & 2) pg8::gemm_phase<EpiGm>(lds, g, S, E, wave0); }
            conv_stage(lds, 1, 64, wave0);
            GSYNC();
            if (PHM & 4) gating_phase(lds, G, wave0);
            GSYNC();
        } else {
            { const Params P = load_params(lds); unsigned char* ws = P.ws;
              pg8::Gemm g{(const bf16_t*)(ws + WS_Z + 130 * MiB), (const bf16_t*)(ws + WS_WQKV), MT, 1280, 1024, 1024}; S.init(MP, 1280, G, blockIdx.x);
              EpiQKV E{(const float*)(ws + WS_SSB), (const float*)(ws + WS_ROPE), (bf16_t*)(ws + WS_Z + 195 * MiB), (bf16_t*)(ws + WS_KB), (bf16_t*)(ws + WS_VB), P.out};
              if (PHM & 8) pg8::gemm_phase<EpiQKV>(lds, g, S, E, wave0); }
            GSYNC();
#if PROBE == 2
            attn_phase(lds, G, wave0, 1);
#endif
            if (PHM & 16) attn_phase(lds, G, wave0, 0);
            GSYNC();
        }
        { const Params P = load_params(lds); unsigned char* ws = P.ws;
          pg8::Gemm g{(const bf16_t*)(ws + WS_Z + (L == 0 ? 0 : 195 * MiB)), (const bf16_t*)(ws + (L == 0 ? WS_WOUT : WS_WO)), MT, 1024, L == 0 ? 2048 : 1024, L == 0 ? 4096 : 1024}; S.init(MP, 1024, G, blockIdx.x);
          EpiRes E{(const bf16_t*)(ws + (L == 0 ? WS_XBA : WS_Z + 130 * MiB)), (bf16_t*)(ws + WS_XBA), (float*)(ws + WS_SSB)}; if (PHM & 32) pg8::gemm_phase<EpiRes>(lds, g, S, E, wave0); }
        if (L == 0) conv_stage(lds, 2, 16, wave0); else conv_stage(lds, 8, 16, wave0);
        GSYNC();
        { const Params P = load_params(lds); unsigned char* ws = P.ws;
          pg8::Gemm g{(const bf16_t*)(ws + WS_XBA), (const bf16_t*)(ws + WS_WGU0 + (size_t)L * 11 * MiB), MT, 2 * DFF, 1024, 1024}; S.init(MP, 2 * DFF, G, blockIdx.x);
          EpiGU E{(const float*)(ws + WS_SSB), (bf16_t*)(ws + WS_Z), P.conv_w + (size_t)L * 3 * DFF, P.conv_b + (size_t)L * DFF, (float*)(ws + WS_HG), (float*)(ws + WS_C0), (float*)(ws + WS_U0),
                  P.state + (size_t)L * 128 * 2 * DFF, P.out + O_NCS + (size_t)L * 128 * 2 * DFF};
          REP_BEGIN(3) if (PHM & 64) pg8::gemm_phase<EpiGU>(lds, g, S, E, wave0); REP_END()
        }
        if (L == 0) conv_stage(lds, 3, 88, wave0); else conv_stage(lds, 5, 88, wave0);
        GSYNC();
        if (PHM & 128) fixup_phase(lds, L, G, wave0);
        GSYNC();
        { const Params P = load_params(lds); unsigned char* ws = P.ws;
          pg8::Gemm g{(const bf16_t*)(ws + WS_Z), (const bf16_t*)(ws + WS_WD0 + (size_t)L * 5632 * 1024), MT, 1024, DFF, DFF}; S.init(MP, 1024, G, blockIdx.x);
          EpiRes E{(const bf16_t*)(ws + WS_XBA), (bf16_t*)(ws + WS_XBA), (float*)(ws + WS_SSA)}; if (PHM & 256) pg8::gemm_phase<EpiRes>(lds, g, S, E, wave0); }
        if (L == 0) conv_stage(lds, 4, 16, wave0); else conv_stage(lds, 6, 16, wave0);
        GSYNC();
        { const Params P = load_params(lds); unsigned char* ws = P.ws;
          pg8::Gemm g{(const bf16_t*)(ws + WS_PB) + (size_t)L * MT * PLE, (const bf16_t*)(ws + WS_WPP0 + (size_t)L * 512 * 1024), MT, 1024, 256, 256}; S.init(MP, 1024, G, blockIdx.x);
          EpiBf E{(bf16_t*)(ws + WS_Z)}; if (PHM & 512) pg8::gemm_phase<EpiBf>(lds, g, S, E, wave0); }
        { const Params P = load_params(lds); unsigned char* ws = P.ws;
          pg8::Gemm g{(const bf16_t*)(ws + WS_XBA), (const bf16_t*)(ws + WS_WPG0 + (size_t)L * 2 * MiB), MT, 1024, 1024, 1024}; S.init(MP, 1024, G, blockIdx.x);
          EpiPle E{(const float*)(ws + WS_SSA), (const bf16_t*)(ws + WS_Z), (const bf16_t*)(ws + WS_XBA), (bf16_t*)(ws + WS_Z + 130 * MiB), (float*)(ws + WS_SSB)}; if (PHM & 1024) pg8::gemm_phase<EpiPle>(lds, g, S, E, wave0); }
        if (L == 0) conv_stage(lds, 7, 16, wave0);
        GSYNC();
    }
    if (PHM & 2048) final_phase(lds, G, wave0);
#if PROBE_MASK != 0u
    if ((PROBE_MASK >> 15) & 1u) { asm volatile("s_waitcnt vmcnt(0)" ::: "memory"); const unsigned long long tn_ = __builtin_amdgcn_s_memrealtime(); if (blockIdx.x == 0) { while (__builtin_amdgcn_s_memrealtime() - tn_ < tn_ - tprev_) __builtin_amdgcn_s_sleep(8); } }
#endif
}

extern "C" void kernel_launch(void* const* d_in, const int* in_sizes, int n_in, void* d_out, int out_size, void* d_ws, size_t ws_size, hipStream_t stream) {
    static int grid = 0;
    if (grid == 0) {
        if (n_in != 28 || ws_size < WS_END) { fprintf(stderr, "kernel_launch: unexpected n_in %d / ws_size %zu\n", n_in, ws_size); grid = -1; return; }
        int dev = 0, cus = 0, per_cu = 0;
        hipGetDevice(&dev); hipDeviceGetAttribute(&cus, hipDeviceAttributeMultiprocessorCount, dev);
        hipFuncSetAttribute((const void*)yoco_fwd, hipFuncAttributeMaxDynamicSharedMemorySize, LDS_BYTES);
        hipOccupancyMaxActiveBlocksPerMultiprocessor(&per_cu, (const void*)yoco_fwd, 512, LDS_BYTES);
        if (per_cu < 1) { fprintf(stderr, "kernel_launch: occupancy query says %d blocks/CU\n", per_cu); per_cu = 1; }
        (void)hipGetLastError();
        if (cus < 256) { fprintf(stderr, "kernel_launch: needs 256 CUs, device has %d\n", cus); grid = -1; return; }
        grid = 256;
    }
    if (grid < 0) return;
    if (hipMemsetAsync(d_ws, 0, 65536, stream) != hipSuccess) { fprintf(stderr, "kernel_launch: memset failed\n"); return; }
    Params p{};
    const float** pp = (const float**)&p;
    for (int i = 0; i < 28; ++i) pp[i] = (const float*)d_in[i];
    p.out = (float*)d_out; p.ws = (unsigned char*)d_ws;
    void* args[] = {&p};
    hipError_t e = hipLaunchCooperativeKernel((const void*)yoco_fwd, dim3(grid), dim3(512), args, LDS_BYTES, stream);
    if (e != hipSuccess) fprintf(stderr, "cooperative launch failed: %s (grid %d)\n", hipGetErrorString(e), grid);
}
```
